# Optimizing an MI355X kernel written in HIP

```python
import jax, jax.numpy as jnp
from jax import lax
import numpy as np

D_MODEL = 2048
BATCH = 4
SEQ = 4096
DEPTH = 4

CHUNK = 64
N_A_LAYERS = DEPTH // 2
N_B_LAYERS = DEPTH - N_A_LAYERS
RMS_EPS = 1e-6

GLA_HEADS = 4
GLA_DK = D_MODEL // 2 // GLA_HEADS
GLA_DV = D_MODEL // GLA_HEADS
GLA_GATE_RANK = 16
GLA_GATE_TEMP = 16.0
GLA_IN_COLS = 2 * GLA_HEADS * GLA_DK + 2 * GLA_HEADS * GLA_DV + GLA_GATE_RANK

FOX_HEADS = 16
FOX_DH = D_MODEL // FOX_HEADS
FOX_QBLOCK = 128
FOX_FORGET_BIAS_MEAN = 3.0

PEER_HEADS = 8
PEER_QDIM = 256
PEER_HALF = PEER_QDIM // 2
PEER_NKEYS = 128
PEER_N_EXPERTS = PEER_NKEYS * PEER_NKEYS
PEER_TOPK = 16
PEER_TOKEN_BLOCK = 128

kernel_name = 'hybrid_gla_fox_peer_adaln_trunk'


def _rmsnorm(x, g):
    xf = x.astype(jnp.float32)
    xf = xf * lax.rsqrt(jnp.mean(xf * xf, axis=-1, keepdims=True) + RMS_EPS)
    return xf.astype(x.dtype) * g


def _modulate(h, shift, scale):
    return h * (1 + scale[:, None, :]) + shift[:, None, :]


def _gla(h, w_in, w_gate2, b_gate2, g_norm, w_out):
    B, S, _ = h.shape
    nc = S // CHUNK
    hk = GLA_HEADS * GLA_DK
    hv = GLA_HEADS * GLA_DV
    proj = h @ w_in
    q, k, v, g, gl = jnp.split(proj, [hk, 2 * hk, 2 * hk + hv, 2 * hk + 2 * hv], axis=-1)
    log_a = jax.nn.log_sigmoid((gl @ w_gate2 + b_gate2).astype(jnp.float32)) / GLA_GATE_TEMP

    def to_chunks(t, dh):
        return t.astype(jnp.float32).reshape(B, nc, CHUNK, GLA_HEADS, dh).transpose(1, 0, 3, 2, 4)

    qc = to_chunks(q, GLA_DK) * (GLA_DK ** -0.5)
    kc = to_chunks(k, GLA_DK)
    vc = to_chunks(v, GLA_DV)
    bc = jnp.cumsum(to_chunks(log_a, GLA_DK), axis=3)

    def step(state, xs):
        qt, kt, vt, bt = xs
        inter = jnp.einsum('bhtk,bhkv->bhtv', qt * jnp.exp(bt), state)
        decay = jnp.exp(-jnp.abs(bt[:, :, :, None, :] - bt[:, :, None, :, :]))
        scores = jnp.einsum('bhtk,bhsk,bhtsk->bhts', qt, kt, decay)
        out = inter + jnp.einsum('bhts,bhsv->bhtv', scores, vt)
        b_end = bt[:, :, -1:, :]
        state = (jnp.exp(b_end[:, :, 0, :])[..., None] * state
                 + jnp.einsum('bhsk,bhsv->bhkv', kt * jnp.exp(b_end - bt), vt))
        return state, out

    s0 = jnp.zeros((B, GLA_HEADS, GLA_DK, GLA_DV), jnp.float32)
    _, o = lax.scan(step, s0, (qc, kc, vc, bc))
    o = o.transpose(1, 0, 3, 2, 4).reshape(B, S, GLA_HEADS, GLA_DV)
    o = _rmsnorm(o, g_norm).astype(h.dtype).reshape(B, S, hv)
    return (o * jax.nn.silu(g)) @ w_out


def _shared_kv(x, c_act, kv_norm, kv_ada_w, kv_ada_b, w_kv, b_f):
    B, S, _ = x.shape
    shift, scale = jnp.split(c_act @ kv_ada_w + kv_ada_b, 2, axis=-1)
    hk = _modulate(_rmsnorm(x, kv_norm), shift, scale)
    k, v, fl = jnp.split(hk @ w_kv, [D_MODEL, 2 * D_MODEL], axis=-1)
    log_f = jax.nn.log_sigmoid((fl + b_f).astype(jnp.float32))
    F = jnp.cumsum(log_f, axis=1).transpose(0, 2, 1)
    k = k.reshape(B, S, FOX_HEADS, FOX_DH).transpose(0, 2, 1, 3)
    v = v.reshape(B, S, FOX_HEADS, FOX_DH).transpose(0, 2, 1, 3)
    return k, v, F


def _fox(h, k, v, F, w_q, w_out):
    B, S, _ = h.shape
    q, g = jnp.split(h @ w_q, 2, axis=-1)
    q = q.reshape(B, S, FOX_HEADS, FOX_DH).transpose(0, 2, 1, 3) * (FOX_DH ** -0.5)
    outs = []
    for i in range(S // FOX_QBLOCK):
        lo, hi = i * FOX_QBLOCK, (i + 1) * FOX_QBLOCK
        s = jnp.einsum('bhqd,bhkd->bhqk', q[:, :, lo:hi], k[:, :, :hi]).astype(jnp.float32)
        s = s + F[:, :, lo:hi, None] - F[:, :, None, :hi]
        mask = jnp.arange(lo, hi)[:, None] >= jnp.arange(hi)[None, :]
        p = jax.nn.softmax(jnp.where(mask, s, -jnp.inf), axis=-1).astype(v.dtype)
        outs.append(jnp.einsum('bhqk,bhkd->bhqd', p, v[:, :, :hi]))
    o = jnp.concatenate(outs, axis=2).transpose(0, 2, 1, 3).reshape(B, S, D_MODEL)
    return (o * jax.nn.sigmoid(g)) @ w_out


def _peer(h, w_q, subkeys, u, v):
    B, S, D = h.shape
    T = B * S
    hf = h.reshape(T, D)
    q = (hf @ w_q).reshape(T, PEER_HEADS, 2, PEER_HALF)
    s = jnp.einsum('thpd,hpnd->thpn', q, subkeys)
    vals, idx = lax.top_k(s, PEER_TOPK)
    cand = (vals[:, :, 0, :, None] + vals[:, :, 1, None, :]).reshape(T, PEER_HEADS, PEER_TOPK * PEER_TOPK)
    cand_id = (idx[:, :, 0, :, None] * PEER_NKEYS + idx[:, :, 1, None, :]).reshape(T, PEER_HEADS, PEER_TOPK * PEER_TOPK)
    top_v, top_i = lax.top_k(cand, PEER_TOPK)
    expert = jnp.take_along_axis(cand_id, top_i, axis=-1)
    w = jax.nn.softmax(top_v.astype(jnp.float32), axis=-1).astype(h.dtype)
    nb = T // PEER_TOKEN_BLOCK
    kk = PEER_HEADS * PEER_TOPK
    ids = expert.reshape(nb, PEER_TOKEN_BLOCK, kk)
    ws = w.reshape(nb, PEER_TOKEN_BLOCK, kk)
    xb = hf.reshape(nb, PEER_TOKEN_BLOCK, D)

    def block(args):
        xt, it, wt = args
        act = jax.nn.gelu(jnp.einsum('tkd,td->tk', u[it], xt))
        return jnp.einsum('tk,tkd->td', wt * act, v[it])

    return lax.map(block, (xb, ids, ws)).reshape(B, S, D)


def setup_inputs(seed: int = 0) -> dict:
    key = jax.random.key(seed)
    ks = jax.random.split(key, 24)
    D = D_MODEL

    def nrm(k, shape, std):
        return jax.random.normal(k, shape, jnp.float32) * std

    def gain(k, shape):
        return 1.0 + nrm(k, shape, 0.01)

    return {
        'x': nrm(ks[0], (BATCH, SEQ, D), 1.0),
        'c': nrm(ks[1], (BATCH, D), 1.0),
        'ada_w': nrm(ks[2], (DEPTH, D, 6 * D), 0.5 * D ** -0.5),
        'ada_b': nrm(ks[3], (DEPTH, 6 * D), 0.02),
        'norm_mix': gain(ks[4], (DEPTH, D)),
        'norm_ffn': gain(ks[5], (DEPTH, D)),
        'gla_w_in': nrm(ks[6], (N_A_LAYERS, D, GLA_IN_COLS), D ** -0.5),
        'gla_w_gate2': nrm(ks[7], (N_A_LAYERS, GLA_GATE_RANK, GLA_HEADS * GLA_DK), GLA_GATE_RANK ** -0.5),
        'gla_b_gate2': nrm(ks[8], (N_A_LAYERS, GLA_HEADS * GLA_DK), 0.02),
        'gla_norm': gain(ks[9], (N_A_LAYERS, GLA_DV)),
        'gla_w_out': nrm(ks[10], (N_A_LAYERS, GLA_HEADS * GLA_DV, D), (GLA_HEADS * GLA_DV) ** -0.5),
        'kv_norm': gain(ks[11], (D,)),
        'kv_ada_w': nrm(ks[12], (D, 2 * D), 0.5 * D ** -0.5),
        'kv_ada_b': nrm(ks[13], (2 * D,), 0.02),
        'fox_w_kv': nrm(ks[14], (D, 2 * D + FOX_HEADS), D ** -0.5),
        'fox_b_f': FOX_FORGET_BIAS_MEAN + nrm(ks[15], (FOX_HEADS,), 0.5),
        'fox_w_q': nrm(ks[16], (N_B_LAYERS, D, 2 * D), D ** -0.5),
        'fox_w_out': nrm(ks[17], (N_B_LAYERS, D, D), D ** -0.5),
        'peer_w_q': nrm(ks[18], (DEPTH, D, PEER_HEADS * PEER_QDIM), D ** -0.5),
        'peer_subkeys': nrm(ks[19], (DEPTH, PEER_HEADS, 2, PEER_NKEYS, PEER_HALF), PEER_HALF ** -0.5),
        'peer_u': nrm(ks[20], (DEPTH, PEER_N_EXPERTS, D), D ** -0.5),
        'peer_v': nrm(ks[21], (DEPTH, PEER_N_EXPERTS, D), PEER_HEADS ** -0.5),
        'final_norm': gain(ks[22], (D,)),
    }


def reference(x, c, ada_w, ada_b, norm_mix, norm_ffn, gla_w_in, gla_w_gate2, gla_b_gate2,
              gla_norm, gla_w_out, kv_norm, kv_ada_w, kv_ada_b, fox_w_kv, fox_b_f,
              fox_w_q, fox_w_out, peer_w_q, peer_subkeys, peer_u, peer_v, final_norm):
    c_act = jax.nn.silu(c)
    kv = None
    for l in range(DEPTH):
        mod = c_act @ ada_w[l] + ada_b[l]
        sh_m, sc_m, gt_m, sh_f, sc_f, gt_f = jnp.split(mod, 6, axis=-1)
        h = _modulate(_rmsnorm(x, norm_mix[l]), sh_m, sc_m)
        if l < N_A_LAYERS:
            a = l
            y = _gla(h, gla_w_in[a], gla_w_gate2[a], gla_b_gate2[a], gla_norm[a], gla_w_out[a])
        else:
            b = l - N_A_LAYERS
            y = _fox(h, kv[0], kv[1], kv[2], fox_w_q[b], fox_w_out[b])
        x = x + gt_m[:, None, :] * y
        h = _modulate(_rmsnorm(x, norm_ffn[l]), sh_f, sc_f)
        x = x + gt_f[:, None, :] * _peer(h, peer_w_q[l], peer_subkeys[l], peer_u[l], peer_v[l])
        if l == N_A_LAYERS - 1:
            kv = _shared_kv(x, c_act, kv_norm, kv_ada_w, kv_ada_b, fox_w_kv, fox_b_f)
    return _rmsnorm(x, final_norm)
```

```cpp
#include <hip/hip_runtime.h>
#include <stdint.h>
#include <stdio.h>

#define LAS __attribute__((address_space(3)))
typedef unsigned short bf16_t;
typedef float f32x16 __attribute__((ext_vector_type(16)));
typedef short s16x4 __attribute__((ext_vector_type(4)));
typedef __bf16 bf16x2 __attribute__((ext_vector_type(2)));

namespace pg8 {
#define PG8_LAS __attribute__((address_space(3)))
typedef unsigned short bf16_t;
typedef short bf16x8 __attribute__((ext_vector_type(8)));
typedef float f32x4 __attribute__((ext_vector_type(4)));
typedef unsigned u32x4 __attribute__((ext_vector_type(4)));
constexpr int BM = 256, BK = 64, HALF = 128, HTB = HALF * BK * 2  , STAGE_BYTES = 8 * HTB, NXCD = 8, WGM = 8;

__host__ __device__ __forceinline__ int lds_byte(int r, int c) { const int st = (r >> 4) * 2 + (c >> 5), rr = r & 15, cc = c & 31, ob = rr * 64 + cc * 2; return st * 1024 + (ob ^ (((ob >> 9) & 1) << 5)); }
__host__ __device__ __forceinline__ void stage_rc(int b, int& R, int& C) { const int st = b / 1024, sb = b % 1024, swz = sb ^ (((sb >> 9) & 1) << 5); R = (st >> 1) * 16 + swz / 64; C = (st & 1) * 32 + (swz % 64) / 2; }
__host__ __device__ __forceinline__ int perm32(int rho) { const int n = rho >> 4, i = rho & 15; return 8 * (i >> 2) + 4 * n + (i & 3); }

struct Unit { int pm, pn; };
struct Gemm { const bf16_t* A; const bf16_t* Bt; int M, N, K; };

struct StaticOrder {
    int nM, nN, nwg, G, c;
    __host__ __device__ void init(int M, int N, int G_, int c_) { nM = M / BM; nN = N / BM; nwg = nM * nN; G = G_; c = c_; }
    __host__ __device__ bool next(int i, Unit& u) const {
        const long L = (long)i * G + c; if (L >= nwg) return false;
        int wgid = (int)L; { const int q = nwg / NXCD, r = nwg % NXCD, xcd = wgid % NXCD, off = wgid / NXCD; wgid = (xcd < r ? xcd * (q + 1) : r * (q + 1) + (xcd - r) * q) + off; }
        const int nig = WGM * nN, gid = wgid / nig, fm = gid * WGM, gsz = (nM - fm) < WGM ? (nM - fm) : WGM;
        u.pm = fm + ((wgid % nig) % gsz); u.pn = (wgid % nig) / gsz; return true;
    }
    __device__ __forceinline__ void a_ready(const Unit&) const {}
    __device__ __forceinline__ void done(const Unit&) const {}
};
struct CountedOrder : StaticOrder {
    const unsigned* ready; unsigned need; unsigned* tmo;
    __device__ __forceinline__ void a_ready(const Unit& u) const {
        if (threadIdx.x < 64) {
            const unsigned long long t0 = __builtin_amdgcn_s_memrealtime(); unsigned polls = 0;
            while ((unsigned)__builtin_amdgcn_readfirstlane(__hip_atomic_load(ready + 64 * u.pm, __ATOMIC_RELAXED, __HIP_MEMORY_SCOPE_AGENT)) < need) {
                if ((++polls & 255u) == 0u && __builtin_amdgcn_readfirstlane(__hip_atomic_load(tmo, __ATOMIC_RELAXED, __HIP_MEMORY_SCOPE_AGENT)) != 0u) break;
                if (__builtin_amdgcn_s_memrealtime() - t0 > 2000000ull) {
                    if (threadIdx.x == 0) { unsigned expect = 0u; __hip_atomic_compare_exchange_strong(tmo + 1, &expect, 0x600u | (unsigned)(u.pm & 0xff), __ATOMIC_RELAXED, __ATOMIC_RELAXED, __HIP_MEMORY_SCOPE_AGENT); __hip_atomic_store(tmo, 1u, __ATOMIC_RELAXED, __HIP_MEMORY_SCOPE_AGENT); }
                    break; }
                __builtin_amdgcn_s_sleep(2); }
            __builtin_amdgcn_fence(__ATOMIC_ACQUIRE, "agent");
            asm volatile("s_waitcnt vmcnt(0)" ::: "memory");
        }
#if !defined(BROKEN_HOOK_NO_BARRIER)
        asm volatile("" ::: "memory"); __builtin_amdgcn_s_barrier(); asm volatile("" ::: "memory");
#endif
    }
};

__device__ __forceinline__ unsigned cvt_pk_bf16(float lo, float hi) { unsigned r; asm volatile("v_cvt_pk_bf16_f32 %0, %1, %2" : "=v"(r) : "v"(lo), "v"(hi)); return r; }
typedef float f32x2 __attribute__((ext_vector_type(2)));
__device__ __forceinline__ f32x2 gelu_pk(f32x2 v) {
    const f32x2 av = __builtin_elementwise_abs(v), d = av * 0.2316418882f + 1.0f;
    f32x2 t; t.x = __builtin_amdgcn_rcpf(d.x); t.y = __builtin_amdgcn_rcpf(d.y);
    f32x2 q = t * 0.5307027145f + (-0.7265760135f); q = q * t + 0.7107068705f; q = q * t + (-0.142248368f); q = q * t + 0.127414796f; q = q * t;
    const f32x2 s = (v * v) * (-0.72134752044f);
    f32x2 e; e.x = __builtin_amdgcn_exp2f(s.x); e.y = __builtin_amdgcn_exp2f(s.y);
    const f32x2 m = v * (q * e), r = v - m;
    f32x2 o; o.x = v.x < 0.f ? m.x : r.x; o.y = v.y < 0.f ? m.y : r.y; return o;
}

struct EpiF32 {
    static constexpr bool PERM = false, AFTER_DRAIN = false;
    float* C; int ldc; const float* bias;
    __device__ __forceinline__ void operator()(const f32x4 (&acc)[2][2][4][2], const Unit& u, int wr, int wc, int fr, int fq) const {
        const int row0 = u.pm * BM + wr * 64 + fr, col0 = u.pn * BM + wc * 32 + 4 * fq;
        f32x4 bv[2][2];
#pragma unroll
        for (int bj = 0; bj < 2; ++bj)
#pragma unroll
            for (int n = 0; n < 2; ++n) bv[bj][n] = bias ? *(const f32x4*)(bias + col0 + bj * HALF + n * 16) : (f32x4){0.f, 0.f, 0.f, 0.f};
#pragma unroll
        for (int ai = 0; ai < 2; ++ai)
#pragma unroll
            for (int m = 0; m < 4; ++m) { float* rowp = C + (size_t)(row0 + ai * HALF + m * 16) * ldc + col0;
#pragma unroll
                for (int bj = 0; bj < 2; ++bj)
#pragma unroll
                    for (int n = 0; n < 2; ++n) *(f32x4*)(rowp + bj * HALF + n * 16) = acc[ai][bj][m][n] + bv[bj][n]; }
    }
};
template <int ACT  > struct EpiBf16 {
    static constexpr bool PERM = true, AFTER_DRAIN = false;
    bf16_t* O; int ldc; const float* bias; int split_cols; size_t split_stride;
    __device__ __forceinline__ void operator()(const f32x4 (&acc)[2][2][4][2], const Unit& u, int wr, int wc, int fr, int fq) const {
        const int row0 = u.pm * BM + wr * 64 + fr; int colt = u.pn * BM; bf16_t* base = O;
        if (split_cols) { const int t = colt / split_cols; base += (size_t)t * split_stride; colt -= t * split_cols; }
        const int col0 = colt + wc * 32 + 8 * fq, bcol0 = u.pn * BM + wc * 32 + 8 * fq;
        f32x4 bv[2][2];
#pragma unroll
        for (int bj = 0; bj < 2; ++bj)
#pragma unroll
            for (int n = 0; n < 2; ++n) bv[bj][n] = bias ? *(const f32x4*)(bias + bcol0 + bj * HALF + 4 * n) : (f32x4){0.f, 0.f, 0.f, 0.f};
#pragma unroll
        for (int ai = 0; ai < 2; ++ai)
#pragma unroll
            for (int m = 0; m < 4; ++m) { bf16_t* rowp = base + (size_t)(row0 + ai * HALF + m * 16) * ldc + col0;
#pragma unroll
                for (int bj = 0; bj < 2; ++bj) { f32x4 v0 = acc[ai][bj][m][0] + bv[bj][0], v1 = acc[ai][bj][m][1] + bv[bj][1];
                    if (ACT == 1) { f32x2 a = gelu_pk((f32x2){v0[0], v0[1]}), b = gelu_pk((f32x2){v0[2], v0[3]}), c = gelu_pk((f32x2){v1[0], v1[1]}), d = gelu_pk((f32x2){v1[2], v1[3]});
                        v0 = (f32x4){a.x, a.y, b.x, b.y}; v1 = (f32x4){c.x, c.y, d.x, d.y}; }
                    if (ACT == 2) {
#pragma unroll
                        for (int j = 0; j < 4; ++j) { v0[j] = 0.5f * v0[j] * (1.0f + erff(v0[j] * 0.70710678f)); v1[j] = 0.5f * v1[j] * (1.0f + erff(v1[j] * 0.70710678f)); } }
                    u32x4 w; w.x = cvt_pk_bf16(v0[0], v0[1]); w.y = cvt_pk_bf16(v0[2], v0[3]); w.z = cvt_pk_bf16(v1[0], v1[1]); w.w = cvt_pk_bf16(v1[2], v1[3]);
                    *(u32x4*)(rowp + bj * HALF) = w; } }
    }
};
struct EpiResid {
    static constexpr bool PERM = false, AFTER_DRAIN = false;
    const float* xold; float* xnew; const float* gate; int gstride;
    __device__ __forceinline__ void operator()(const f32x4 (&acc)[2][2][4][2], const Unit& u, int wr, int wc, int fr, int fq) const {
        const int row0 = u.pm * BM + wr * 64 + fr, col0 = u.pn * BM + wc * 32 + 4 * fq;
        const float* gp = gate + (size_t)((u.pm * BM) >> 12) * gstride + col0;
        f32x4 gv[2][2];
#pragma unroll
        for (int bj = 0; bj < 2; ++bj)
#pragma unroll
            for (int n = 0; n < 2; ++n) gv[bj][n] = *(const f32x4*)(gp + bj * HALF + n * 16);
#pragma unroll
        for (int ai = 0; ai < 2; ++ai)
#pragma unroll
            for (int m = 0; m < 4; ++m) { const size_t off = (size_t)(row0 + ai * HALF + m * 16) * 2048 + col0;
#pragma unroll
                for (int bj = 0; bj < 2; ++bj)
#pragma unroll
                    for (int n = 0; n < 2; ++n) { const f32x4 xo = *(const f32x4*)(xold + off + bj * HALF + n * 16);
                        *(f32x4*)(xnew + off + bj * HALF + n * 16) = xo + gv[bj][n] * acc[ai][bj][m][n]; } }
    }
};

template <class Epi, class Sched, bool STAMP = false>
__device__ __forceinline__ void gemm_phase(PG8_LAS unsigned char* lds, const Gemm g, const Sched& S, const Epi& E, unsigned long long* stamps) {
    const int tid = threadIdx.x, wid = __builtin_amdgcn_readfirstlane(tid >> 6), lane = tid & 63, wr = wid >> 2, wc = wid & 3, fr = lane & 15, fq = lane >> 4;
    const int K = g.K, nt = K / BK;
    int ts_lo = 0, ts_hi = 0, nts = 0; const unsigned long long rt_entry = STAMP ? (unsigned long long)wall_clock64() : 0ull;
#define PG8_STAMP() do { if (STAMP && wid == 0 && nts < 64) { const unsigned long long _c = (unsigned long long)clock64(); \
        ts_lo = (lane == nts) ? (int)(unsigned)_c : ts_lo; ts_hi = (lane == nts) ? (int)(unsigned)(_c >> 32) : ts_hi; ++nts; } } while (0)
    PG8_STAMP();
    unsigned voffA[2], voffB[2];
#pragma unroll
    for (int i = 0; i < 2; ++i) { int R, C; stage_rc(tid * 16 + i * 8192, R, C); const int Rb = Epi::PERM ? ((R & ~31) + perm32(R & 31)) : R;
        voffA[i] = (unsigned)(R * K + C) * 2u; voffB[i] = (unsigned)(Rb * K + C) * 2u; }
    const size_t kstep = (size_t)(BK * 2);
    const size_t hstep = (size_t)HALF * K * 2;
    const size_t tstep = 2 * hstep;
    const unsigned ldsw = (unsigned)wid * 1024u;
    const int aoff = lds_byte(wr * 64 + fr, fq * 8), boff = lds_byte(wc * 32 + fr, fq * 8);
#define PG8_SA(b, h) (((b) * 2 + (h)) * HTB)
#define PG8_SB(b, h) ((4 + (b) * 2 + (h)) * HTB)
#define PG8_STAGE(bufoff, gbase, voff) do { _Pragma("unroll") for (int _i = 0; _i < 2; ++_i) \
        __builtin_amdgcn_global_load_lds((const unsigned*)((const char*)(gbase) + (voff)[_i]), (PG8_LAS unsigned*)(lds + (bufoff) + ldsw + _i * 8192), 16, 0, 0); } while (0)
#define PG8_LDA(dst, b, h) do { _Pragma("unroll") for (int m = 0; m < 4; ++m) _Pragma("unroll") for (int k = 0; k < 2; ++k) dst[m][k] = *(const PG8_LAS bf16x8*)(lds + PG8_SA(b, h) + aoff + m * 2048 + k * 1024); } while (0)
#define PG8_LDB(dst, b, h) do { _Pragma("unroll") for (int n = 0; n < 2; ++n) _Pragma("unroll") for (int k = 0; k < 2; ++k) dst[n][k] = *(const PG8_LAS bf16x8*)(lds + PG8_SB(b, h) + boff + n * 2048 + k * 1024); } while (0)
#define PG8_MMA(ai, bj, At, Bt) do { __builtin_amdgcn_s_setprio(1); _Pragma("unroll") for (int m = 0; m < 4; ++m) _Pragma("unroll") for (int n = 0; n < 2; ++n) _Pragma("unroll") for (int k = 0; k < 2; ++k) \
        acc[ai][bj][m][n] = __builtin_amdgcn_mfma_f32_16x16x32_bf16(Bt[n][k], At[m][k], acc[ai][bj][m][n], 0, 0, 0); __builtin_amdgcn_s_setprio(0); } while (0)
#define PG8_WAIT_V(n) asm volatile("s_waitcnt vmcnt(" #n ")" ::: "memory")
#define PG8_WAIT_L(n) asm volatile("s_waitcnt lgkmcnt(" #n ")" ::: "memory")
#define PG8_BAR __builtin_amdgcn_s_barrier()
#define PG8_SCHED __builtin_amdgcn_sched_barrier(0)
    Unit cur, nxt; int ui = 0;
    if (!S.next(0, cur)) return;
    f32x4 acc[2][2][4][2];
#pragma unroll
    for (int a = 0; a < 2; ++a)
#pragma unroll
        for (int b = 0; b < 2; ++b)
#pragma unroll
            for (int m = 0; m < 4; ++m)
#pragma unroll
                for (int n = 0; n < 2; ++n) acc[a][b][m][n] = (f32x4){0.f, 0.f, 0.f, 0.f};
    bf16x8 At[4][2], B0[2][2], B1[2][2];
    const char* cA = (const char*)g.A + (size_t)cur.pm * tstep; const char* cB = (const char*)g.Bt + (size_t)cur.pn * tstep;
    S.a_ready(cur);
    PG8_STAGE(PG8_SB(0, 0), cB, voffB); PG8_STAGE(PG8_SA(0, 0), cA, voffA); PG8_STAGE(PG8_SB(0, 1), cB + hstep, voffB); PG8_STAGE(PG8_SA(0, 1), cA + hstep, voffA);
    if (wr == 1) PG8_BAR;
    PG8_WAIT_V(4); PG8_BAR;
    PG8_STAGE(PG8_SB(1, 0), cB + kstep, voffB); PG8_STAGE(PG8_SA(1, 0), cA + kstep, voffA); PG8_STAGE(PG8_SB(1, 1), cB + hstep + kstep, voffB);
    PG8_WAIT_V(6); PG8_BAR;
    PG8_STAMP();
    for (;;) {
        const bool has_next = S.next(ui + 1, nxt);
        const char* nA = has_next ? (const char*)g.A + (size_t)nxt.pm * tstep : cA; const char* nB = has_next ? (const char*)g.Bt + (size_t)nxt.pn * tstep : cB;
        for (int t = 0; t < nt; t += 2) {
            const bool last = (t == nt - 2);
            const char* a1 = cA + (size_t)(t + 1) * kstep;
            const char* a2 = last ? nA : cA + (size_t)(t + 2) * kstep; const char* b2 = last ? nB : cB + (size_t)(t + 2) * kstep;
            const char* a3 = a2 + kstep; const char* b3 = b2 + kstep;
            if (last && has_next) S.a_ready(nxt);
            PG8_LDB(B0, 0, 0); PG8_SCHED; PG8_LDA(At, 0, 0); PG8_STAGE(PG8_SA(1, 1), a1 + hstep, voffA);
            PG8_WAIT_L(8); PG8_BAR; PG8_WAIT_L(0); PG8_MMA(0, 0, At, B0); PG8_BAR; PG8_SCHED;
            PG8_LDB(B1, 0, 1); PG8_STAGE(PG8_SB(0, 0), b2, voffB);
            PG8_BAR; PG8_WAIT_L(0); PG8_MMA(0, 1, At, B1); PG8_BAR;
            PG8_LDA(At, 0, 1); PG8_STAGE(PG8_SA(0, 0), a2, voffA);
            PG8_BAR; PG8_WAIT_L(0); PG8_MMA(1, 0, At, B0); PG8_BAR; PG8_SCHED;
            PG8_STAGE(PG8_SB(0, 1), b2 + hstep, voffB);
            PG8_WAIT_V(6); PG8_BAR; PG8_MMA(1, 1, At, B1); PG8_BAR;
            PG8_LDB(B0, 1, 0); PG8_SCHED; PG8_LDA(At, 1, 0); PG8_STAGE(PG8_SA(0, 1), a2 + hstep, voffA);
            PG8_WAIT_L(8); PG8_BAR; PG8_WAIT_L(0); PG8_MMA(0, 0, At, B0); PG8_BAR; PG8_SCHED;
            PG8_LDB(B1, 1, 1); PG8_STAGE(PG8_SB(1, 0), b3, voffB);
            PG8_BAR; PG8_WAIT_L(0); PG8_MMA(0, 1, At, B1); PG8_BAR;
            PG8_LDA(At, 1, 1); PG8_STAGE(PG8_SA(1, 0), a3, voffA);
            PG8_BAR; PG8_WAIT_L(0); PG8_MMA(1, 0, At, B0); PG8_BAR; PG8_SCHED;
            PG8_STAGE(PG8_SB(1, 1), b3 + hstep, voffB);
            PG8_WAIT_V(6); PG8_BAR; PG8_MMA(1, 1, At, B1); PG8_BAR;
        }
        PG8_STAMP();
        if constexpr (!Epi::AFTER_DRAIN) { E(acc, cur, wr, wc, fr, fq); S.done(cur); }
        PG8_STAMP();
        if (!has_next) break;
#pragma unroll
        for (int a = 0; a < 2; ++a)
#pragma unroll
            for (int b = 0; b < 2; ++b)
#pragma unroll
                for (int m = 0; m < 4; ++m)
#pragma unroll
                    for (int n = 0; n < 2; ++n) acc[a][b][m][n] = (f32x4){0.f, 0.f, 0.f, 0.f};
        cur = nxt; cA = nA; cB = nB; ++ui;
    }
    PG8_WAIT_V(0);
    if (wr == 0) PG8_BAR;
    PG8_BAR;
    if constexpr (Epi::AFTER_DRAIN) { E.fused(acc, cur, wr, wc, fr, fq, lds, wid, lane); S.done(cur); }
    PG8_STAMP();
    if (STAMP && wid == 0) { stamps[lane] = lane < nts ? (((unsigned long long)(unsigned)ts_hi << 32) | (unsigned)ts_lo) : 0ull;
        if (lane == 62) stamps[62] = rt_entry; if (lane == 63) stamps[63] = (unsigned long long)wall_clock64(); }
#undef PG8_STAMP
#undef PG8_SA
#undef PG8_SB
#undef PG8_STAGE
#undef PG8_LDA
#undef PG8_LDB
#undef PG8_MMA
#undef PG8_WAIT_V
#undef PG8_WAIT_L
#undef PG8_BAR
#undef PG8_SCHED
}
}
#define XB_TMO      128
#define XB_XCNT(j)  (256  + 64 * (j))
#define XB_XSUB(j)  (1280 + 64 * (j))
#define XB_XGEN(j)  (2304 + 64 * (j))
#define XB_TOP      3328
#define XB_TOPGEN   3392
#define XCD_BAR_WORDS 3456
#define XB_SPIN_CAP (1u << 18)
#define LAS __attribute__((address_space(3)))

__device__ __forceinline__ unsigned xb_ld(unsigned* p)              { return __hip_atomic_load(p, __ATOMIC_RELAXED, __HIP_MEMORY_SCOPE_AGENT); }
__device__ __forceinline__ unsigned xb_add(unsigned* p, unsigned v) { return __hip_atomic_fetch_add(p, v, __ATOMIC_RELAXED, __HIP_MEMORY_SCOPE_AGENT); }
__device__ __forceinline__ unsigned xb_xcc_id() { return (unsigned)__builtin_amdgcn_s_getreg((3 << 11) | 20) & 0xFu; }
#define XB_SPIN(cond, bar) do { unsigned _sp = 0; while (cond) { __builtin_amdgcn_s_sleep(1); \
    if ((++_sp & 255u) == 0u) { if (xb_ld(&(bar)[XB_TMO])) break; if (_sp > XB_SPIN_CAP) { atomicAdd(&(bar)[XB_TMO], 1u); break; } } } } while (0)

struct XcdBarrier {
    unsigned* bar; unsigned x;
    volatile LAS unsigned* st;
};

__device__ __forceinline__ XcdBarrier xcd_barrier_post(unsigned* bar, volatile LAS unsigned* st) {
    XcdBarrier b; b.bar = bar; b.x = xb_xcc_id(); b.st = st;
    if (threadIdx.x == 0) (void)xb_add(&bar[XB_XCNT(b.x)], 1u);
    return b;
}
__device__ __forceinline__ void xcd_barrier_complete(unsigned* bar, unsigned x, unsigned& nloc, unsigned& nx) {
    const unsigned G = gridDim.x * gridDim.y * gridDim.z;
    unsigned sum, cnt, mine, sp = 0u;
    for (;;) {
        sum = 0u; cnt = 0u; mine = 0u;
#pragma unroll
        for (unsigned j = 0; j < 16; ++j) { const unsigned c = xb_ld(&bar[XB_XCNT(j)]); sum += c; cnt += (c > 0u) ? 1u : 0u; mine = (j == x) ? c : mine; }
        if (sum == G) break;
        __builtin_amdgcn_s_sleep(1);
        if ((++sp & 255u) == 0u) { if (xb_ld(&bar[XB_TMO])) break; if (sp > XB_SPIN_CAP) { atomicAdd(&bar[XB_TMO], 1u); break; } }
    }
    nloc = mine > 0u ? mine : 1u; nx = cnt > 0u ? cnt : 1u;
}

__device__ __forceinline__ void xcd_barrier(const XcdBarrier& b) {
    asm volatile("s_waitcnt vmcnt(0)" ::: "memory");
    __syncthreads();
    if (threadIdx.x == 0) {
        unsigned* bar = b.bar;
        __builtin_amdgcn_s_waitcnt(0);
        unsigned nloc = b.st[0], nx = b.st[1];
        if (nloc == 0u) { xcd_barrier_complete(bar, b.x, nloc, nx); b.st[0] = nloc; b.st[1] = nx; }
        const unsigned old = xb_add(&bar[XB_XSUB(b.x)], 1u);
        const unsigned gen = old / nloc;
        if (old + 1u == (gen + 1u) * nloc) {
            __builtin_amdgcn_fence(__ATOMIC_RELEASE, "agent");
            asm volatile("s_waitcnt vmcnt(0)" ::: "memory");
            const unsigned og = xb_add(&bar[XB_TOP], 1u);
            const unsigned tg = og / nx;
            if (og + 1u == (tg + 1u) * nx) xb_add(&bar[XB_TOPGEN], 1u);
            else XB_SPIN(xb_ld(&bar[XB_TOPGEN]) == tg, bar);
            __builtin_amdgcn_fence(__ATOMIC_ACQUIRE, "agent");
            xb_add(&bar[XB_XGEN(b.x)], 1u);
            asm volatile("s_waitcnt vmcnt(0)" ::: "memory");
        } else {
            XB_SPIN(xb_ld(&bar[XB_XGEN(b.x)]) == gen, bar);
            __builtin_amdgcn_fence(__ATOMIC_ACQUIRE, "agent");
            asm volatile("s_waitcnt vmcnt(0)" ::: "memory");
        }
    }
    __syncthreads();
}

constexpr int NTHR = 512, NWAVE = 8;
constexpr int TT = 16384, DM = 2048, SEQ = 4096, NBATCH = 4;
constexpr int GLA_N = 6160, GLA_NM = 6144;
constexpr int KV_N = 4112, KV_NM = 4096;
constexpr float RMS_EPS = 1e-6f;
constexpr int LDS_BYTES = 155648;

typedef pg8::bf16x8 bf16x8;
typedef pg8::f32x4 f32x4;
typedef pg8::u32x4 u32x4;

struct TMat { const float* src; bf16_t* dst; bf16_t* dst16; int N, Nmain, ntn, first; };
constexpr int NTMAT = 13;
struct Params {
    const float *x, *c, *ada_w, *ada_b, *norm_mix, *norm_ffn, *gla_w_in, *gla_wg2, *gla_bg2, *gla_norm, *gla_w_out, *kv_norm, *kv_ada_w, *kv_ada_b,
                *fox_w_kv, *fox_b_f, *fox_w_q, *fox_w_out, *peer_w_q, *peer_subk, *peer_u, *peer_v, *final_norm;
    float* out;
    unsigned* bar; float* mod; float* kvmod;
    bf16_t *Wt_in, *W16_in, *Wt_out, *Wt_kv, *W16_kv, *Wt_q, *Wt_fo, *Wt_pq, *subk, *U, *V;
    float* xbuf; bf16_t *h, *hk, *h2, *og, *pq; int* ids; float* wts; float* fl;
    bf16_t *proj, *qt, *khT, *vT, *Pm; float* dec; float* o;
    bf16_t *qb, *gb, *Kb, *Vb, *ob; float* Fa;
    TMat tm[NTMAT];
    int ntr_jobs, pad0;
};

__device__ __forceinline__ unsigned cvtpk(float lo, float hi) { unsigned r; asm("v_cvt_pk_bf16_f32 %0, %1, %2" : "=v"(r) : "v"(lo), "v"(hi)); return r; }
__device__ __forceinline__ float bflo(unsigned w) { return __uint_as_float(w << 16); }
__device__ __forceinline__ float bfhi(unsigned w) { return __uint_as_float(w & 0xffff0000u); }
__device__ __forceinline__ bf16_t f2bf(float f) { return (bf16_t)(cvtpk(f, f) & 0xffffu); }
__device__ __forceinline__ float wave_sum_shfl(float v) {
#pragma unroll
    for (int o = 32; o > 0; o >>= 1) v += __shfl_xor(v, o);
    return v;
}
template <int CTRL> __device__ __forceinline__ float dpp_f(float x) { return __builtin_bit_cast(float, __builtin_amdgcn_mov_dpp(__builtin_bit_cast(int, x), CTRL, 0xf, 0xf, true)); }
__device__ __forceinline__ float rdlane(float v, int l) { return __builtin_bit_cast(float, __builtin_amdgcn_readlane(__builtin_bit_cast(int, v), l)); }
__device__ __forceinline__ float wave_sum_dpp(float v) {
    v += dpp_f<0xB1>(v); v += dpp_f<0x4E>(v); v += dpp_f<0x141>(v); v += dpp_f<0x128>(v);
    return (rdlane(v, 0) + rdlane(v, 16)) + (rdlane(v, 32) + rdlane(v, 48));
}
__device__ __forceinline__ float dot2bf(unsigned a, unsigned b, float acc) { return __builtin_amdgcn_fdot2_f32_bf16(__builtin_bit_cast(bf16x2, a), __builtin_bit_cast(bf16x2, b), acc, false); }
__device__ __forceinline__ float log_sigmoidf(float z) { return fminf(z, 0.f) - log1pf(expf(-fabsf(z))); }
__device__ __forceinline__ float siluf(float z) { return z / (1.f + expf(-z)); }
__device__ __forceinline__ float sigmoidf_(float z) { return 1.f / (1.f + expf(-z)); }
__device__ __forceinline__ float gelu_tanh(float x) { const float u = 0.7978845608028654f * (x + 0.044715f * x * x * x); return 0.5f * x * (1.f + tanhf(u)); }
__device__ __forceinline__ u32x4 pack8f(const float (&v)[8]) { u32x4 w; w.x = cvtpk(v[0], v[1]); w.y = cvtpk(v[2], v[3]); w.z = cvtpk(v[4], v[5]); w.w = cvtpk(v[6], v[7]); return w; }
__device__ __forceinline__ void unpack8(const u32x4 w, float (&v)[8]) { v[0] = bflo(w.x); v[1] = bfhi(w.x); v[2] = bflo(w.y); v[3] = bfhi(w.y); v[4] = bflo(w.z); v[5] = bfhi(w.z); v[6] = bflo(w.w); v[7] = bfhi(w.w); }
#define MFMA16(a, b, c) __builtin_amdgcn_mfma_f32_16x16x32_bf16((a), (b), (c), 0, 0, 0)

constexpr int NGEMV = 208, NCONV = 2048 + 2048 + 16;
__device__ __forceinline__ void phase_prologue(const Params& p, unsigned char* lds) {
    const int tid = threadIdx.x, wid = tid >> 6, lane = tid & 63;
    float* cact = (float*)lds;
    float* red = (float*)(lds + 32768);
    float* tile = (float*)(lds + 65536);
    for (int i = tid; i < NBATCH * DM; i += NTHR) cact[i] = siluf(p.c[i]);
    __syncthreads();
    const int njobs = NGEMV + p.ntr_jobs + NCONV;
    for (int job = blockIdx.x; job < njobs; job += gridDim.x) {
        if (job < NGEMV) {
            const float* W; const float* bias; float* outp; int N, ostride, cb;
            if (job < 192) { const int l = job / 48; cb = job % 48; W = p.ada_w + (size_t)l * DM * 12288; bias = p.ada_b + l * 12288; outp = p.mod + (size_t)l * NBATCH * 12288; N = 12288; ostride = 12288; }
            else { cb = job - 192; W = p.kv_ada_w; bias = p.kv_ada_b; outp = p.kvmod; N = 4096; ostride = 4096; }
            const int col = cb * 256 + 4 * lane;
            f32x4 acc[4];
#pragma unroll
            for (int b = 0; b < 4; ++b) acc[b] = (f32x4){0.f, 0.f, 0.f, 0.f};
            const float* wp = W + (size_t)(wid * 256) * N + col;
#pragma unroll 8
            for (int k = 0; k < 256; ++k) {
                const f32x4 w4 = *(const f32x4*)(wp + (size_t)k * N);
#pragma unroll
                for (int b = 0; b < 4; ++b) acc[b] += cact[b * DM + wid * 256 + k] * w4;
            }
#pragma unroll
            for (int b = 0; b < 4; ++b) *(f32x4*)(red + (wid * 4 + b) * 256 + 4 * lane) = acc[b];
            __syncthreads();
#pragma unroll
            for (int i = 0; i < 2; ++i) { const int o = tid + NTHR * i, b = o >> 8, cl = o & 255; float s = bias[cb * 256 + cl];
#pragma unroll
                for (int ks = 0; ks < 8; ++ks) s += red[(ks * 4 + b) * 256 + cl];
                outp[(size_t)b * ostride + cb * 256 + cl] = s; }
            __syncthreads();
        } else if (job < NGEMV + p.ntr_jobs) {
            const int j = job - NGEMV; int m = 0;
#pragma unroll
            for (int q = 1; q < NTMAT; ++q) if (j >= p.tm[q].first) m = q;
            const TMat M = p.tm[m];
            const int r = j - M.first, kt = r / M.ntn, nt = r - kt * M.ntn;
#pragma unroll
            for (int i = 0; i < 2; ++i) { const int idx = tid + NTHR * i, rr = idx >> 4, c4 = idx & 15, n = nt * 64 + 4 * c4;
                f32x4 v = (f32x4){0.f, 0.f, 0.f, 0.f};
                if (n < M.N) v = *(const f32x4*)(M.src + (size_t)(kt * 64 + rr) * M.N + n);
                float* tp = tile + rr * 65 + 4 * c4; tp[0] = v[0]; tp[1] = v[1]; tp[2] = v[2]; tp[3] = v[3]; }
            __syncthreads();
            { const int nl = tid >> 3, ks = tid & 7, n = nt * 64 + nl; float v[8];
#pragma unroll
              for (int e = 0; e < 8; ++e) v[e] = tile[(8 * ks + e) * 65 + nl];
              const u32x4 w = pack8f(v);
              if (n < M.Nmain) *(u32x4*)(M.dst + (size_t)n * DM + kt * 64 + 8 * ks) = w;
              else if (n < M.N) *(u32x4*)(M.dst16 + (size_t)(n - M.Nmain) * DM + kt * 64 + 8 * ks) = w; }
            __syncthreads();
        } else {
            const int j = job - NGEMV - p.ntr_jobs; const float* src; bf16_t* dst; size_t base;
            if (j < 2048) { src = p.peer_u; dst = p.U; base = (size_t)j * 65536; }
            else if (j < 4096) { src = p.peer_v; dst = p.V; base = (size_t)(j - 2048) * 65536; }
            else { src = p.peer_subk; dst = p.subk; base = (size_t)(j - 4096) * 65536; }
#pragma unroll 4
            for (int i = 0; i < 16; ++i) { const size_t e = base + (size_t)(i * NTHR + tid) * 8;
                const f32x4 a = *(const f32x4*)(src + e), b = *(const f32x4*)(src + e + 4);
                u32x4 w; w.x = cvtpk(a[0], a[1]); w.y = cvtpk(a[2], a[3]); w.z = cvtpk(b[0], b[1]); w.w = cvtpk(b[2], b[3]);
                *(u32x4*)(dst + e) = w; }
        }
    }
}

template <bool TWO, bool FINAL>
__device__ __forceinline__ void phase_norm(const float* x, const float* g1, const float* sh1, const float* sc1, int ms1, bf16_t* out1,
                                           const float* g2, const float* sh2, const float* sc2, int ms2, bf16_t* out2, float* outf) {
    const int tid = threadIdx.x, wid = tid >> 6, lane = tid & 63;
    for (int row = blockIdx.x * NWAVE + wid; row < TT; row += gridDim.x * NWAVE) {
        const int b = row >> 12; const float* xr = x + (size_t)row * DM;
        f32x4 v[8]; float ss = 0.f;
#pragma unroll
        for (int i = 0; i < 4; ++i) { const int c = 8 * (lane + 64 * i); v[2 * i] = *(const f32x4*)(xr + c); v[2 * i + 1] = *(const f32x4*)(xr + c + 4); }
#pragma unroll
        for (int i = 0; i < 8; ++i) ss += v[i][0] * v[i][0] + v[i][1] * v[i][1] + v[i][2] * v[i][2] + v[i][3] * v[i][3];
        ss = wave_sum_shfl(ss);
        const float rs = rsqrtf(ss * (1.f / DM) + RMS_EPS);
#pragma unroll
        for (int i = 0; i < 4; ++i) { const int c = 8 * (lane + 64 * i);
            if constexpr (FINAL) {
                const f32x4 ga = *(const f32x4*)(g1 + c), gb = *(const f32x4*)(g1 + c + 4);
                *(f32x4*)(outf + (size_t)row * DM + c) = v[2 * i] * rs * ga; *(f32x4*)(outf + (size_t)row * DM + c + 4) = v[2 * i + 1] * rs * gb;
            } else {
                { const f32x4 ga = *(const f32x4*)(g1 + c), gb = *(const f32x4*)(g1 + c + 4);
                  const f32x4 sa = *(const f32x4*)(sc1 + (size_t)b * ms1 + c), sb = *(const f32x4*)(sc1 + (size_t)b * ms1 + c + 4);
                  const f32x4 ha = *(const f32x4*)(sh1 + (size_t)b * ms1 + c), hb = *(const f32x4*)(sh1 + (size_t)b * ms1 + c + 4);
                  const f32x4 ya = v[2 * i] * rs * ga * (1.f + sa) + ha, yb = v[2 * i + 1] * rs * gb * (1.f + sb) + hb;
                  u32x4 w; w.x = cvtpk(ya[0], ya[1]); w.y = cvtpk(ya[2], ya[3]); w.z = cvtpk(yb[0], yb[1]); w.w = cvtpk(yb[2], yb[3]);
                  *(u32x4*)(out1 + (size_t)row * DM + c) = w; }
                if constexpr (TWO) {
                  const f32x4 ga = *(const f32x4*)(g2 + c), gb = *(const f32x4*)(g2 + c + 4);
                  const f32x4 sa = *(const f32x4*)(sc2 + (size_t)b * ms2 + c), sb = *(const f32x4*)(sc2 + (size_t)b * ms2 + c + 4);
                  const f32x4 ha = *(const f32x4*)(sh2 + (size_t)b * ms2 + c), hb = *(const f32x4*)(sh2 + (size_t)b * ms2 + c + 4);
                  const f32x4 ya = v[2 * i] * rs * ga * (1.f + sa) + ha, yb = v[2 * i + 1] * rs * gb * (1.f + sb) + hb;
                  u32x4 w; w.x = cvtpk(ya[0], ya[1]); w.y = cvtpk(ya[2], ya[3]); w.z = cvtpk(yb[0], yb[1]); w.w = cvtpk(yb[2], yb[3]);
                  *(u32x4*)(out2 + (size_t)row * DM + c) = w; }
            }
        }
    }
}

__device__ __forceinline__ void mini16(const bf16_t* A  , const bf16_t* W16, float* gls) {
    const int tid = threadIdx.x, wid = tid >> 6, lane = tid & 63, fr = lane & 15, fq = lane >> 4, mt = wid & 3, kh = wid >> 2;
    f32x4 acc = (f32x4){0.f, 0.f, 0.f, 0.f};
    const bf16_t* ap = A + (size_t)(16 * mt + fr) * DM + kh * 1024 + 8 * fq;
    const bf16_t* bp = W16 + (size_t)fr * DM + kh * 1024 + 8 * fq;
#pragma unroll 8
    for (int ks = 0; ks < 32; ++ks) { const bf16x8 a = *(const bf16x8*)(ap + 32 * ks), b = *(const bf16x8*)(bp + 32 * ks); acc = MFMA16(a, b, acc); }
#pragma unroll
    for (int i = 0; i < 4; ++i) gls[(kh * 64 + 16 * mt + 4 * fq + i) * 16 + fr] = acc[i];
}

constexpr int PREP_GLS = 0, PREP_TOT = 8192, PREP_BLOC = 10240, PREP_X = 75776, PREP_Y = 109568, PREP_PS = 143360;
constexpr int XLD = 264, TLD = 72;
__device__ __forceinline__ void phase_gla_prep(const Params& p, int l, unsigned char* lds) {
    const int tid = threadIdx.x, wid = tid >> 6, lane = tid & 63, fr = lane & 15, fq = lane >> 4;
    float* gls = (float*)(lds + PREP_GLS); float* tot0 = (float*)(lds + PREP_TOT); float* bloc = (float*)(lds + PREP_BLOC);
    bf16_t* X = (bf16_t*)(lds + PREP_X); bf16_t* Y = (bf16_t*)(lds + PREP_Y); bf16_t* Ps = (bf16_t*)(lds + PREP_PS); bf16_t* TR = X;
    const float* wg2 = p.gla_wg2 + (size_t)l * 16 * 1024; const float* bg2 = p.gla_bg2 + l * 1024;
    const bf16_t* W16 = p.W16_in + (size_t)l * 16 * DM;
    for (int u = blockIdx.x; u < 256; u += gridDim.x) {
        const int tok0 = (u >> 6) * SEQ + (u & 63) * 64;
        mini16(p.h + (size_t)tok0 * DM, W16, gls);
        __syncthreads();
        for (int hd = 0; hd < 4; ++hd) {
            const size_t uh = (size_t)u * 4 + hd;
            { const int k = tid & 255, half = tid >> 8; float wg[16];
#pragma unroll
              for (int r = 0; r < 16; ++r) wg[r] = wg2[r * 1024 + hd * 256 + k];
              const float bg = bg2[hd * 256 + k]; float run = 0.f;
              for (int tt = 0; tt < 32; ++tt) { const int t = 32 * half + tt; float z = bg;
#pragma unroll
                  for (int r = 0; r < 16; ++r) z += (gls[t * 16 + r] + gls[(64 + t) * 16 + r]) * wg[r];
                  run += log_sigmoidf(z) * (1.f / 16.f); bloc[t * 256 + k] = run; }
              if (half == 0) tot0[k] = run; }
            __syncthreads();
            f32x4 Lacc[2];
#pragma unroll
            for (int pass = 0; pass < 2; ++pass) {
#pragma unroll
                for (int i = 0; i < 4; ++i) { const int idx = tid + NTHR * i, t = idx >> 5, g = idx & 31, k0 = 8 * g;
                    const bf16_t* pr = p.proj + (size_t)(tok0 + t) * GLA_NM + hd * 256 + k0;
                    float q8[8], k8[8]; unpack8(*(const u32x4*)pr, q8); unpack8(*(const u32x4*)(pr + 1024), k8);
                    float xo[8], yo[8];
#pragma unroll
                    for (int e = 0; e < 8; ++e) { const float bb = bloc[t * 256 + k0 + e] + (t >= 32 ? tot0[k0 + e] : 0.f);
                        const float ep = expf(bb), em = expf(-bb);
                        xo[e] = q8[e] * 0.0625f * (pass == 0 ? ep : em); yo[e] = k8[e] * (pass == 0 ? em : ep); }
                    const u32x4 xw = pack8f(xo), yw = pack8f(yo);
                    *(u32x4*)(X + t * XLD + k0) = xw; *(u32x4*)(Y + t * XLD + k0) = yw;
                    if (pass == 0) { const int G = g >> 2, a = g & 3, p1 = ((a & 1) << 4) | ((a >> 1) << 2);
                        bf16_t* qo = p.qt + (uh * 64 + t) * 256 + 32 * G + p1;
                        *(uint2*)qo = make_uint2(xw.x, xw.y); *(uint2*)(qo + 8) = make_uint2(xw.z, xw.w); } }
                __syncthreads();
#pragma unroll
                for (int j = 0; j < 2; ++j) { const int tt = 2 * wid + j, mt = tt >> 2, nt = tt & 3; f32x4 acc = (f32x4){0.f, 0.f, 0.f, 0.f};
#pragma unroll
                    for (int ks = 0; ks < 8; ++ks) { const bf16x8 a = *(const bf16x8*)(X + (16 * mt + fr) * XLD + 32 * ks + 8 * fq), b = *(const bf16x8*)(Y + (16 * nt + fr) * XLD + 32 * ks + 8 * fq);
                        acc = MFMA16(a, b, acc); }
                    if (pass == 0) Lacc[j] = acc;
                    else {
#pragma unroll
                        for (int i = 0; i < 4; ++i) { const int t = 16 * mt + 4 * fq + i, s = 16 * nt + fr; Ps[t * TLD + s] = f2bf(s <= t ? Lacc[j][i] : acc[i]); } } }
                __syncthreads();
            }
            { const int row = tid >> 3, seg = tid & 7; *(u32x4*)(p.Pm + (uh * 64 + row) * 64 + 8 * seg) = *(const u32x4*)(Ps + row * TLD + 8 * seg); }
#pragma unroll
            for (int i = 0; i < 4; ++i) { const int idx = tid + NTHR * i, t = idx >> 5, g = idx & 31, k0 = 8 * g;
                float k8[8]; unpack8(*(const u32x4*)(p.proj + (size_t)(tok0 + t) * GLA_NM + 1024 + hd * 256 + k0), k8);
#pragma unroll
                for (int e = 0; e < 8; ++e) { const float bend = bloc[63 * 256 + k0 + e] + tot0[k0 + e], bb = bloc[t * 256 + k0 + e] + (t >= 32 ? tot0[k0 + e] : 0.f);
                    TR[(k0 + e) * TLD + t] = f2bf(k8[e] * expf(bend - bb));
                    if (t == 0) p.dec[uh * 256 + k0 + e] = expf(bend); } }
            __syncthreads();
#pragma unroll
            for (int i = 0; i < 4; ++i) { const int idx = tid + NTHR * i, row = idx >> 3, seg = idx & 7;
                *(u32x4*)(p.khT + (uh * 256 + row) * 64 + 8 * seg) = *(const u32x4*)(TR + row * TLD + 8 * seg); }
            __syncthreads();
            for (int dh = 0; dh < 2; ++dh) {
#pragma unroll
                for (int i = 0; i < 4; ++i) { const int idx = tid + NTHR * i, t = idx >> 5, g = idx & 31, d0 = 8 * g;
                    const u32x4 w = *(const u32x4*)(p.proj + (size_t)(tok0 + t) * GLA_NM + 2048 + hd * 512 + dh * 256 + d0);
                    bf16_t* tp = TR + d0 * TLD + t;
                    tp[0] = (bf16_t)(w.x & 0xffffu); tp[TLD] = (bf16_t)(w.x >> 16); tp[2 * TLD] = (bf16_t)(w.y & 0xffffu); tp[3 * TLD] = (bf16_t)(w.y >> 16);
                    tp[4 * TLD] = (bf16_t)(w.z & 0xffffu); tp[5 * TLD] = (bf16_t)(w.z >> 16); tp[6 * TLD] = (bf16_t)(w.w & 0xffffu); tp[7 * TLD] = (bf16_t)(w.w >> 16); }
                __syncthreads();
#pragma unroll
                for (int i = 0; i < 4; ++i) { const int idx = tid + NTHR * i, row = idx >> 3, seg = idx & 7;
                    *(u32x4*)(p.vT + (uh * 512 + dh * 256 + row) * 64 + 8 * seg) = *(const u32x4*)(TR + row * TLD + 8 * seg); }
                __syncthreads();
            }
        }
    }
}

__device__ __forceinline__ void phase_gla_rec(const Params& p) {
    const int tid = threadIdx.x, wid = tid >> 6, lane = tid & 63, fr = lane & 15, fq = lane >> 4;
    for (int u = blockIdx.x + gridDim.x * wid; u < 512; u += gridDim.x * NWAVE) {
        const int b = u >> 7, hd = (u >> 5) & 3, d0 = (u & 31) * 16;
        f32x4 S[16];
#pragma unroll
        for (int kb = 0; kb < 16; ++kb) S[kb] = (f32x4){0.f, 0.f, 0.f, 0.f};
        for (int c = 0; c < 64; ++c) {
            const size_t uh = ((size_t)(b * 64 + c)) * 4 + hd;
            const bf16_t* qt = p.qt + uh * 64 * 256; const bf16_t* khT = p.khT + uh * 256 * 64; const bf16_t* vT = p.vT + (uh * 512 + d0) * 64;
            const bf16_t* Pm = p.Pm + uh * 64 * 64; const float* dec = p.dec + uh * 256;
            f32x4 acc[4];
#pragma unroll
            for (int mt = 0; mt < 4; ++mt) acc[mt] = (f32x4){0.f, 0.f, 0.f, 0.f};
            const bf16x8 bv0 = *(const bf16x8*)(vT + fr * 64 + 8 * fq), bv1 = *(const bf16x8*)(vT + fr * 64 + 32 + 8 * fq);
#pragma unroll
            for (int ks = 0; ks < 8; ++ks) {
                u32x4 w; w.x = cvtpk(S[2 * ks][0], S[2 * ks][1]); w.y = cvtpk(S[2 * ks][2], S[2 * ks][3]); w.z = cvtpk(S[2 * ks + 1][0], S[2 * ks + 1][1]); w.w = cvtpk(S[2 * ks + 1][2], S[2 * ks + 1][3]);
                const bf16x8 bs = __builtin_bit_cast(bf16x8, w);
#pragma unroll
                for (int mt = 0; mt < 4; ++mt) { const bf16x8 a = *(const bf16x8*)(qt + (16 * mt + fr) * 256 + 32 * ks + 8 * fq); acc[mt] = MFMA16(a, bs, acc[mt]); }
            }
#pragma unroll
            for (int mt = 0; mt < 4; ++mt) { const bf16x8 a0 = *(const bf16x8*)(Pm + (16 * mt + fr) * 64 + 8 * fq), a1 = *(const bf16x8*)(Pm + (16 * mt + fr) * 64 + 32 + 8 * fq);
                acc[mt] = MFMA16(a0, bv0, acc[mt]); acc[mt] = MFMA16(a1, bv1, acc[mt]); }
            float* op = p.o + (size_t)(b * SEQ + c * 64) * DM + hd * 512 + d0 + fr;
#pragma unroll
            for (int mt = 0; mt < 4; ++mt)
#pragma unroll
                for (int i = 0; i < 4; ++i) op[(size_t)(16 * mt + 4 * fq + i) * DM] = acc[mt][i];
#pragma unroll
            for (int kb = 0; kb < 16; ++kb) { const f32x4 dv = *(const f32x4*)(dec + 16 * kb + 4 * fq);
                const bf16x8 a0 = *(const bf16x8*)(khT + (16 * kb + fr) * 64 + 8 * fq), a1 = *(const bf16x8*)(khT + (16 * kb + fr) * 64 + 32 + 8 * fq);
                S[kb] = S[kb] * dv; S[kb] = MFMA16(a0, bv0, S[kb]); S[kb] = MFMA16(a1, bv1, S[kb]); }
        }
    }
}

__device__ __forceinline__ void phase_gla_onorm(const Params& p, int l) {
    const int tid = threadIdx.x, wid = tid >> 6, lane = tid & 63;
    const float* gn = p.gla_norm + l * 512 + 8 * lane;
    const f32x4 ga = *(const f32x4*)gn, gb = *(const f32x4*)(gn + 4);
    for (int row = blockIdx.x * NWAVE + wid; row < TT; row += gridDim.x * NWAVE) {
#pragma unroll
        for (int i = 0; i < 4; ++i) { const int c = 512 * i + 8 * lane;
            const f32x4 va = *(const f32x4*)(p.o + (size_t)row * DM + c), vb = *(const f32x4*)(p.o + (size_t)row * DM + c + 4);
            float g8[8]; unpack8(*(const u32x4*)(p.proj + (size_t)row * GLA_NM + 4096 + c), g8);
            float ss = va[0] * va[0] + va[1] * va[1] + va[2] * va[2] + va[3] * va[3] + vb[0] * vb[0] + vb[1] * vb[1] + vb[2] * vb[2] + vb[3] * vb[3];
            ss = wave_sum_shfl(ss);
            const float rs = rsqrtf(ss * (1.f / 512.f) + RMS_EPS);
            float y[8];
#pragma unroll
            for (int e = 0; e < 4; ++e) { y[e] = va[e] * rs * ga[e] * siluf(g8[e]); y[4 + e] = vb[e] * rs * gb[e] * siluf(g8[4 + e]); }
            *(u32x4*)(p.og + (size_t)row * DM + c) = pack8f(y); }
    }
}

constexpr int TK_SC = 0, TK_TL = 66048;
template <int N> __device__ __forceinline__ void top_insert(float (&L)[N], float v) {
#pragma unroll
    for (int j = N - 1; j >= 1; --j) L[j] = __builtin_amdgcn_fmed3f(L[j - 1], L[j], v);
    L[0] = fmaxf(L[0], v);
}
__device__ __forceinline__ void phase_peer_topk(const Params& p, int l, unsigned char* lds) {
    const int tid = threadIdx.x, wid = tid >> 6, lane = tid & 63, fr = lane & 15, fq = lane >> 4;
    float* sc = (float*)(lds + TK_SC); unsigned* tl = (unsigned*)(lds + TK_TL);
    for (int tile = blockIdx.x; tile < TT / 64; tile += gridDim.x) {
        const int tok0 = tile * 64;
        for (int hd = 0; hd < 8; ++hd) {
            { const int pp = wid >> 2, mt = wid & 3;
              const bf16_t* ap = p.pq + (size_t)(tok0 + 16 * mt + fr) * DM + hd * 256 + pp * 128 + 8 * fq;
              bf16x8 a[4];
#pragma unroll
              for (int ks = 0; ks < 4; ++ks) a[ks] = *(const bf16x8*)(ap + 32 * ks);
              const bf16_t* bp = p.subk + ((size_t)((l * 8 + hd) * 2 + pp) * 128 + fr) * 128 + 8 * fq;
#pragma unroll
              for (int nt = 0; nt < 8; ++nt) { f32x4 acc = (f32x4){0.f, 0.f, 0.f, 0.f};
#pragma unroll
                  for (int ks = 0; ks < 4; ++ks) { const bf16x8 b = *(const bf16x8*)(bp + (size_t)nt * 16 * 128 + 32 * ks); acc = MFMA16(a[ks], b, acc); }
#pragma unroll
                  for (int i = 0; i < 4; ++i) sc[(pp * 64 + 16 * mt + 4 * fq + i) * 129 + 16 * nt + fr] = acc[i]; } }
            __syncthreads();
            if (tid < 128) { const int pp = tid >> 6, t = tid & 63; const float* sp = sc + (pp * 64 + t) * 129;
                float L[16];
#pragma unroll
                for (int j = 0; j < 16; ++j) L[j] = -3.0e38f;
                for (int n = 0; n < 128; ++n) { const float v = __uint_as_float((__float_as_uint(sp[n]) & ~127u) | (unsigned)n); top_insert<16>(L, v); }
#pragma unroll
                for (int j = 0; j < 16; ++j) tl[(pp * 64 + t) * 16 + j] = __float_as_uint(L[j]); }
            __syncthreads();
            if (tid < 64) { const int t = tid; float a[16], b[16], M[16];
#pragma unroll
                for (int j = 0; j < 16; ++j) { a[j] = __uint_as_float(tl[t * 16 + j]); b[j] = __uint_as_float(tl[(64 + t) * 16 + j]); M[j] = -3.0e38f; }
#pragma unroll
                for (int i = 0; i < 16; ++i)
#pragma unroll
                    for (int j = 0; j < 16; ++j) if ((i + 1) * (j + 1) <= 16) { const float s = a[i] + b[j]; top_insert<16>(M, __uint_as_float((__float_as_uint(s) & ~255u) | (unsigned)(i * 16 + j))); }
                float e[16], sum = 0.f;
#pragma unroll
                for (int r = 0; r < 16; ++r) { e[r] = expf(M[r] - M[0]); sum += e[r]; }
                const float inv = 1.f / sum;
#pragma unroll
                for (int r = 0; r < 16; ++r) { const unsigned code = __float_as_uint(M[r]) & 255u; const unsigned ia = tl[t * 16 + (code >> 4)] & 127u, ib = tl[(64 + t) * 16 + (code & 15u)] & 127u;
                    p.ids[(size_t)(tok0 + t) * 128 + hd * 16 + r] = (int)(ia * 128u + ib); p.wts[(size_t)(tok0 + t) * 128 + hd * 16 + r] = e[r] * inv; } }
            __syncthreads();
        }
    }
}

__device__ __forceinline__ void phase_peer_gather(const Params& p, int l, const float* gate  ) {
    const int tid = threadIdx.x, wid = tid >> 6, lane = tid & 63;
    const bf16_t* Ut = p.U + (size_t)l * 16384 * DM + 8 * lane; const bf16_t* Vt = p.V + (size_t)l * 16384 * DM + 8 * lane;
    for (int tok = blockIdx.x * NWAVE + wid; tok < TT; tok += gridDim.x * NWAVE) {
        u32x4 hq[4];
#pragma unroll
        for (int i = 0; i < 4; ++i) hq[i] = *(const u32x4*)(p.h2 + (size_t)tok * DM + 512 * i + 8 * lane);
        const int id0 = p.ids[(size_t)tok * 128 + lane], id1 = p.ids[(size_t)tok * 128 + 64 + lane];
        const float w0 = p.wts[(size_t)tok * 128 + lane], w1 = p.wts[(size_t)tok * 128 + 64 + lane];
        float a0 = 0.f, a1 = 0.f;
#pragma unroll
        for (int kh = 0; kh < 2; ++kh) {
            const int idv = kh ? id1 : id0;
#pragma unroll 4
            for (int k = 0; k < 64; ++k) {
                const int e = __builtin_amdgcn_readlane(idv, k);
                const bf16_t* rp = Ut + (size_t)e * DM;
                float d0 = 0.f, d1 = 0.f, d2 = 0.f, d3 = 0.f;
#pragma unroll
                for (int i = 0; i < 4; ++i) { const u32x4 r = *(const u32x4*)(rp + 512 * i);
                    d0 = dot2bf(r.x, hq[i].x, d0); d1 = dot2bf(r.y, hq[i].y, d1); d2 = dot2bf(r.z, hq[i].z, d2); d3 = dot2bf(r.w, hq[i].w, d3); }
                const float tot = wave_sum_dpp((d0 + d1) + (d2 + d3));
                if (kh == 0) a0 = (lane == k) ? tot : a0; else a1 = (lane == k) ? tot : a1;
            }
        }
        const float c0 = w0 * gelu_tanh(a0), c1 = w1 * gelu_tanh(a1);
        float y[32];
#pragma unroll
        for (int j = 0; j < 32; ++j) y[j] = 0.f;
#pragma unroll
        for (int kh = 0; kh < 2; ++kh) {
            const int idv = kh ? id1 : id0; const float cv = kh ? c1 : c0;
#pragma unroll 4
            for (int k = 0; k < 64; ++k) {
                const int e = __builtin_amdgcn_readlane(idv, k);
                const float ck = __builtin_bit_cast(float, __builtin_amdgcn_readlane(__builtin_bit_cast(int, cv), k));
                const bf16_t* rp = Vt + (size_t)e * DM;
#pragma unroll
                for (int i = 0; i < 4; ++i) { const u32x4 r = *(const u32x4*)(rp + 512 * i);
                    y[8 * i + 0] += ck * bflo(r.x); y[8 * i + 1] += ck * bfhi(r.x); y[8 * i + 2] += ck * bflo(r.y); y[8 * i + 3] += ck * bfhi(r.y);
                    y[8 * i + 4] += ck * bflo(r.z); y[8 * i + 5] += ck * bfhi(r.z); y[8 * i + 6] += ck * bflo(r.w); y[8 * i + 7] += ck * bfhi(r.w); }
            }
        }
        const int b = tok >> 12;
#pragma unroll
        for (int i = 0; i < 4; ++i) { const int c = 512 * i + 8 * lane; float* xp = p.xbuf + (size_t)tok * DM + c; const float* gp = gate + (size_t)b * 12288 + c;
            const f32x4 xa = *(const f32x4*)xp, xb = *(const f32x4*)(xp + 4), ga = *(const f32x4*)gp, gb = *(const f32x4*)(gp + 4);
            *(f32x4*)xp = xa + ga * (f32x4){y[8 * i], y[8 * i + 1], y[8 * i + 2], y[8 * i + 3]};
            *(f32x4*)(xp + 4) = xb + gb * (f32x4){y[8 * i + 4], y[8 * i + 5], y[8 * i + 6], y[8 * i + 7]}; }
    }
}

__device__ __forceinline__ void phase_fl(const Params& p, unsigned char* lds) {
    const int tid = threadIdx.x; float* gls = (float*)lds;
    for (int u = blockIdx.x; u < 256; u += gridDim.x) {
        mini16(p.hk + (size_t)u * 64 * DM, p.W16_kv, gls);
        __syncthreads();
#pragma unroll
        for (int i = 0; i < 2; ++i) { const int o = tid + NTHR * i; p.fl[(size_t)u * 1024 + o] = gls[o] + gls[1024 + o]; }
        __syncthreads();
    }
}
__device__ __forceinline__ void phase_fscan(const Params& p) {
    const int tid = threadIdx.x, wid = tid >> 6, lane = tid & 63;
    for (int u = blockIdx.x * NWAVE + wid; u < 64; u += gridDim.x * NWAVE) {
        const int b = u >> 4, hd = u & 15; const float bf = p.fox_b_f[hd];
        const float* fp = p.fl + ((size_t)b * SEQ + 64 * lane) * 16 + hd;
        float tot = 0.f;
        for (int s = 0; s < 64; ++s) tot += log_sigmoidf(fp[(size_t)s * 16] + bf);
        float incl = tot;
#pragma unroll
        for (int d = 1; d < 64; d <<= 1) { const float n = __shfl_up(incl, d); if (lane >= d) incl += n; }
        float run = incl - tot;
        float* op = p.Fa + (size_t)u * SEQ + 64 * lane;
        for (int s = 0; s < 64; ++s) { run += log_sigmoidf(fp[(size_t)s * 16] + bf); op[s] = run * (-11.313708498984761f); }
    }
}
__device__ __forceinline__ void phase_fox_gate(const Params& p) {
    for (size_t e = ((size_t)blockIdx.x * NTHR + threadIdx.x) * 8; e < (size_t)TT * DM; e += (size_t)gridDim.x * NTHR * 8) {
        float o8[8], g8[8], y[8]; unpack8(*(const u32x4*)(p.ob + e), o8); unpack8(*(const u32x4*)(p.gb + e), g8);
#pragma unroll
        for (int j = 0; j < 8; ++j) y[j] = o8[j] * sigmoidf_(g8[j]);
        *(u32x4*)(p.og + e) = pack8f(y);
    }
}

namespace fa {
constexpr int D = 128, RS = 2048;
constexpr float SCALE = 0.08838834764831845f, THR = 8.f;
constexpr int NW = 8, QBLK = 32, KVBLK = 64, QB = NW * QBLK;
constexpr int SHM_V = KVBLK * D * 2, SHM_K = KVBLK * D * 2, SHM_A = KVBLK * 4;
constexpr int OFF_K = 2 * SHM_V, OFF_WS = 2 * SHM_V + 2 * SHM_K, OFF_A = OFF_WS + NW * 64 * 4, LDS_BYTES = OFF_A + 2 * SHM_A;
#define KSWZ(row, colB) ((row) * 256 + ((colB) ^ (((row) & 7) << 4)))
#define SBAR() __builtin_amdgcn_sched_barrier(0)
__device__ __forceinline__ int v_st(int k, int c) { const int kk = (k & ~0xC) | ((k & 4) << 1) | ((k & 8) >> 1); return ((kk >> 3) * 4 + (c >> 5)) * 512 + ((kk & 7) * 32 + (c & 31)) * 2; }
__device__ __forceinline__ int v_rd_base(int lane) { return ((lane & 3) << 3) | (((lane >> 2) & 3) << 6) | (((lane >> 4) & 1) << 5) | (((lane >> 5) & 1) << 8); }
constexpr int v_rd_off(int d0, int ks, int half) { return d0 * 512 + ks * 4096 + half * 2048; }
__device__ __forceinline__ int crow(int r, int hi) { return (r & 3) + 8 * (r >> 2) + 4 * hi; }
__device__ __forceinline__ unsigned cvtpkv(float lo, float hi) { unsigned r; asm volatile("v_cvt_pk_bf16_f32 %0, %1, %2" : "=v"(r) : "v"(lo), "v"(hi)); return r; }
__device__ __forceinline__ bf16x8 load8(const bf16_t* p) { return *reinterpret_cast<const bf16x8*>(p); }
__device__ __forceinline__ void mask_tile(f32x16& p0, f32x16& p1, int dq) {
    const float NEG = -__builtin_inff();
#pragma unroll
    for (int r = 0; r < 16; ++r) { const int c = (r & 3) + 8 * (r >> 2); if (dq - c < 0) p0[r] = NEG; if (dq - c - 32 < 0) p1[r] = NEG; }
}
__device__ __forceinline__ void partialSM(f32x16& p0, f32x16& p1, float& m_reg, float& mn, float& alpha) {
    float pmax = p0[0]; for (int r = 1; r < 16; ++r) pmax = fmaxf(pmax, p0[r]); for (int r = 0; r < 16; ++r) pmax = fmaxf(pmax, p1[r]);
    { auto rr = __builtin_amdgcn_permlane32_swap(__float_as_uint(pmax), __float_as_uint(pmax), false, false);
      pmax = fmaxf(__uint_as_float(rr[0]), __uint_as_float(rr[1])); }
    constexpr float C2 = 1.4426950408889634f * SCALE;
    if (__builtin_expect(__all((pmax - m_reg) * SCALE <= THR), 1)) { mn = m_reg; alpha = 1.f; }
    else { mn = fmaxf(m_reg, pmax); alpha = __builtin_amdgcn_exp2f((m_reg - mn) * C2); m_reg = mn; }
    const float mnL = -mn * C2;
    for (int r = 0; r < 16; ++r) p0[r] = fmaf(p0[r], C2, mnL); for (int r = 0; r < 16; ++r) p1[r] = fmaf(p1[r], C2, mnL);
    for (int r = 0; r < 16; ++r) p0[r] = __builtin_amdgcn_exp2f(p0[r]);
}
__device__ __forceinline__ void finishSM(f32x16& p0, f32x16& p1, float alpha, float& l_reg, bf16x8& pa0, bf16x8& pa1, bf16x8& pa2, bf16x8& pa3) {
    for (int r = 0; r < 16; ++r) p1[r] = __builtin_amdgcn_exp2f(p1[r]);
    float ps = 0; for (int r = 0; r < 16; ++r) ps += p0[r]; for (int r = 0; r < 16; ++r) ps += p1[r];
    { auto rr = __builtin_amdgcn_permlane32_swap(__float_as_uint(ps), __float_as_uint(ps), false, false);
      ps = __uint_as_float(rr[0]) + __uint_as_float(rr[1]); }
    l_reg = l_reg * alpha + ps;
#define PK4(P, B_, OUT) do { unsigned a0 = cvtpkv(P[B_+0], P[B_+1]), a1 = cvtpkv(P[B_+2], P[B_+3]);                          \
        unsigned b0 = cvtpkv(P[B_+4], P[B_+5]), b1 = cvtpkv(P[B_+6], P[B_+7]);                                             \
        auto r0 = __builtin_amdgcn_permlane32_swap(a0, b0, false, false); auto r1 = __builtin_amdgcn_permlane32_swap(a1, b1, false, false); \
        u32x4 w = {r0[0], r1[0], r0[1], r1[1]}; OUT = *reinterpret_cast<bf16x8*>(&w); } while (0)
    PK4(p0, 0, pa0); PK4(p0, 8, pa1); PK4(p1, 0, pa2); PK4(p1, 8, pa3);
#undef PK4
}
template <int KB>
__device__ __forceinline__ void qkt(f32x16& p0, f32x16& p1, const char* K_lds, int r32, int hi, const bf16x8* qr) {
    p0 = f32x16{}; p1 = f32x16{};
    const char* kb[4];
#pragma unroll
    for (int dd = 0; dd < 4; ++dd) kb[dd] = K_lds + KB * SHM_K + KSWZ(r32, (dd * 16 + hi * 8) * 2);
#pragma unroll
    for (int d0 = 0; d0 < 8; ++d0) { const char* a = kb[d0 & 3] + (d0 >> 2) * 128;
        bf16x8 b0 = *reinterpret_cast<const bf16x8*>(a);
        bf16x8 b1 = *reinterpret_cast<const bf16x8*>(a + 32 * 256);
        p0 = __builtin_amdgcn_mfma_f32_32x32x16_bf16(b0, qr[d0], p0, 0, 0, 0);
        p1 = __builtin_amdgcn_mfma_f32_32x32x16_bf16(b1, qr[d0], p1, 0, 0, 0); }
}
template <int VB>
__device__ __forceinline__ void pv_tile(f32x16* o, int vb0, bf16x8 pa0, bf16x8 pa1, bf16x8 pa2, bf16x8 pa3) {
#define TRRD(dst, off) asm volatile("ds_read_b64_tr_b16 %0, %1 offset:%2" : "=&v"(dst) : "v"(vb0), "i"(off) : "memory")
#define PV_D0(d0) do { constexpr int b_ = VB * SHM_V + v_rd_off(d0, 0, 0); \
        { s16x4 l0, l1, h0, h1; TRRD(l0, b_); TRRD(h0, b_ + 2048); TRRD(l1, b_ + 4096); TRRD(h1, b_ + 6144); \
          asm volatile("s_waitcnt lgkmcnt(0)" ::: "memory"); SBAR();   \
          o[d0] = __builtin_amdgcn_mfma_f32_32x32x16_bf16(pa0, (bf16x8){l0[0], l0[1], l0[2], l0[3], h0[0], h0[1], h0[2], h0[3]}, o[d0], 0, 0, 0);   \
          o[d0] = __builtin_amdgcn_mfma_f32_32x32x16_bf16(pa1, (bf16x8){l1[0], l1[1], l1[2], l1[3], h1[0], h1[1], h1[2], h1[3]}, o[d0], 0, 0, 0); } \
        { s16x4 l2, l3, h2, h3; TRRD(l2, b_ + 8192); TRRD(h2, b_ + 10240); TRRD(l3, b_ + 12288); TRRD(h3, b_ + 14336); \
          asm volatile("s_waitcnt lgkmcnt(0)" ::: "memory"); SBAR();   \
          o[d0] = __builtin_amdgcn_mfma_f32_32x32x16_bf16(pa2, (bf16x8){l2[0], l2[1], l2[2], l2[3], h2[0], h2[1], h2[2], h2[3]}, o[d0], 0, 0, 0);   \
          o[d0] = __builtin_amdgcn_mfma_f32_32x32x16_bf16(pa3, (bf16x8){l3[0], l3[1], l3[2], l3[3], h3[0], h3[1], h3[2], h3[3]}, o[d0], 0, 0, 0); } } while (0)
    PV_D0(0); PV_D0(1); PV_D0(2); PV_D0(3);
#undef PV_D0
#undef TRRD
}
struct Ptrs { const bf16_t* qb; const bf16_t* Kb; const bf16_t* Vb; const float* Fa; bf16_t* ob; };
struct BlockRef { unsigned qo, ko, fo; int P0; };
struct Seam { bf16x8 qr[8]; bf16x8 st_v0, st_v1, st_k0, st_k1; };
#define VMW() asm volatile("s_waitcnt vmcnt(0)" ::: "memory")
#define VMWN(n) asm volatile("s_waitcnt vmcnt(%0)" :: "i"(n) : "memory")
#define SLOAD_H(Kp, Vp, k0) do { const bf16_t* kt_ = (Kp) + (size_t)(k0) * RS; const bf16_t* vt_ = (Vp) + (size_t)(k0) * RS;                       \
        S.st_v0 = load8(vt_ + svo); S.st_v1 = load8(vt_ + 32 * RS + svo); S.st_k0 = load8(kt_ + svo); S.st_k1 = load8(kt_ + 32 * RS + svo); } while (0)
#define ALOAD(Fp, k0, bf) do { if (wid == 0) __builtin_amdgcn_global_load_lds((const unsigned*)((Fp) + (size_t)((k0) + lane)), (LAS unsigned*)(ldsl + OFF_A + (bf) * SHM_A), 4, 0, 0); } while (0)
#define SWRITE_HK(bf) do { *(bf16x8*)(K_lds + (bf) * SHM_K + kws) = S.st_k0; *(bf16x8*)(K_lds + (bf) * SHM_K + kws + 32 * 256) = S.st_k1; } while (0)
#define SWRITE_HV(bf) do { *(bf16x8*)(V_lds + (bf) * SHM_V + vst0) = S.st_v0; *(bf16x8*)(V_lds + (bf) * SHM_V + vst1) = S.st_v1; } while (0)
#define SWRITE_H(bf) do { SWRITE_HV(bf); SWRITE_HK(bf); } while (0)
__device__ __forceinline__ void attn_prime(const Ptrs& P, const BlockRef& cur, char* lds, LAS unsigned char* ldsl, Seam& S) {
    const int tid = threadIdx.x, wid = __builtin_amdgcn_readfirstlane(tid >> 6), lane = tid & 63, r32 = lane & 31, hi = lane >> 5;
    const int sr = tid >> 4, sc = (tid & 15) * 8, kws = KSWZ(sr, sc * 2); char* K_lds = lds + OFF_K;
    const unsigned svo = (unsigned)(sr * RS + sc), qvo = (unsigned)(r32 * RS + hi * 8);
    { const bf16_t* qw = P.qb + cur.qo + (size_t)(wid * QBLK) * RS;
      for (int d0 = 0; d0 < 8; ++d0) S.qr[d0] = load8(qw + qvo + d0 * 16); }
    SLOAD_H(P.Kb + cur.ko, P.Vb + cur.ko, 0); ALOAD(P.Fa + cur.fo, 0, 0); VMW(); SWRITE_HK(0);
    __syncthreads();
}
__device__ __forceinline__ void attn_block(const Ptrs& P, const BlockRef& cur, const BlockRef& nxt, char* lds, LAS unsigned char* ldsl, Seam& S) {
    const int tid = threadIdx.x, wid = __builtin_amdgcn_readfirstlane(tid >> 6), lane = tid & 63, r32 = lane & 31, hi = lane >> 5;
    const int NT = (cur.P0 + QB - 1) / KVBLK + 1;
    const int qlo = cur.P0 + wid * QBLK, qm = qlo + r32 - 4 * hi;
    char* V_lds = lds; char* K_lds = lds + OFF_K; const char* A_lds = lds + OFF_A;
    float* ws = (float*)(lds + OFF_WS) + wid * 64; float* li_l = ws, * al_l = ws + 32;
    float m_reg = -1e30f, l_reg = 0; f32x16 o[4] = {};
    const int sr = tid >> 4, sc = (tid & 15) * 8, vst0 = v_st(sr, sc), vst1 = v_st(32 + sr, sc), kws = KSWZ(sr, sc * 2);
    const unsigned svo = (unsigned)(sr * RS + sc), qvo = (unsigned)(r32 * RS + hi * 8);
    const int vb0 = (int)(uintptr_t)V_lds + v_rd_base(lane);
    const bf16_t* Kh = P.Kb + cur.ko; const bf16_t* Vh = P.Vb + cur.ko; const float* Fh = P.Fa + cur.fo;
#define RESC(a) do { if (__any((a) < 1.f)) { if (hi == 0) al_l[r32] = (a); asm volatile("s_waitcnt lgkmcnt(0)" ::: "memory");              \
                     for (int d_ = 0; d_ < 4; ++d_) for (int r = 0; r < 16; ++r) o[d_][r] *= al_l[crow(r, hi)]; } } while (0)
#define KBASE(t) ((t) * KVBLK)
#define ADDB(P0_, P1_, KB) do { const float* bp_ = (const float*)(A_lds + (KB) * SHM_A) + 4 * hi;                                      \
        _Pragma("unroll") for (int q_ = 0; q_ < 4; ++q_) { const f32x4 b0_ = *(const f32x4*)(bp_ + 8 * q_), b1_ = *(const f32x4*)(bp_ + 32 + 8 * q_); \
            _Pragma("unroll") for (int e_ = 0; e_ < 4; ++e_) { P0_[4 * q_ + e_] += b0_[e_]; P1_[4 * q_ + e_] += b1_[e_]; } } } while (0)
#define MASKT(P0_, P1_, t) do { const int kb_ = KBASE(t); if (kb_ + KVBLK - 1 > qlo) mask_tile(P0_, P1_, qm - kb_); } while (0)
    constexpr int NQL = 8;
#define SEAM_K0() do { VMWN(NQL); SWRITE_HK(0); SBAR(); } while (0)
    f32x16 pA0, pA1, pB0, pB1; float mnA, mnB, alA, alB; bf16x8 pa0, pa1, pa2, pa3;
    SWRITE_HV(0); SBAR();
    SLOAD_H(Kh, Vh, KBASE(1)); ALOAD(Fh, KBASE(1), 1);
    SBAR(); qkt<0>(pA0, pA1, K_lds, r32, hi, S.qr);
    ADDB(pA0, pA1, 0); MASKT(pA0, pA1, 0); partialSM(pA0, pA1, m_reg, mnA, alA);
    VMW(); SWRITE_H(1);
    __syncthreads();
#define HALF_STEP(PX0, PX1, mnX, alX, PY0, PY1, alY, t, KB, VB, SB) do {                                                      \
        SBAR(); qkt<KB>(PX0, PX1, K_lds, r32, hi, S.qr);                                                         \
        finishSM(PY0, PY1, alY, l_reg, pa0, pa1, pa2, pa3); SBAR();                                                           \
        if ((t) + 1 < NT) { SLOAD_H(Kh, Vh, KBASE((t) + 1)); ALOAD(Fh, KBASE((t) + 1), SB); SBAR(); }                         \
        pv_tile<VB>(o, vb0, pa0, pa1, pa2, pa3); ADDB(PX0, PX1, KB); MASKT(PX0, PX1, (t)); partialSM(PX0, PX1, m_reg, mnX, alX);                  \
        __syncthreads();                                                                                                      \
        if ((t) + 1 < NT) { VMW(); SWRITE_H(SB); }                                                                            \
        RESC(alX); __syncthreads(); } while (0)
    for (int t = 1; t + 1 < NT; t += 2) {
        HALF_STEP(pB0, pB1, mnB, alB, pA0, pA1, alA, t, 1, 0, 0);
        HALF_STEP(pA0, pA1, mnA, alA, pB0, pB1, alB, t + 1, 0, 1, 1);
    }
    const bool even = (NT & 1) == 0;
    if (even) { SBAR(); qkt<1>(pB0, pB1, K_lds, r32, hi, S.qr); SBAR(); }
    SLOAD_H(P.Kb + nxt.ko, P.Vb + nxt.ko, 0); ALOAD(P.Fa + nxt.fo, 0, 0); SBAR();
    { const bf16_t* qw = P.qb + nxt.qo + (size_t)(wid * QBLK) * RS;
#pragma unroll
      for (int d0 = 0; d0 < 8; ++d0) S.qr[d0] = load8(qw + qvo + d0 * 16); }
    SBAR();
    finishSM(pA0, pA1, alA, l_reg, pa0, pa1, pa2, pa3); SBAR();
    pv_tile<0>(o, vb0, pa0, pa1, pa2, pa3);
    if (even) { ADDB(pB0, pB1, 1); MASKT(pB0, pB1, NT - 1); partialSM(pB0, pB1, m_reg, mnB, alB); __syncthreads(); RESC(alB);
        finishSM(pB0, pB1, alB, l_reg, pa0, pa1, pa2, pa3); SBAR(); pv_tile<1>(o, vb0, pa0, pa1, pa2, pa3); }
    SBAR(); SEAM_K0();
    if (hi == 0) li_l[r32] = l_reg; asm volatile("s_waitcnt lgkmcnt(0)" ::: "memory");
    float rli[16];
#pragma unroll
    for (int r = 0; r < 16; ++r) rli[r] = __builtin_amdgcn_rcpf(li_l[crow(r, hi)]);
    bf16_t* Ow = P.ob + cur.qo + (size_t)(wid * QBLK) * RS;
    const unsigned ovo = (unsigned)(4 * hi * RS + r32);
#pragma unroll
    for (int r = 0; r < 16; ++r) { bf16_t* rowp = Ow + (size_t)((r & 3) + 8 * (r >> 2)) * RS;
#pragma unroll
        for (int d0 = 0; d0 < 4; ++d0) { const float v = o[d0][r] * rli[r]; const float vn = __shfl_xor(v, 1);
            if ((r32 & 1) == 0) *(unsigned*)(rowp + ovo + d0 * 32) = cvtpkv(v, vn); } }
    __syncthreads();
#undef RESC
#undef ADDB
#undef KBASE
#undef MASKT
#undef SEAM_K0
#undef HALF_STEP
}
#undef VMW
#undef VMWN
#undef SLOAD_H
#undef ALOAD
#undef SWRITE_HK
#undef SWRITE_HV
#undef SWRITE_H
__device__ __forceinline__ BlockRef make_ref(int bh, int qb) {
    const int b = bh >> 4, hd = bh & 15; BlockRef r;
    r.qo = (unsigned)((b * SEQ + qb * QB) * RS + hd * D); r.ko = (unsigned)(b * SEQ * RS + hd * D); r.fo = (unsigned)(bh * SEQ); r.P0 = qb * QB; return r;
}
__device__ __forceinline__ void attn_phase(LAS unsigned char* ldsl, const bf16_t* qb_, const bf16_t* Kb_, const bf16_t* Vb_, const float* Fa_, bf16_t* ob_) {
    char* lds = (char*)ldsl; const Ptrs p{qb_, Kb_, Vb_, Fa_, ob_};
    const int total = 64 * 8, stride = gridDim.x;
    int L = blockIdx.x; if (L >= total) return;
    int pass = 0;
    BlockRef cur = make_ref(L >> 3, L & 7);
    Seam S;
    attn_prime(p, cur, lds, ldsl, S);
    for (;;) {
        const bool more_pass = pass == 0, more_item = L + stride < total, last = !more_pass && !more_item;
        int passn = pass + 1, Ln = L;
        if (!more_pass) { passn = 0; Ln = more_item ? L + stride : L; }
        const BlockRef nxt = last ? cur : make_ref(Ln >> 3, passn ? 15 - (Ln & 7) : (Ln & 7));
        attn_block(p, cur, nxt, lds, ldsl, S);
        if (last) break;
        cur = nxt; pass = passn; L = Ln;
    }
}
}

constexpr int NSTEPS = 41;
__device__ __forceinline__ void gemm_bf16_nl(LAS unsigned char* smem, const bf16_t* A, const bf16_t* Bt, int N, bf16_t* O, int ldc, int split_cols, size_t split_stride) {
    pg8::Gemm g{A, Bt, TT, N, DM}; pg8::StaticOrder S; S.init(TT, N, (int)gridDim.x, (int)blockIdx.x);
    pg8::EpiBf16<0> E{O, ldc, nullptr, split_cols, split_stride};
    pg8::gemm_phase<pg8::EpiBf16<0>, pg8::StaticOrder, false>(smem, g, S, E, nullptr);
}
__device__ __forceinline__ void gemm_resid_nl(LAS unsigned char* smem, const bf16_t* A, const bf16_t* Bt, const float* xold, float* xnew, const float* gate) {
    pg8::Gemm g{A, Bt, TT, DM, DM}; pg8::StaticOrder S; S.init(TT, DM, (int)gridDim.x, (int)blockIdx.x);
    pg8::EpiResid E{xold, xnew, gate, 12288};
    pg8::gemm_phase<pg8::EpiResid, pg8::StaticOrder, false>(smem, g, S, E, nullptr);
}
template <unsigned PHASE_MASK>
__global__ void __launch_bounds__(NTHR, 2) trunk_kernel(Params p_unused, int lo, int hi) {
    extern __shared__ __attribute__((aligned(16))) unsigned char smem[];
    LAS unsigned char* sl = (LAS unsigned char*)smem;
    typedef const __attribute__((address_space(4))) Params* KP;
    KP kp0 = (KP)__builtin_amdgcn_kernarg_segment_ptr();
    XcdBarrier bar; bar.bar = kp0->bar; bar.x = 0; bar.st = nullptr;
    if (hi - lo > 1) {
        LAS unsigned* stw = (LAS unsigned*)(smem + LDS_BYTES - 16);
        if (threadIdx.x == 0) { stw[0] = 0u; stw[1] = 0u; stw[2] = 0u; stw[3] = 0u; }
        __syncthreads();
        bar = xcd_barrier_post(kp0->bar, (volatile LAS unsigned*)stw);
    }
    int step = 0;
#define EN(k) (((PHASE_MASK) >> (k)) & 1u)
#define RUN(kind, ...) do { if (step >= lo && step < hi) { if constexpr (EN(kind)) { KP kq = kp0; asm volatile("" : "+s"(kq)); const Params& p = *(const Params*)kq; __VA_ARGS__; } if (step + 1 < hi) xcd_barrier(bar); } ++step; } while (0)
    RUN(0, phase_prologue(p, smem));
    RUN(1, (phase_norm<false, false>(p.x, p.norm_mix, p.mod + 0, p.mod + 2048, 12288, p.h, nullptr, nullptr, nullptr, 0, nullptr, nullptr)));
    for (int l = 0; l < 2; ++l) {
        RUN(2, gemm_bf16_nl(sl, p.h, p.Wt_in + (size_t)l * GLA_NM * DM, GLA_NM, p.proj, GLA_NM, 0, 0));
        RUN(3, phase_gla_prep(p, l, smem));
        RUN(4, phase_gla_rec(p));
        RUN(5, phase_gla_onorm(p, l));
        RUN(6, gemm_resid_nl(sl, p.og, p.Wt_out + (size_t)l * DM * DM, l == 0 ? p.x : p.xbuf, p.xbuf, (p.mod + (size_t)l * NBATCH * 12288) + 4096));
        RUN(1, (phase_norm<false, false>(p.xbuf, p.norm_ffn + l * DM, (p.mod + (size_t)l * NBATCH * 12288) + 6144, (p.mod + (size_t)l * NBATCH * 12288) + 8192, 12288, p.h2, nullptr, nullptr, nullptr, 0, nullptr, nullptr)));
        RUN(2, gemm_bf16_nl(sl, p.h2, p.Wt_pq + (size_t)l * DM * DM, DM, p.pq, DM, 0, 0));
        RUN(7, phase_peer_topk(p, l, smem));
        RUN(8, phase_peer_gather(p, l, (p.mod + (size_t)l * NBATCH * 12288) + 10240));
        if (l == 0) RUN(1, (phase_norm<false, false>(p.xbuf, p.norm_mix + DM, (p.mod + (size_t)l * NBATCH * 12288) + NBATCH * 12288, (p.mod + (size_t)l * NBATCH * 12288) + NBATCH * 12288 + 2048, 12288, p.h, nullptr, nullptr, nullptr, 0, nullptr, nullptr)));
        else RUN(1, (phase_norm<true, false>(p.xbuf, p.kv_norm, p.kvmod, p.kvmod + 2048, 4096, p.hk, p.norm_mix + 2 * DM, (p.mod + (size_t)l * NBATCH * 12288) + NBATCH * 12288, (p.mod + (size_t)l * NBATCH * 12288) + NBATCH * 12288 + 2048, 12288, p.h, nullptr)));
    }
    RUN(2, { gemm_bf16_nl(sl, p.hk, p.Wt_kv, KV_NM, p.Kb, DM, DM, (size_t)TT * DM); __syncthreads(); if constexpr (EN(9)) phase_fl(p, smem); });
    for (int l = 2; l < 4; ++l) {
        RUN(2, { gemm_bf16_nl(sl, p.h, p.Wt_q + (size_t)(l - 2) * 4096 * DM, 4096, p.qb, DM, DM, (size_t)TT * DM); if constexpr (EN(10)) { if (l == 2) phase_fscan(p); } });
        RUN(11, fa::attn_phase(sl, p.qb, p.Kb, p.Vb, p.Fa, p.ob));
        RUN(12, phase_fox_gate(p));
        RUN(6, gemm_resid_nl(sl, p.og, p.Wt_fo + (size_t)(l - 2) * DM * DM, p.xbuf, p.xbuf, (p.mod + (size_t)l * NBATCH * 12288) + 4096));
        RUN(1, (phase_norm<false, false>(p.xbuf, p.norm_ffn + l * DM, (p.mod + (size_t)l * NBATCH * 12288) + 6144, (p.mod + (size_t)l * NBATCH * 12288) + 8192, 12288, p.h2, nullptr, nullptr, nullptr, 0, nullptr, nullptr)));
        RUN(2, gemm_bf16_nl(sl, p.h2, p.Wt_pq + (size_t)l * DM * DM, DM, p.pq, DM, 0, 0));
        RUN(7, phase_peer_topk(p, l, smem));
        RUN(8, phase_peer_gather(p, l, (p.mod + (size_t)l * NBATCH * 12288) + 10240));
        if (l == 2) RUN(1, (phase_norm<false, false>(p.xbuf, p.norm_mix + 3 * DM, (p.mod + (size_t)l * NBATCH * 12288) + NBATCH * 12288, (p.mod + (size_t)l * NBATCH * 12288) + NBATCH * 12288 + 2048, 12288, p.h, nullptr, nullptr, nullptr, 0, nullptr, nullptr)));
        else RUN(1, (phase_norm<false, true>(p.xbuf, p.final_norm, nullptr, nullptr, 0, nullptr, nullptr, nullptr, nullptr, 0, nullptr, p.out)));
    }
#undef RUN
}

#ifndef N_LAUNCH_MODE
#define N_LAUNCH_MODE 0
#define NSTEPS_RUN 41
#endif
__global__ void __launch_bounds__(NTHR, 2) attn_kernel(const bf16_t* qb_, const bf16_t* Kb_, const bf16_t* Vb_, const float* Fa_, bf16_t* ob_) {
    extern __shared__ __attribute__((aligned(16))) unsigned char smem[];
    fa::attn_phase((LAS unsigned char*)smem, qb_, Kb_, Vb_, Fa_, ob_);
}
template <unsigned M> static bool set_attr() { return hipFuncSetAttribute((const void*)trunk_kernel<M>, hipFuncAttributeMaxDynamicSharedMemorySize, LDS_BYTES) == hipSuccess; }
extern "C" void kernel_launch(void* const* d_in, const int* in_sizes, int n_in, void* d_out, int out_size, void* d_ws, size_t ws_size, hipStream_t stream) {
    static int grid = 0;
    if (grid == 0) {
        int dev = 0, cus = 0;
        if (hipGetDevice(&dev) != hipSuccess || hipDeviceGetAttribute(&cus, hipDeviceAttributeMultiprocessorCount, dev) != hipSuccess || cus <= 0) cus = 256;
        bool ok = true;
#if N_LAUNCH_MODE == 1
        ok = set_attr<0xffffffffu>();
#else
        ok = set_attr<1u << 0>() && set_attr<1u << 1>() && set_attr<(1u << 2) | (1u << 9) | (1u << 10)>() && set_attr<1u << 3>() && set_attr<1u << 4>() && set_attr<1u << 5>() && set_attr<1u << 6>() &&
             set_attr<1u << 7>() && set_attr<1u << 8>() && set_attr<1u << 12>() &&
             hipFuncSetAttribute((const void*)attn_kernel, hipFuncAttributeMaxDynamicSharedMemorySize, LDS_BYTES) == hipSuccess;
#endif
        if (!ok) { fprintf(stderr, "kernel_launch: hipFuncSetAttribute failed\n"); grid = -1; return; }
        (void)hipGetLastError();
        grid = cus;
    }
    if (grid < 0 || n_in != 23) return;
    Params p{};
    const float* const* in = (const float* const*)d_in;
    p.x = in[0]; p.c = in[1]; p.ada_w = in[2]; p.ada_b = in[3]; p.norm_mix = in[4]; p.norm_ffn = in[5]; p.gla_w_in = in[6]; p.gla_wg2 = in[7]; p.gla_bg2 = in[8]; p.gla_norm = in[9];
    p.gla_w_out = in[10]; p.kv_norm = in[11]; p.kv_ada_w = in[12]; p.kv_ada_b = in[13]; p.fox_w_kv = in[14]; p.fox_b_f = in[15]; p.fox_w_q = in[16]; p.fox_w_out = in[17];
    p.peer_w_q = in[18]; p.peer_subk = in[19]; p.peer_u = in[20]; p.peer_v = in[21]; p.final_norm = in[22];
    p.out = (float*)d_out;
    unsigned char* ws = (unsigned char*)d_ws; size_t off = 0;
    auto take = [&](size_t bytes) { unsigned char* r = ws + off; off += (bytes + 255) & ~(size_t)255; return r; };
    p.bar = (unsigned*)take(16384);
    p.mod = (float*)take((size_t)4 * NBATCH * 12288 * 4); p.kvmod = (float*)take((size_t)NBATCH * 4096 * 4);
    p.Wt_in = (bf16_t*)take((size_t)2 * GLA_NM * DM * 2); p.W16_in = (bf16_t*)take((size_t)2 * 16 * DM * 2);
    p.Wt_out = (bf16_t*)take((size_t)2 * DM * DM * 2); p.Wt_kv = (bf16_t*)take((size_t)KV_NM * DM * 2); p.W16_kv = (bf16_t*)take((size_t)16 * DM * 2);
    p.Wt_q = (bf16_t*)take((size_t)2 * 4096 * DM * 2); p.Wt_fo = (bf16_t*)take((size_t)2 * DM * DM * 2); p.Wt_pq = (bf16_t*)take((size_t)4 * DM * DM * 2);
    p.subk = (bf16_t*)take((size_t)4 * 8 * 2 * 128 * 128 * 2);
    p.U = (bf16_t*)take((size_t)4 * 16384 * DM * 2); p.V = (bf16_t*)take((size_t)4 * 16384 * DM * 2);
    p.xbuf = (float*)take((size_t)TT * DM * 4);
    p.h = (bf16_t*)take((size_t)TT * DM * 2); p.hk = (bf16_t*)take((size_t)TT * DM * 2); p.h2 = (bf16_t*)take((size_t)TT * DM * 2);
    p.og = (bf16_t*)take((size_t)TT * DM * 2); p.pq = (bf16_t*)take((size_t)TT * DM * 2);
    p.ids = (int*)take((size_t)TT * 128 * 4); p.wts = (float*)take((size_t)TT * 128 * 4); p.fl = (float*)take((size_t)TT * 16 * 4);
    const size_t region = off;
    p.proj = (bf16_t*)take((size_t)TT * GLA_NM * 2); p.qt = (bf16_t*)take((size_t)TT * 1024 * 2); p.khT = (bf16_t*)take((size_t)TT * 1024 * 2);
    p.vT = (bf16_t*)take((size_t)TT * DM * 2); p.Pm = (bf16_t*)take((size_t)TT * 4 * 64 * 2); p.dec = (float*)take((size_t)1024 * 256 * 4); p.o = (float*)take((size_t)TT * DM * 4);
    const size_t end_gla = off; off = region;
    p.qb = (bf16_t*)take((size_t)TT * DM * 2); p.gb = (bf16_t*)take((size_t)TT * DM * 2); p.Kb = (bf16_t*)take((size_t)TT * DM * 2); p.Vb = (bf16_t*)take((size_t)TT * DM * 2);
    p.ob = (bf16_t*)take((size_t)TT * DM * 2); p.Fa = (float*)take((size_t)64 * SEQ * 4);
    const size_t end_all = off > end_gla ? off : end_gla;
    if (end_all > ws_size) { fprintf(stderr, "kernel_launch: workspace too small: need %zu have %zu\n", end_all, ws_size); return; }
    { int first = 0, m = 0;
      auto add = [&](const float* src, bf16_t* dst, bf16_t* dst16, int N, int Nmain) { TMat& t = p.tm[m++]; t.src = src; t.dst = dst; t.dst16 = dst16; t.N = N; t.Nmain = Nmain; t.ntn = (N + 63) / 64; t.first = first; first += 32 * t.ntn; };
      for (int l = 0; l < 2; ++l) add(p.gla_w_in + (size_t)l * DM * GLA_N, p.Wt_in + (size_t)l * GLA_NM * DM, p.W16_in + (size_t)l * 16 * DM, GLA_N, GLA_NM);
      for (int l = 0; l < 2; ++l) add(p.gla_w_out + (size_t)l * DM * DM, p.Wt_out + (size_t)l * DM * DM, nullptr, DM, DM);
      add(p.fox_w_kv, p.Wt_kv, p.W16_kv, KV_N, KV_NM);
      for (int l = 0; l < 2; ++l) add(p.fox_w_q + (size_t)l * DM * 4096, p.Wt_q + (size_t)l * 4096 * DM, nullptr, 4096, 4096);
      for (int l = 0; l < 2; ++l) add(p.fox_w_out + (size_t)l * DM * DM, p.Wt_fo + (size_t)l * DM * DM, nullptr, DM, DM);
      for (int l = 0; l < 4; ++l) add(p.peer_w_q + (size_t)l * DM * DM, p.Wt_pq + (size_t)l * DM * DM, nullptr, DM, DM);
      p.ntr_jobs = first; p.pad0 = 0; }
    (void)hipMemsetAsync(p.bar, 0, 16384, stream);
#if N_LAUNCH_MODE == 1
    hipLaunchKernelGGL(trunk_kernel<0xffffffffu>, dim3(grid), dim3(NTHR), LDS_BYTES, stream, p, 0, NSTEPS);
#else
    {
        int kinds[NSTEPS]; int n = 0; kinds[n++] = 0; kinds[n++] = 1;
        for (int l = 0; l < 2; ++l) { const int k[10] = {2, 3, 4, 5, 6, 1, 2, 7, 8, 1}; for (int i = 0; i < 10; ++i) kinds[n++] = k[i]; }
        kinds[n++] = 2;
        for (int l = 2; l < 4; ++l) { const int k[9] = {2, 11, 12, 6, 1, 2, 7, 8, 1}; for (int i = 0; i < 9; ++i) kinds[n++] = k[i]; }
#ifndef NSTEPS_RUN
#define NSTEPS_RUN NSTEPS
#endif
        for (int s = 0; s < NSTEPS_RUN; ++s) {
            switch (kinds[s]) {
                case 0: hipLaunchKernelGGL(trunk_kernel<1u << 0>, dim3(grid), dim3(NTHR), LDS_BYTES, stream, p, s, s + 1); break;
                case 1: hipLaunchKernelGGL(trunk_kernel<1u << 1>, dim3(grid), dim3(NTHR), LDS_BYTES, stream, p, s, s + 1); break;
                case 2: hipLaunchKernelGGL(trunk_kernel<(1u << 2) | (1u << 9) | (1u << 10)>, dim3(grid), dim3(NTHR), LDS_BYTES, stream, p, s, s + 1); break;
                case 3: hipLaunchKernelGGL(trunk_kernel<1u << 3>, dim3(grid), dim3(NTHR), LDS_BYTES, stream, p, s, s + 1); break;
                case 4: hipLaunchKernelGGL(trunk_kernel<1u << 4>, dim3(grid), dim3(NTHR), LDS_BYTES, stream, p, s, s + 1); break;
                case 5: hipLaunchKernelGGL(trunk_kernel<1u << 5>, dim3(grid), dim3(NTHR), LDS_BYTES, stream, p, s, s + 1); break;
                case 6: hipLaunchKernelGGL(trunk_kernel<1u << 6>, dim3(grid), dim3(NTHR), LDS_BYTES, stream, p, s, s + 1); break;
                case 7: hipLaunchKernelGGL(trunk_kernel<1u << 7>, dim3(grid), dim3(NTHR), LDS_BYTES, stream, p, s, s + 1); break;
                case 8: hipLaunchKernelGGL(trunk_kernel<1u << 8>, dim3(grid), dim3(NTHR), LDS_BYTES, stream, p, s, s + 1); break;
                case 11: hipLaunchKernelGGL(attn_kernel, dim3(grid), dim3(NTHR), LDS_BYTES, stream, (const bf16_t*)p.qb, (const bf16_t*)p.Kb, (const bf16_t*)p.Vb, (const float*)p.Fa, p.ob); break;
                default: hipLaunchKernelGGL(trunk_kernel<1u << 12>, dim3(grid), dim3(NTHR), LDS_BYTES, stream, p, s, s + 1); break;
            }
        }
    }
#endif
    const hipError_t le = hipPeekAtLastError();
    if (le != hipSuccess) fprintf(stderr, "kernel_launch: launch failed: %s\n", hipGetErrorName(le));
}
```

```cpp
#include <hip/hip_runtime.h>
#include <stdint.h>
#include <stdio.h>

#define LAS __attribute__((address_space(3)))
typedef unsigned short bf16_t;
typedef float f32x16 __attribute__((ext_vector_type(16)));
typedef float fl2 __attribute__((ext_vector_type(2)));
typedef short s16x4 __attribute__((ext_vector_type(4)));
typedef __bf16 bf16x2 __attribute__((ext_vector_type(2)));

__device__ __forceinline__ int ltid(int wv) { unsigned m = ~0u; asm volatile("" : "+s"(m)); return (wv << 6) | (int)__builtin_amdgcn_mbcnt_hi(m, __builtin_amdgcn_mbcnt_lo(m, 0u)); }

__device__ __forceinline__ int lbid() { int b = (int)blockIdx.x; asm volatile("" : "+s"(b)); return b; }
__device__ __forceinline__ int lgrid() { int g = (int)gridDim.x; asm volatile("" : "+s"(g)); return g; }

namespace pg8 {
#define PG8_LAS __attribute__((address_space(3)))
typedef unsigned short bf16_t;
typedef short bf16x8 __attribute__((ext_vector_type(8)));
typedef float f32x4 __attribute__((ext_vector_type(4)));
typedef unsigned u32x4 __attribute__((ext_vector_type(4)));
constexpr int BM = 256, BK = 64, HALF = 128, HTB = HALF * BK * 2  , STAGE_BYTES = 8 * HTB, NXCD = 8, WGM = 8;

__host__ __device__ __forceinline__ int lds_byte(int r, int c) { const int st = (r >> 4) * 2 + (c >> 5), rr = r & 15, cc = c & 31, ob = rr * 64 + cc * 2; return st * 1024 + (ob ^ (((ob >> 9) & 1) << 5)); }
__host__ __device__ __forceinline__ void stage_rc(int b, int& R, int& C) { const int st = b / 1024, sb = b % 1024, swz = sb ^ (((sb >> 9) & 1) << 5); R = (st >> 1) * 16 + swz / 64; C = (st & 1) * 32 + (swz % 64) / 2; }
__host__ __device__ __forceinline__ int perm32(int rho) { const int n = rho >> 4, i = rho & 15; return 8 * (i >> 2) + 4 * n + (i & 3); }

struct Unit { int pm, pn; };
struct Gemm { const bf16_t* A; const bf16_t* Bt; int M, N, K; };

struct StaticOrder {
    int nM, nN, nwg, G, c;
    __host__ __device__ void init(int M, int N, int G_, int c_) { nM = M / BM; nN = N / BM; nwg = nM * nN; G = G_; c = c_; }
    __host__ __device__ bool next(int i, Unit& u) const {
        const long L = (long)i * G + c; if (L >= nwg) return false;
        int wgid = (int)L; { const int q = nwg / NXCD, r = nwg % NXCD, xcd = wgid % NXCD, off = wgid / NXCD; wgid = (xcd < r ? xcd * (q + 1) : r * (q + 1) + (xcd - r) * q) + off; }
        const int nig = WGM * nN, gid = wgid / nig, fm = gid * WGM, gsz = (nM - fm) < WGM ? (nM - fm) : WGM;
        u.pm = fm + ((wgid % nig) % gsz); u.pn = (wgid % nig) / gsz; return true;
    }
    __device__ __forceinline__ void a_ready(const Unit&) const {}
    __device__ __forceinline__ void done(const Unit&) const {}
};
struct CountedOrder : StaticOrder {
    const unsigned* ready; unsigned need; unsigned* tmo;
    __device__ __forceinline__ void a_ready(const Unit& u) const {
        if (threadIdx.x < 64) {
            const unsigned long long t0 = __builtin_amdgcn_s_memrealtime(); unsigned polls = 0;
            while ((unsigned)__builtin_amdgcn_readfirstlane(__hip_atomic_load(ready + 64 * u.pm, __ATOMIC_RELAXED, __HIP_MEMORY_SCOPE_AGENT)) < need) {
                if ((++polls & 255u) == 0u && __builtin_amdgcn_readfirstlane(__hip_atomic_load(tmo, __ATOMIC_RELAXED, __HIP_MEMORY_SCOPE_AGENT)) != 0u) break;
                if (__builtin_amdgcn_s_memrealtime() - t0 > 2000000ull) {
                    if (threadIdx.x == 0) { unsigned expect = 0u; __hip_atomic_compare_exchange_strong(tmo + 1, &expect, 0x600u | (unsigned)(u.pm & 0xff), __ATOMIC_RELAXED, __ATOMIC_RELAXED, __HIP_MEMORY_SCOPE_AGENT); __hip_atomic_store(tmo, 1u, __ATOMIC_RELAXED, __HIP_MEMORY_SCOPE_AGENT); }
                    break; }
                __builtin_amdgcn_s_sleep(2); }
            __builtin_amdgcn_fence(__ATOMIC_ACQUIRE, "agent");
            asm volatile("s_waitcnt vmcnt(0)" ::: "memory");
        }
#if !defined(BROKEN_HOOK_NO_BARRIER)
        asm volatile("" ::: "memory"); __builtin_amdgcn_s_barrier(); asm volatile("" ::: "memory");
#endif
    }
};

__device__ __forceinline__ unsigned cvt_pk_bf16(float lo, float hi) { unsigned r; asm volatile("v_cvt_pk_bf16_f32 %0, %1, %2" : "=v"(r) : "v"(lo), "v"(hi)); return r; }
typedef float f32x2 __attribute__((ext_vector_type(2)));
__device__ __forceinline__ f32x2 gelu_pk(f32x2 v) {
    const f32x2 av = __builtin_elementwise_abs(v), d = av * 0.2316418882f + 1.0f;
    f32x2 t; t.x = __builtin_amdgcn_rcpf(d.x); t.y = __builtin_amdgcn_rcpf(d.y);
    f32x2 q = t * 0.5307027145f + (-0.7265760135f); q = q * t + 0.7107068705f; q = q * t + (-0.142248368f); q = q * t + 0.127414796f; q = q * t;
    const f32x2 s = (v * v) * (-0.72134752044f);
    f32x2 e; e.x = __builtin_amdgcn_exp2f(s.x); e.y = __builtin_amdgcn_exp2f(s.y);
    const f32x2 m = v * (q * e), r = v - m;
    f32x2 o; o.x = v.x < 0.f ? m.x : r.x; o.y = v.y < 0.f ? m.y : r.y; return o;
}

struct EpiF32 {
    static constexpr bool PERM = false, AFTER_DRAIN = false;
    float* C; int ldc; const float* bias;
    __device__ __forceinline__ void operator()(const f32x4 (&acc)[2][2][4][2], const Unit& u, int wr, int wc, int fr, int fq) const {
        const int row0 = u.pm * BM + wr * 64 + fr, col0 = u.pn * BM + wc * 32 + 4 * fq;
        f32x4 bv[2][2];
#pragma unroll
        for (int bj = 0; bj < 2; ++bj)
#pragma unroll
            for (int n = 0; n < 2; ++n) bv[bj][n] = bias ? *(const f32x4*)(bias + col0 + bj * HALF + n * 16) : (f32x4){0.f, 0.f, 0.f, 0.f};
#pragma unroll
        for (int ai = 0; ai < 2; ++ai)
#pragma unroll
            for (int m = 0; m < 4; ++m) { float* rowp = C + (size_t)(row0 + ai * HALF + m * 16) * ldc + col0;
#pragma unroll
                for (int bj = 0; bj < 2; ++bj)
#pragma unroll
                    for (int n = 0; n < 2; ++n) *(f32x4*)(rowp + bj * HALF + n * 16) = acc[ai][bj][m][n] + bv[bj][n]; }
    }
};
template <int ACT  > struct EpiBf16 {
    static constexpr bool PERM = true, AFTER_DRAIN = false;
    bf16_t* O; int ldc; const float* bias; int split_cols; size_t split_stride;
    __device__ __forceinline__ void operator()(const f32x4 (&acc)[2][2][4][2], const Unit& u, int wr, int wc, int fr, int fq) const {
        const int row0 = u.pm * BM + wr * 64 + fr; int colt = u.pn * BM; bf16_t* base = O;
        if (split_cols) { const int t = colt / split_cols; base += (size_t)t * split_stride; colt -= t * split_cols; }
        const int col0 = colt + wc * 32 + 8 * fq, bcol0 = u.pn * BM + wc * 32 + 8 * fq;
        f32x4 bv[2][2];
#pragma unroll
        for (int bj = 0; bj < 2; ++bj)
#pragma unroll
            for (int n = 0; n < 2; ++n) bv[bj][n] = bias ? *(const f32x4*)(bias + bcol0 + bj * HALF + 4 * n) : (f32x4){0.f, 0.f, 0.f, 0.f};
#pragma unroll
        for (int ai = 0; ai < 2; ++ai)
#pragma unroll
            for (int m = 0; m < 4; ++m) { bf16_t* rowp = base + (size_t)(row0 + ai * HALF + m * 16) * ldc + col0;
#pragma unroll
                for (int bj = 0; bj < 2; ++bj) { f32x4 v0 = acc[ai][bj][m][0] + bv[bj][0], v1 = acc[ai][bj][m][1] + bv[bj][1];
                    if (ACT == 1) { f32x2 a = gelu_pk((f32x2){v0[0], v0[1]}), b = gelu_pk((f32x2){v0[2], v0[3]}), c = gelu_pk((f32x2){v1[0], v1[1]}), d = gelu_pk((f32x2){v1[2], v1[3]});
                        v0 = (f32x4){a.x, a.y, b.x, b.y}; v1 = (f32x4){c.x, c.y, d.x, d.y}; }
                    if (ACT == 2) {
#pragma unroll
                        for (int j = 0; j < 4; ++j) { v0[j] = 0.5f * v0[j] * (1.0f + erff(v0[j] * 0.70710678f)); v1[j] = 0.5f * v1[j] * (1.0f + erff(v1[j] * 0.70710678f)); } }
                    u32x4 w; w.x = cvt_pk_bf16(v0[0], v0[1]); w.y = cvt_pk_bf16(v0[2], v0[3]); w.z = cvt_pk_bf16(v1[0], v1[1]); w.w = cvt_pk_bf16(v1[2], v1[3]);
                    *(u32x4*)(rowp + bj * HALF) = w; } }
    }
};
struct EpiResid {
    static constexpr bool PERM = false, AFTER_DRAIN = false;
    const void* xold; int xold_f32; bf16_t* xnew; const float* gate; int gstride;
    __device__ __forceinline__ void operator()(const f32x4 (&acc)[2][2][4][2], const Unit& u, int wr, int wc, int fr, int fq) const {
        const int row0 = u.pm * BM + wr * 64 + fr, col0 = u.pn * BM + wc * 32 + 4 * fq;
        const float* gp = gate + (size_t)((u.pm * BM) >> 12) * gstride + col0;
        f32x4 gv[2][2];
#pragma unroll
        for (int bj = 0; bj < 2; ++bj)
#pragma unroll
            for (int n = 0; n < 2; ++n) gv[bj][n] = *(const f32x4*)(gp + bj * HALF + n * 16);
#pragma unroll
        for (int ai = 0; ai < 2; ++ai) {
            f32x4 xo[4][2][2];
            if (xold_f32) {
#pragma unroll
                for (int m = 0; m < 4; ++m) { const size_t off = (size_t)(row0 + ai * HALF + m * 16) * 2048 + col0;
#pragma unroll
                    for (int bj = 0; bj < 2; ++bj)
#pragma unroll
                        for (int n = 0; n < 2; ++n) xo[m][bj][n] = *(const f32x4*)((const float*)xold + off + bj * HALF + n * 16); }
            } else {
#pragma unroll
                for (int m = 0; m < 4; ++m) { const size_t off = (size_t)(row0 + ai * HALF + m * 16) * 2048 + col0;
#pragma unroll
                    for (int bj = 0; bj < 2; ++bj)
#pragma unroll
                        for (int n = 0; n < 2; ++n) { const uint2 w = *(const uint2*)((const bf16_t*)xold + off + bj * HALF + n * 16);
                            xo[m][bj][n] = (f32x4){__uint_as_float(w.x << 16), __uint_as_float(w.x & 0xffff0000u), __uint_as_float(w.y << 16), __uint_as_float(w.y & 0xffff0000u)}; } }
            }
#pragma unroll
            for (int m = 0; m < 4; ++m) { const size_t off = (size_t)(row0 + ai * HALF + m * 16) * 2048 + col0;
#pragma unroll
                for (int bj = 0; bj < 2; ++bj)
#pragma unroll
                    for (int n = 0; n < 2; ++n) { const f32x4 y = xo[m][bj][n] + gv[bj][n] * acc[ai][bj][m][n];
                        *(uint2*)(xnew + off + bj * HALF + n * 16) = make_uint2(cvt_pk_bf16(y[0], y[1]), cvt_pk_bf16(y[2], y[3])); } } }
    }
};

template <class Epi, class Sched, bool STAMP = false>
__device__ __forceinline__ void gemm_phase(int wv, PG8_LAS unsigned char* lds, const Gemm g, const Sched& S, const Epi& E, unsigned long long* stamps) {
    const int tid = ltid(wv), wid = wv, lane = tid & 63, wr = wid >> 2, wc = wid & 3, fr = lane & 15, fq = lane >> 4;
    const int K = g.K, nt = K / BK;
    int ts_lo = 0, ts_hi = 0, nts = 0; const unsigned long long rt_entry = STAMP ? (unsigned long long)wall_clock64() : 0ull;
#define PG8_STAMP() do { if (STAMP && wid == 0 && nts < 64) { const unsigned long long _c = (unsigned long long)clock64(); \
        ts_lo = (lane == nts) ? (int)(unsigned)_c : ts_lo; ts_hi = (lane == nts) ? (int)(unsigned)(_c >> 32) : ts_hi; ++nts; } } while (0)
    PG8_STAMP();
    unsigned voffA[2], voffB[2];
#pragma unroll
    for (int i = 0; i < 2; ++i) { int R, C; stage_rc(tid * 16 + i * 8192, R, C); const int Rb = Epi::PERM ? ((R & ~31) + perm32(R & 31)) : R;
        voffA[i] = (unsigned)(R * K + C) * 2u; voffB[i] = (unsigned)(Rb * K + C) * 2u; }
    const size_t kstep = (size_t)(BK * 2);
    const size_t hstep = (size_t)HALF * K * 2;
    const size_t tstep = 2 * hstep;
    const unsigned ldsw = (unsigned)wid * 1024u;
    const int aoff = lds_byte(wr * 64 + fr, fq * 8), boff = lds_byte(wc * 32 + fr, fq * 8);
#define PG8_SA(b, h) (((b) * 2 + (h)) * HTB)
#define PG8_SB(b, h) ((4 + (b) * 2 + (h)) * HTB)
#define PG8_STAGE(bufoff, gbase, voff) do { _Pragma("unroll") for (int _i = 0; _i < 2; ++_i) \
        __builtin_amdgcn_global_load_lds((const unsigned*)((const char*)(gbase) + (voff)[_i]), (PG8_LAS unsigned*)(lds + (bufoff) + ldsw + _i * 8192), 16, 0, 0); } while (0)
#define PG8_LDA(dst, b, h) do { _Pragma("unroll") for (int m = 0; m < 4; ++m) _Pragma("unroll") for (int k = 0; k < 2; ++k) dst[m][k] = *(const PG8_LAS bf16x8*)(lds + PG8_SA(b, h) + aoff + m * 2048 + k * 1024); } while (0)
#define PG8_LDB(dst, b, h) do { _Pragma("unroll") for (int n = 0; n < 2; ++n) _Pragma("unroll") for (int k = 0; k < 2; ++k) dst[n][k] = *(const PG8_LAS bf16x8*)(lds + PG8_SB(b, h) + boff + n * 2048 + k * 1024); } while (0)
#define PG8_MMA(ai, bj, At, Bt) do { __builtin_amdgcn_s_setprio(1); _Pragma("unroll") for (int m = 0; m < 4; ++m) _Pragma("unroll") for (int n = 0; n < 2; ++n) _Pragma("unroll") for (int k = 0; k < 2; ++k) \
        acc[ai][bj][m][n] = __builtin_amdgcn_mfma_f32_16x16x32_bf16(Bt[n][k], At[m][k], acc[ai][bj][m][n], 0, 0, 0); __builtin_amdgcn_s_setprio(0); } while (0)
#define PG8_WAIT_V(n) asm volatile("s_waitcnt vmcnt(" #n ")" ::: "memory")
#define PG8_WAIT_L(n) asm volatile("s_waitcnt lgkmcnt(" #n ")" ::: "memory")
#define PG8_BAR __builtin_amdgcn_s_barrier()
#define PG8_SCHED __builtin_amdgcn_sched_barrier(0)
    Unit cur, nxt; int ui = 0;
    if (!S.next(0, cur)) return;
    f32x4 acc[2][2][4][2];
#pragma unroll
    for (int a = 0; a < 2; ++a)
#pragma unroll
        for (int b = 0; b < 2; ++b)
#pragma unroll
            for (int m = 0; m < 4; ++m)
#pragma unroll
                for (int n = 0; n < 2; ++n) acc[a][b][m][n] = (f32x4){0.f, 0.f, 0.f, 0.f};
    bf16x8 At[4][2], B0[2][2], B1[2][2];
    const char* cA = (const char*)g.A + (size_t)cur.pm * tstep; const char* cB = (const char*)g.Bt + (size_t)cur.pn * tstep;
    S.a_ready(cur);
    PG8_STAGE(PG8_SB(0, 0), cB, voffB); PG8_STAGE(PG8_SA(0, 0), cA, voffA); PG8_STAGE(PG8_SB(0, 1), cB + hstep, voffB); PG8_STAGE(PG8_SA(0, 1), cA + hstep, voffA);
    if (wr == 1) PG8_BAR;
    PG8_WAIT_V(4); PG8_BAR;
    PG8_STAGE(PG8_SB(1, 0), cB + kstep, voffB); PG8_STAGE(PG8_SA(1, 0), cA + kstep, voffA); PG8_STAGE(PG8_SB(1, 1), cB + hstep + kstep, voffB);
    PG8_WAIT_V(6); PG8_BAR;
    PG8_STAMP();
    for (;;) {
        const bool has_next = S.next(ui + 1, nxt);
        const char* nA = has_next ? (const char*)g.A + (size_t)nxt.pm * tstep : cA; const char* nB = has_next ? (const char*)g.Bt + (size_t)nxt.pn * tstep : cB;
        for (int t = 0; t < nt; t += 2) {
            const bool last = (t == nt - 2);
            const char* a1 = cA + (size_t)(t + 1) * kstep;
            const char* a2 = last ? nA : cA + (size_t)(t + 2) * kstep; const char* b2 = last ? nB : cB + (size_t)(t + 2) * kstep;
            const char* a3 = a2 + kstep; const char* b3 = b2 + kstep;
            if (last && has_next) S.a_ready(nxt);
            PG8_LDB(B0, 0, 0); PG8_SCHED; PG8_LDA(At, 0, 0); PG8_STAGE(PG8_SA(1, 1), a1 + hstep, voffA);
            PG8_WAIT_L(8); PG8_BAR; PG8_WAIT_L(0); PG8_MMA(0, 0, At, B0); PG8_BAR; PG8_SCHED;
            PG8_LDB(B1, 0, 1); PG8_STAGE(PG8_SB(0, 0), b2, voffB);
            PG8_BAR; PG8_WAIT_L(0); PG8_MMA(0, 1, At, B1); PG8_BAR;
            PG8_LDA(At, 0, 1); PG8_STAGE(PG8_SA(0, 0), a2, voffA);
            PG8_BAR; PG8_WAIT_L(0); PG8_MMA(1, 0, At, B0); PG8_BAR; PG8_SCHED;
            PG8_STAGE(PG8_SB(0, 1), b2 + hstep, voffB);
            PG8_WAIT_V(6); PG8_BAR; PG8_MMA(1, 1, At, B1); PG8_BAR;
            PG8_LDB(B0, 1, 0); PG8_SCHED; PG8_LDA(At, 1, 0); PG8_STAGE(PG8_SA(0, 1), a2 + hstep, voffA);
            PG8_WAIT_L(8); PG8_BAR; PG8_WAIT_L(0); PG8_MMA(0, 0, At, B0); PG8_BAR; PG8_SCHED;
            PG8_LDB(B1, 1, 1); PG8_STAGE(PG8_SB(1, 0), b3, voffB);
            PG8_BAR; PG8_WAIT_L(0); PG8_MMA(0, 1, At, B1); PG8_BAR;
            PG8_LDA(At, 1, 1); PG8_STAGE(PG8_SA(1, 0), a3, voffA);
            PG8_BAR; PG8_WAIT_L(0); PG8_MMA(1, 0, At, B0); PG8_BAR; PG8_SCHED;
            PG8_STAGE(PG8_SB(1, 1), b3 + hstep, voffB);
            PG8_WAIT_V(6); PG8_BAR; PG8_MMA(1, 1, At, B1); PG8_BAR;
        }
        PG8_STAMP();
        if constexpr (!Epi::AFTER_DRAIN) { E(acc, cur, wr, wc, fr, fq); S.done(cur); }
        PG8_STAMP();
        if (!has_next) break;
#pragma unroll
        for (int a = 0; a < 2; ++a)
#pragma unroll
            for (int b = 0; b < 2; ++b)
#pragma unroll
                for (int m = 0; m < 4; ++m)
#pragma unroll
                    for (int n = 0; n < 2; ++n) acc[a][b][m][n] = (f32x4){0.f, 0.f, 0.f, 0.f};
        cur = nxt; cA = nA; cB = nB; ++ui;
    }
    PG8_WAIT_V(0);
    if (wr == 0) PG8_BAR;
    PG8_BAR;
    if constexpr (Epi::AFTER_DRAIN) { E.fused(acc, cur, wr, wc, fr, fq, lds, wid, lane); S.done(cur); }
    PG8_STAMP();
    if (STAMP && wid == 0) { stamps[lane] = lane < nts ? (((unsigned long long)(unsigned)ts_hi << 32) | (unsigned)ts_lo) : 0ull;
        if (lane == 62) stamps[62] = rt_entry; if (lane == 63) stamps[63] = (unsigned long long)wall_clock64(); }
#undef PG8_STAMP
#undef PG8_SA
#undef PG8_SB
#undef PG8_STAGE
#undef PG8_LDA
#undef PG8_LDB
#undef PG8_MMA
#undef PG8_WAIT_V
#undef PG8_WAIT_L
#undef PG8_BAR
#undef PG8_SCHED
}
}
#define XB_TMO      128
#define XB_XCNT(j)  (256  + 64 * (j))
#define XB_XSUB(j)  (1280 + 64 * (j))
#define XB_XGEN(j)  (2304 + 64 * (j))
#define XB_TOP      3328
#define XB_TOPGEN   3392
#define XCD_BAR_WORDS 3456
#define XB_SPIN_CAP (1u << 18)
#define LAS __attribute__((address_space(3)))

__device__ __forceinline__ unsigned xb_ld(unsigned* p)              { return __hip_atomic_load(p, __ATOMIC_RELAXED, __HIP_MEMORY_SCOPE_AGENT); }
__device__ __forceinline__ unsigned xb_add(unsigned* p, unsigned v) { return __hip_atomic_fetch_add(p, v, __ATOMIC_RELAXED, __HIP_MEMORY_SCOPE_AGENT); }
__device__ __forceinline__ unsigned xb_xcc_id() { return (unsigned)__builtin_amdgcn_s_getreg((3 << 11) | 20) & 0xFu; }
#define XB_SPIN(cond, bar) do { unsigned _sp = 0; while (cond) { __builtin_amdgcn_s_sleep(1); \
    if ((++_sp & 255u) == 0u) { if (xb_ld(&(bar)[XB_TMO])) break; if (_sp > XB_SPIN_CAP) { atomicAdd(&(bar)[XB_TMO], 1u); break; } } } } while (0)

struct XcdBarrier {
    unsigned* bar; unsigned x; int wv;
    volatile LAS unsigned* st;
};

__device__ __forceinline__ bool xb_thread0(int wv) { unsigned m = ~0u; asm volatile("" : "+s"(m)); return wv == 0 && __builtin_amdgcn_mbcnt_hi(m, __builtin_amdgcn_mbcnt_lo(m, 0u)) == 0u; }
__device__ __forceinline__ XcdBarrier xcd_barrier_post(unsigned* bar, volatile LAS unsigned* st, int wv) {
    XcdBarrier b; b.bar = bar; b.x = xb_xcc_id(); b.st = st; b.wv = wv;
    if (xb_thread0(wv)) (void)xb_add(&bar[XB_XCNT(b.x)], 1u);
    return b;
}
__device__ __forceinline__ void xcd_barrier_complete(unsigned* bar, unsigned x, unsigned& nloc, unsigned& nx) {
    const unsigned G = gridDim.x * gridDim.y * gridDim.z;
    unsigned sum, cnt, mine, sp = 0u;
    for (;;) {
        sum = 0u; cnt = 0u; mine = 0u;
#pragma unroll
        for (unsigned j = 0; j < 16; ++j) { const unsigned c = xb_ld(&bar[XB_XCNT(j)]); sum += c; cnt += (c > 0u) ? 1u : 0u; mine = (j == x) ? c : mine; }
        if (sum == G) break;
        __builtin_amdgcn_s_sleep(1);
        if ((++sp & 255u) == 0u) { if (xb_ld(&bar[XB_TMO])) break; if (sp > XB_SPIN_CAP) { atomicAdd(&bar[XB_TMO], 1u); break; } }
    }
    nloc = mine > 0u ? mine : 1u; nx = cnt > 0u ? cnt : 1u;
}

__device__ __forceinline__ void xcd_barrier(const XcdBarrier& b) {
    asm volatile("s_waitcnt vmcnt(0)" ::: "memory");
    __syncthreads();
    if (xb_thread0(b.wv)) {
        unsigned* bar = b.bar; asm volatile("" : "+s"(bar)); unsigned bx = b.x; asm volatile("" : "+s"(bx));
        __builtin_amdgcn_s_waitcnt(0);
        unsigned nloc = b.st[0], nx = b.st[1];
        if (nloc == 0u) { xcd_barrier_complete(bar, bx, nloc, nx); b.st[0] = nloc; b.st[1] = nx; }
        const unsigned old = xb_add(&bar[XB_XSUB(bx)], 1u);
        const unsigned gen = old / nloc;
        if (old + 1u == (gen + 1u) * nloc) {
            __builtin_amdgcn_fence(__ATOMIC_RELEASE, "agent");
            asm volatile("s_waitcnt vmcnt(0)" ::: "memory");
            const unsigned og = xb_add(&bar[XB_TOP], 1u);
            const unsigned tg = og / nx;
            if (og + 1u == (tg + 1u) * nx) xb_add(&bar[XB_TOPGEN], 1u);
            else XB_SPIN(xb_ld(&bar[XB_TOPGEN]) == tg, bar);
            __builtin_amdgcn_fence(__ATOMIC_ACQUIRE, "agent");
            xb_add(&bar[XB_XGEN(bx)], 1u);
            asm volatile("s_waitcnt vmcnt(0)" ::: "memory");
        } else {
            XB_SPIN(xb_ld(&bar[XB_XGEN(bx)]) == gen, bar);
            __builtin_amdgcn_fence(__ATOMIC_ACQUIRE, "agent");
            asm volatile("s_waitcnt vmcnt(0)" ::: "memory");
        }
    }
    __syncthreads();
    __builtin_amdgcn_s_waitcnt(0);
}

constexpr int NTHR = 512, NWAVE = 8;
constexpr int TT = 16384, DM = 2048, SEQ = 4096, NBATCH = 4;
constexpr int GLA_N = 6160, GLA_NM = 6144;
constexpr int KV_N = 4112, KV_NM = 4096;
constexpr float RMS_EPS = 1e-6f;
constexpr int LDS_BYTES = 155648;

typedef pg8::bf16x8 bf16x8;
typedef pg8::f32x4 f32x4;
typedef pg8::u32x4 u32x4;

struct TMat { const float* src; bf16_t* dst; bf16_t* dst16; int N, Nmain, ntn, first; };
constexpr int NTMAT = 13;
struct Params {
    const float *x, *c, *ada_w, *ada_b, *norm_mix, *norm_ffn, *gla_w_in, *gla_wg2, *gla_bg2, *gla_norm, *gla_w_out, *kv_norm, *kv_ada_w, *kv_ada_b,
                *fox_w_kv, *fox_b_f, *fox_w_q, *fox_w_out, *peer_w_q, *peer_subk, *peer_u, *peer_v, *final_norm;
    float* out;
    unsigned* bar; float* mod; float* kvmod;
    bf16_t *Wt_in, *W16_in, *Wt_out, *Wt_kv, *W16_kv, *Wt_q, *Wt_fo, *Wt_pq, *subk; unsigned char *U8, *V8; float *su, *sv;
    bf16_t* xbuf; bf16_t *h, *hk, *h2, *og, *pq; int* ids; float* wts; float* fl; float* apart; signed char* cqbuf; float* scbuf; float* kn2; int* jlo;
    bf16_t *proj, *qt, *khT, *vT, *Pm; float* dec; bf16_t* o;
    bf16_t *qb, *gb, *Kb, *Vb, *ob; float* Fa;
    TMat tm[NTMAT];
    int ntr_jobs, pad0;
};

__device__ __forceinline__ unsigned cvtpk(float lo, float hi) { unsigned r; asm("v_cvt_pk_bf16_f32 %0, %1, %2" : "=v"(r) : "v"(lo), "v"(hi)); return r; }
__device__ __forceinline__ float bflo(unsigned w) { return __uint_as_float(w << 16); }
__device__ __forceinline__ float bfhi(unsigned w) { return __uint_as_float(w & 0xffff0000u); }
__device__ __forceinline__ bf16_t f2bf(float f) { return (bf16_t)(cvtpk(f, f) & 0xffffu); }
__device__ __forceinline__ float shfl_idx(float v, int src_lane) { return __builtin_bit_cast(float, __builtin_amdgcn_ds_bpermute(src_lane << 2, __builtin_bit_cast(int, v))); }
__device__ __forceinline__ float wave_sum_shfl(float v, int lane) {
#pragma unroll
    for (int o = 32; o > 0; o >>= 1) v += shfl_idx(v, lane ^ o);
    return v;
}
template <int CTRL> __device__ __forceinline__ int dpp_i(int x) { return __builtin_amdgcn_mov_dpp(x, CTRL, 0xf, 0xf, true); }
template <int CTRL> __device__ __forceinline__ float dpp_f(float x) { return __builtin_bit_cast(float, __builtin_amdgcn_mov_dpp(__builtin_bit_cast(int, x), CTRL, 0xf, 0xf, true)); }
__device__ __forceinline__ float rdlane(float v, int l) { return __builtin_bit_cast(float, __builtin_amdgcn_readlane(__builtin_bit_cast(int, v), l)); }
__device__ __forceinline__ float wave_sum_dpp(float v) {
    v += dpp_f<0xB1>(v); v += dpp_f<0x4E>(v); v += dpp_f<0x141>(v); v += dpp_f<0x128>(v);
    return (rdlane(v, 0) + rdlane(v, 16)) + (rdlane(v, 32) + rdlane(v, 48));
}
__device__ __forceinline__ float dot2bf(unsigned a, unsigned b, float acc) { return __builtin_amdgcn_fdot2_f32_bf16(__builtin_bit_cast(bf16x2, a), __builtin_bit_cast(bf16x2, b), acc, false); }
__device__ __forceinline__ float log_sigmoidf(float z) { return fminf(z, 0.f) - log1pf(expf(-fabsf(z))); }
__device__ __forceinline__ float log_sigmoid_fast(float z) { return fminf(z, 0.f) - __logf(1.f + __expf(-fabsf(z))); }
__device__ __forceinline__ float siluf(float z) { return z / (1.f + expf(-z)); }
__device__ __forceinline__ float sigmoidf_(float z) { return 1.f / (1.f + expf(-z)); }
__device__ __forceinline__ float gelu_tanh(float x) { const float u = 0.7978845608028654f * (x + 0.044715f * x * x * x); return x * __builtin_amdgcn_rcpf(1.f + __expf(-2.f * u)); }
__device__ __forceinline__ u32x4 pack8f(const float (&v)[8]) { u32x4 w; w.x = cvtpk(v[0], v[1]); w.y = cvtpk(v[2], v[3]); w.z = cvtpk(v[4], v[5]); w.w = cvtpk(v[6], v[7]); return w; }
__device__ __forceinline__ void unpack8(const u32x4 w, float (&v)[8]) { v[0] = bflo(w.x); v[1] = bfhi(w.x); v[2] = bflo(w.y); v[3] = bfhi(w.y); v[4] = bflo(w.z); v[5] = bfhi(w.z); v[6] = bflo(w.w); v[7] = bfhi(w.w); }
#define MFMA16(a, b, c) __builtin_amdgcn_mfma_f32_16x16x32_bf16((a), (b), (c), 0, 0, 0)

constexpr int NGEMV = 208, NCONV = 2048 + 2048 + 16;
__device__ __forceinline__ void phase_prologue(int wv, const Params& p, unsigned char* lds, unsigned* qctr) {
    const int tid = ltid(wv), wid = wv, lane = tid & 63;
    const int bid_ = lbid(), ngrid_ = lgrid();
    float* cact = (float*)lds;
    float* red = (float*)(lds + 32768);
    float* tile = (float*)(lds + 65536);
    for (int i = tid; i < NBATCH * DM; i += NTHR) cact[i] = siluf(p.c[i]);
    __syncthreads();
    const int njobs = NGEMV + p.ntr_jobs + NCONV;
    volatile int* s_job = (volatile int*)(lds + 140 * 1024);
    (void)bid_; (void)ngrid_;
    if (tid == 0) *s_job = (int)__hip_atomic_fetch_add(qctr, 1u, __ATOMIC_RELAXED, __HIP_MEMORY_SCOPE_AGENT);
    __syncthreads();
    int job = __builtin_amdgcn_readfirstlane(*s_job);
    __syncthreads();
    for (; job < njobs; ) {
        if (tid == 0) *s_job = (int)__hip_atomic_fetch_add(qctr, 1u, __ATOMIC_RELAXED, __HIP_MEMORY_SCOPE_AGENT);
        if (job < NGEMV) {
            const float* W; const float* bias; float* outp; int N, ostride, cb;
            if (job < 192) { const int l = job / 48; cb = job % 48; W = p.ada_w + (size_t)l * DM * 12288; bias = p.ada_b + l * 12288; outp = p.mod + (size_t)l * NBATCH * 12288; N = 12288; ostride = 12288; }
            else { cb = job - 192; W = p.kv_ada_w; bias = p.kv_ada_b; outp = p.kvmod; N = 4096; ostride = 4096; }
            const int col = cb * 256 + 4 * lane;
            f32x4 acc[4];
#pragma unroll
            for (int b = 0; b < 4; ++b) acc[b] = (f32x4){0.f, 0.f, 0.f, 0.f};
            const float* wp = W + (size_t)(wid * 256) * N + col;
#pragma unroll 8
            for (int k = 0; k < 256; ++k) {
                const f32x4 w4 = *(const f32x4*)(wp + (size_t)k * N);
#pragma unroll
                for (int b = 0; b < 4; ++b) acc[b] += cact[b * DM + wid * 256 + k] * w4;
            }
#pragma unroll
            for (int b = 0; b < 4; ++b) *(f32x4*)(red + (wid * 4 + b) * 256 + 4 * lane) = acc[b];
            __syncthreads();
#pragma unroll
            for (int i = 0; i < 2; ++i) { const int o = tid + NTHR * i, b = o >> 8, cl = o & 255; float s = bias[cb * 256 + cl];
#pragma unroll
                for (int ks = 0; ks < 8; ++ks) s += red[(ks * 4 + b) * 256 + cl];
                outp[(size_t)b * ostride + cb * 256 + cl] = s; }
            __syncthreads();
        } else if (job < NGEMV + p.ntr_jobs) {
            const int j = job - NGEMV; int m = 0;
#pragma unroll
            for (int q = 1; q < NTMAT; ++q) if (j >= p.tm[q].first) m = q;
            const TMat M = p.tm[m];
            const int r = j - M.first, kt = r / M.ntn, nt4 = r - kt * M.ntn;
#pragma unroll
            for (int i = 0; i < 8; ++i) { const int idx = tid + NTHR * i, rr = idx >> 6, c4 = idx & 63, n = nt4 * 256 + 4 * c4;
                f32x4 v = (f32x4){0.f, 0.f, 0.f, 0.f};
                if (n < M.N) v = *(const f32x4*)(M.src + (size_t)(kt * 64 + rr) * M.N + n);
                float* tp = tile + ((c4 >> 4) * 64 + rr) * 65 + 4 * (c4 & 15); tp[0] = v[0]; tp[1] = v[1]; tp[2] = v[2]; tp[3] = v[3]; }
            __syncthreads();
#pragma unroll
            for (int q = 0; q < 4; ++q) { const int nl = tid >> 3, ks = tid & 7, n = nt4 * 256 + q * 64 + nl; float v[8];
#pragma unroll
              for (int e = 0; e < 8; ++e) v[e] = tile[(q * 64 + 8 * ks + e) * 65 + nl];
              const u32x4 w = pack8f(v);
              if (n < M.Nmain) *(u32x4*)(M.dst + (size_t)n * DM + kt * 64 + 8 * ks) = w;
              else if (n < M.N) *(u32x4*)(M.dst16 + (size_t)(n - M.Nmain) * DM + kt * 64 + 8 * ks) = w; }
            __syncthreads();
        } else {
            const int j = job - NGEMV - p.ntr_jobs;
            if (j < 4096) {
                const float* src = j < 2048 ? p.peer_u : p.peer_v; unsigned char* dst = j < 2048 ? p.U8 : p.V8; float* sc = j < 2048 ? p.su : p.sv; const int jj = j & 2047;
#pragma unroll
                for (int i = 0; i < 4; ++i) { const size_t row = (size_t)jj * 32 + wid * 4 + i; const float* rp = src + row * DM + 16 * lane;
                    f32x4 v[8];
#pragma unroll
                    for (int q = 0; q < 4; ++q) { v[q] = *(const f32x4*)(rp + 4 * q); v[4 + q] = *(const f32x4*)(rp + 1024 + 4 * q); }
                    float am = 0.f;
#pragma unroll
                    for (int q = 0; q < 8; ++q) am = fmaxf(fmaxf(fmaxf(am, fabsf(v[q][0])), fmaxf(fabsf(v[q][1]), fabsf(v[q][2]))), fabsf(v[q][3]));
#pragma unroll
                    for (int o = 32; o > 0; o >>= 1) am = fmaxf(am, shfl_idx(am, lane ^ o));
                    const float s = fmaxf(am, 1e-30f) * (1.f / 127.f), inv = 1.f / s;
                    unsigned w[8];
#pragma unroll
                    for (int q = 0; q < 8; ++q) { unsigned ww = 0u;
#pragma unroll
                        for (int e = 0; e < 4; ++e) { const int qi = (int)rintf(v[q][e] * inv); ww |= (unsigned)(qi & 0xff) << (8 * e); }
                        w[q] = ww; }
                    *(u32x4*)(dst + row * DM + 16 * lane) = (u32x4){w[0], w[1], w[2], w[3]}; *(u32x4*)(dst + row * DM + 1024 + 16 * lane) = (u32x4){w[4], w[5], w[6], w[7]};
                    if (lane == 0) sc[row] = s; }
            } else {
                const size_t base = (size_t)(j - 4096) * 65536; const float* src = p.peer_subk; bf16_t* dst = p.subk;
#pragma unroll 4
                for (int i = 0; i < 16; ++i) { const size_t e = base + (size_t)(i * NTHR + tid) * 8;
                    const f32x4 a = *(const f32x4*)(src + e), b = *(const f32x4*)(src + e + 4);
                    u32x4 w; w.x = cvtpk(a[0], a[1]); w.y = cvtpk(a[2], a[3]); w.z = cvtpk(b[0], b[1]); w.w = cvtpk(b[2], b[3]);
                    *(u32x4*)(dst + e) = w; }
            }
        }
        __syncthreads();
        job = __builtin_amdgcn_readfirstlane(*s_job);
        __syncthreads();
    }
}

template <bool TWO, bool FINAL, bool XF32 = false>
__device__ __forceinline__ void phase_norm(int wv, const void* xv, const float* g1, const float* sh1, const float* sc1, int ms1, bf16_t* out1,
                                           const float* g2, const float* sh2, const float* sc2, int ms2, bf16_t* out2, float* outf) {
    const int tid = ltid(wv), lane = tid & 63;
    const int bid_ = lbid(), ngrid_ = lgrid();
    for (int r0 = (bid_ * NWAVE + wv) * 8; r0 < TT; r0 += ngrid_ * NWAVE * 8) {
        const int b = r0 >> 12;
        f32x4 a1[8], s1[8], a2[8], s2[8];
#pragma unroll
        for (int i = 0; i < 4; ++i)
#pragma unroll
            for (int hh = 0; hh < 2; ++hh) { const int c = 8 * (lane + 64 * i) + 4 * hh;
                if constexpr (FINAL) { a1[2 * i + hh] = *(const f32x4*)(g1 + c); }
                else { a1[2 * i + hh] = *(const f32x4*)(g1 + c) * (1.f + *(const f32x4*)(sc1 + (size_t)b * ms1 + c)); s1[2 * i + hh] = *(const f32x4*)(sh1 + (size_t)b * ms1 + c); }
                if constexpr (TWO) { a2[2 * i + hh] = *(const f32x4*)(g2 + c) * (1.f + *(const f32x4*)(sc2 + (size_t)b * ms2 + c)); s2[2 * i + hh] = *(const f32x4*)(sh2 + (size_t)b * ms2 + c); } }
        for (int rr = 0; rr < 8; ++rr) { const int row = r0 + rr;
            f32x4 v[8]; float ss = 0.f;
            if constexpr (XF32) { const float* xr = (const float*)xv + (size_t)row * DM;
#pragma unroll
                for (int i = 0; i < 4; ++i) { const int c = 8 * (lane + 64 * i); v[2 * i] = *(const f32x4*)(xr + c); v[2 * i + 1] = *(const f32x4*)(xr + c + 4); } }
            else { const bf16_t* xr = (const bf16_t*)xv + (size_t)row * DM;
#pragma unroll
                for (int i = 0; i < 4; ++i) { float t8[8]; unpack8(*(const u32x4*)(xr + 8 * (lane + 64 * i)), t8); v[2 * i] = (f32x4){t8[0], t8[1], t8[2], t8[3]}; v[2 * i + 1] = (f32x4){t8[4], t8[5], t8[6], t8[7]}; } }
#pragma unroll
            for (int i = 0; i < 8; ++i) ss += v[i][0] * v[i][0] + v[i][1] * v[i][1] + v[i][2] * v[i][2] + v[i][3] * v[i][3];
            ss = wave_sum_shfl(ss, lane);
            const float rs = rsqrtf(ss * (1.f / DM) + RMS_EPS);
#pragma unroll
            for (int i = 0; i < 4; ++i) { const int c = 8 * (lane + 64 * i);
                if constexpr (FINAL) { *(f32x4*)(outf + (size_t)row * DM + c) = v[2 * i] * rs * a1[2 * i]; *(f32x4*)(outf + (size_t)row * DM + c + 4) = v[2 * i + 1] * rs * a1[2 * i + 1]; }
                else {
                    { const f32x4 ya = v[2 * i] * rs * a1[2 * i] + s1[2 * i], yb = v[2 * i + 1] * rs * a1[2 * i + 1] + s1[2 * i + 1];
                      u32x4 w; w.x = cvtpk(ya[0], ya[1]); w.y = cvtpk(ya[2], ya[3]); w.z = cvtpk(yb[0], yb[1]); w.w = cvtpk(yb[2], yb[3]);
                      *(u32x4*)(out1 + (size_t)row * DM + c) = w; }
                    if constexpr (TWO) { const f32x4 ya = v[2 * i] * rs * a2[2 * i] + s2[2 * i], yb = v[2 * i + 1] * rs * a2[2 * i + 1] + s2[2 * i + 1];
                      u32x4 w; w.x = cvtpk(ya[0], ya[1]); w.y = cvtpk(ya[2], ya[3]); w.z = cvtpk(yb[0], yb[1]); w.w = cvtpk(yb[2], yb[3]);
                      *(u32x4*)(out2 + (size_t)row * DM + c) = w; }
                }
            }
        }
    }
}

__device__ __forceinline__ void mini16(int wv, const bf16_t* A  , const bf16_t* W16, float* gls) {
    const int tid = ltid(wv), wid = wv, lane = tid & 63, fr = lane & 15, fq = lane >> 4, mt = wid & 3, kh = wid >> 2;
    f32x4 acc = (f32x4){0.f, 0.f, 0.f, 0.f};
    const bf16_t* ap = A + (size_t)(16 * mt + fr) * DM + kh * 1024 + 8 * fq;
    const bf16_t* bp = W16 + (size_t)fr * DM + kh * 1024 + 8 * fq;
    bf16x8 af[12], bfr[12];
#define MINI_BATCH(k0, n) do { __builtin_amdgcn_sched_barrier(0);                                                                                  \
        _Pragma("unroll") for (int j = 0; j < (n); ++j) { af[j] = *(const bf16x8*)(ap + 32 * ((k0) + j)); bfr[j] = *(const bf16x8*)(bp + 32 * ((k0) + j)); } \
        __builtin_amdgcn_sched_barrier(0);                                                                                                         \
        _Pragma("unroll") for (int j = 0; j < (n); ++j) acc = MFMA16(af[j], bfr[j], acc); } while (0)
    MINI_BATCH(0, 12); MINI_BATCH(12, 12); MINI_BATCH(24, 8);
#undef MINI_BATCH
    __builtin_amdgcn_sched_barrier(0);
#pragma unroll
    for (int i = 0; i < 4; ++i) gls[(kh * 64 + 16 * mt + 4 * fq + i) * 16 + fr] = acc[i];
}

constexpr int PREP_GLS = 0, PREP_TOT = 8192, PREP_BLOC = 10240, PREP_X = 75776, PREP_Y = 109568, PREP_PS = 143360;
constexpr int XLD = 264, TLD = 72;
template <int PV>
__device__ __forceinline__ void phase_gla_prep(int wv, const Params& p, int l, unsigned char* lds) {
    const int tid = ltid(wv), wid = wv, lane = tid & 63, fr = lane & 15, fq = lane >> 4;
    const int bid_ = lbid(), ngrid_ = lgrid();
    float* gls = (float*)(lds + PREP_GLS); float* tot0 = (float*)(lds + PREP_TOT); float* bloc = (float*)(lds + PREP_BLOC);
    const unsigned xlds = (unsigned)(uintptr_t)(LAS unsigned char*)(lds + PREP_X);
    bf16_t* X = (bf16_t*)(lds + PREP_X); bf16_t* Y = (bf16_t*)(lds + PREP_Y); bf16_t* Ps = (bf16_t*)(lds + PREP_PS);
    const float* wg2 = p.gla_wg2 + (size_t)l * 16 * 1024; const float* bg2 = p.gla_bg2 + l * 1024;
    const bf16_t* W16 = p.W16_in + (size_t)l * 16 * DM;
    for (int u = bid_; u < 256; u += ngrid_) {
        const int tok0 = (u >> 6) * SEQ + (u & 63) * 64;
        if (PV != 4) mini16(wv, p.h + (size_t)tok0 * DM, W16, gls);
        __syncthreads();
        { const float s0 = gls[tid] + gls[1024 + tid], s1 = gls[NTHR + tid] + gls[1024 + NTHR + tid]; gls[tid] = s0; gls[NTHR + tid] = s1; }
        __syncthreads();
        for (int hd = 0; hd < 4; ++hd) {
            const size_t uh = (size_t)u * 4 + hd;
            u32x4 qw[4], kw[4];
#pragma unroll
            for (int i = 0; i < 4; ++i) { const int idx = tid + NTHR * i, t = idx >> 5, k0 = 8 * (idx & 31);
                const bf16_t* pr = p.proj + (size_t)(tok0 + t) * GLA_NM + hd * 256 + k0; qw[i] = *(const u32x4*)pr; kw[i] = *(const u32x4*)(pr + 1024); }
            for (int rep_ = 0; rep_ < (PV == 6 ? 2 : 1); ++rep_) if (PV != 1) { if (rep_) __syncthreads(); const int k = tid & 255, half = tid >> 8; float wg[16];
#pragma unroll
              for (int r = 0; r < 16; ++r) wg[r] = wg2[r * 1024 + hd * 256 + k];
              const float bg = bg2[hd * 256 + k]; float run = 0.f;
              fl2 wp[8];
#pragma unroll
              for (int r = 0; r < 8; ++r) wp[r] = (fl2){wg[2 * r], wg[2 * r + 1]};
              for (int tt = 0; tt < 32; tt += 4) { const int t = 32 * half + tt; const f32x4* gp = (const f32x4*)(gls + t * 16);
                  f32x4 gq[16];
                  __builtin_amdgcn_sched_barrier(0);
#pragma unroll
                  for (int i = 0; i < 16; ++i) gq[i] = gp[i];
                  __builtin_amdgcn_sched_barrier(0);
                  fl2 z2[4];
#pragma unroll
                  for (int j = 0; j < 4; ++j) z2[j] = (fl2){bg, 0.f};
#pragma unroll
                  for (int q = 0; q < 4; ++q)
#pragma unroll
                      for (int j = 0; j < 4; ++j) { const f32x4 g = gq[4 * j + q]; z2[j] += (fl2){g[0], g[1]} * wp[2 * q]; z2[j] += (fl2){g[2], g[3]} * wp[2 * q + 1]; }
                  float ls[4];
#pragma unroll
                  for (int j = 0; j < 4; ++j) { const float z = z2[j][0] + z2[j][1];
                      ls[j] = fminf(z, 0.f) - 0.6931471805599453f * __builtin_amdgcn_logf(1.f + __builtin_amdgcn_exp2f(-1.4426950408889634f * fabsf(z))); }
#pragma unroll
                  for (int j = 0; j < 4; ++j) { run += ls[j] * (1.f / 16.f); bloc[(t + j) * 256 + k] = run; } }
              if (half == 0) tot0[k] = run; }
            __syncthreads();
            f32x4 Lacc[2];
#pragma unroll
            for (int pass = 0; pass < 2; ++pass) {
#pragma unroll
                for (int i = 0; i < 4; ++i) { const int idx = tid + NTHR * i, t = idx >> 5, g = idx & 31, k0 = 8 * g;
                    float q8[8], k8[8]; unpack8(qw[i], q8); unpack8(kw[i], k8);
                    float xo[8], yo[8];
#pragma unroll
                    for (int e = 0; e < 8; ++e) { const float ep = __expf(bloc[t * 256 + k0 + e] + (t >= 32 ? tot0[k0 + e] : 0.f)), em = __frcp_rn(ep);
                        xo[e] = q8[e] * 0.0625f * (pass == 0 ? ep : em); yo[e] = k8[e] * (pass == 0 ? em : ep); }
                    const u32x4 xw = pack8f(xo), yw = pack8f(yo);
                    *(u32x4*)(X + t * XLD + k0) = xw; *(u32x4*)(Y + t * XLD + k0) = yw;
                    if (pass == 0) { const int G = g >> 2, a = g & 3, p1 = ((a & 1) << 4) | ((a >> 1) << 2);
                        bf16_t* qo = p.qt + uh * 16384 + ((size_t)((G * 4 + (t >> 4)) * 64 + (p1 >> 3) * 16 + (t & 15))) * 8 + (p1 & 7);
                        if (PV != 9) { *(uint2*)qo = make_uint2(xw.x, xw.y); *(uint2*)(qo + 128) = make_uint2(xw.z, xw.w); } } }
                __syncthreads();
#pragma unroll
                for (int j = 0; j < (PV == 3 ? 0 : 2); ++j) { const int tt = 2 * wid + j, mt = tt >> 2, nt = tt & 3; f32x4 acc = (f32x4){0.f, 0.f, 0.f, 0.f};
#pragma unroll
                    for (int ks = 0; ks < 8; ++ks) { const bf16x8 a = *(const bf16x8*)(X + (16 * mt + fr) * XLD + 32 * ks + 8 * fq), b = *(const bf16x8*)(Y + (16 * nt + fr) * XLD + 32 * ks + 8 * fq);
                        acc = MFMA16(a, b, acc); }
                    if (pass == 0) Lacc[j] = acc;
                    else {
#pragma unroll
                        for (int i = 0; i < 4; ++i) { const int t = 16 * mt + 4 * fq + i, s = 16 * nt + fr; Ps[t * TLD + s] = f2bf(s <= t ? Lacc[j][i] : acc[i]); } } }
                __syncthreads();
            }
            { const int row = tid >> 3, seg = tid & 7;
              if (PV != 9) *(u32x4*)(p.Pm + uh * 4096 + ((size_t)(((row >> 4) * 2 + (seg >> 2)) * 64 + (seg & 3) * 16 + (row & 15))) * 8) = *(const u32x4*)(Ps + row * TLD + 8 * seg); }
            if (PV != 5) { float eb[8];
#pragma unroll
              for (int e = 0; e < 8; ++e) eb[e] = __expf(bloc[63 * 256 + 8 * (tid & 31) + e] + tot0[8 * (tid & 31) + e]);
#pragma unroll
              for (int i = 0; i < 4; ++i) { const int idx = tid + NTHR * i, t = idx >> 5, g = idx & 31, k0 = 8 * g;
                float k8[8], kh[8]; unpack8(kw[i], k8);
#pragma unroll
                for (int e = 0; e < 8; ++e) { kh[e] = k8[e] * eb[e] * __expf(-(bloc[t * 256 + k0 + e] + (t >= 32 ? tot0[k0 + e] : 0.f)));
                    if (PV != 9 && t == 0) p.dec[uh * 256 + k0 + e] = eb[e]; }
                *(u32x4*)(X + t * XLD + k0) = pack8f(kh); } }
            __syncthreads();
#define PREP_TR_OUT(DST, FBASE) do { const unsigned la_ = xlds + (unsigned)(((8 * (lane >> 4) + ((lane & 15) >> 2)) * XLD + 4 * (lane & 3)) * 2);                     \
                _Pragma("unroll") for (int f = 0; f < 4; ++f) { const int fi = wid * 4 + f, cb = fi >> 1, ks = fi & 1; const unsigned a_ = la_ + (unsigned)((32 * ks * XLD + 16 * cb) * 2); \
                    s16x4 lo_, hi_;                                                                                                                       \
                    asm volatile("ds_read_b64_tr_b16 %0, %1" : "=&v"(lo_) : "v"(a_) : "memory");                                                           \
                    asm volatile("ds_read_b64_tr_b16 %0, %1 offset:%2" : "=&v"(hi_) : "v"(a_), "i"(4 * XLD * 2) : "memory");                                 \
                    asm volatile("s_waitcnt lgkmcnt(0)" ::: "memory");                                                                                     \
                    const uint2 l2_ = __builtin_bit_cast(uint2, lo_), h2_ = __builtin_bit_cast(uint2, hi_);                                                 \
                    if (PV != 9) *(u32x4*)((DST) + ((size_t)(((FBASE) + cb * 2 + ks) * 64 + lane)) * 8) = (u32x4){l2_.x, l2_.y, h2_.x, h2_.y}; } } while (0)
            if (PV != 5) PREP_TR_OUT(p.khT + uh * 16384, 0);
            __syncthreads();
        }
    }
}

#undef PREP_TR_OUT
constexpr int REC_LD = 36;
struct RecOps { bf16x8 aq[4], ak[2][2], ap[2]; f32x4 dv[2]; };
constexpr int REC_VOFF = 8 * 64 * REC_LD * 4, REC_VS = 96, REC_VBUF = 64 * REC_VS;
__device__ __forceinline__ void rec_load_a(RecOps& R, const Params& p, size_t uh, int w, int lane) {
    const bf16_t* qt = p.qt + uh * 16384 + lane * 8; const bf16_t* Pm = p.Pm + uh * 4096 + lane * 8;
#pragma unroll
    for (int mt = 0; mt < 4; ++mt) R.aq[mt] = *(const bf16x8*)(qt + (w * 4 + mt) * 512);
    const int mp = w >> 1;
    R.ap[0] = *(const bf16x8*)(Pm + (mp * 2) * 512); R.ap[1] = *(const bf16x8*)(Pm + (mp * 2 + 1) * 512);
}
__device__ __forceinline__ void rec_load_b(RecOps& R, const Params& p, size_t uh, int d0, int w, int lane) {
    const bf16_t* khT = p.khT + uh * 16384 + lane * 8; const float* dec = p.dec + uh * 256;
#pragma unroll
    for (int i = 0; i < 2; ++i) { R.ak[i][0] = *(const bf16x8*)(khT + ((2 * w + i) * 2) * 512); R.ak[i][1] = *(const bf16x8*)(khT + ((2 * w + i) * 2 + 1) * 512);
        R.dv[i] = *(const f32x4*)(dec + 16 * (2 * w + i) + 4 * (lane >> 4)); }
}
__device__ __forceinline__ void rec_load(RecOps& R, const Params& p, size_t uh, int d0, int w, int lane) { rec_load_a(R, p, uh, w, lane); rec_load_b(R, p, uh, d0, w, lane); }
template <int VAR>
__device__ __forceinline__ void phase_gla_rec(int wv, const Params& p, unsigned char* lds) {
    const int tid = ltid(wv), w = wv, lane = tid & 63, fr = lane & 15, fq = lane >> 4;
    const int bid_ = lbid(), ngrid_ = lgrid();
    float* red = (float*)lds;
    for (int u = bid_; u < 256; u += ngrid_) {
        const int g_ = (u & 7) * 2 + ((u >> 3) >> 4), b = g_ >> 2, hd = g_ & 3, d0 = ((u >> 3) & 15) * 32;
        f32x4 S[2][2];
#pragma unroll
        for (int i = 0; i < 2; ++i)
#pragma unroll
            for (int n = 0; n < 2; ++n) S[i][n] = (f32x4){0.f, 0.f, 0.f, 0.f};
        RecOps RA = {}, RB = {};
        const bf16_t* vsrc = p.proj + (size_t)(b * SEQ + (tid >> 3)) * GLA_NM + 2048 + hd * 512 + d0 + 4 * (tid & 7);
        unsigned char* vwr = lds + REC_VOFF + (tid >> 3) * REC_VS + 8 * (tid & 7);
        const unsigned vrd = (unsigned)(uintptr_t)(LAS unsigned char*)(lds + REC_VOFF) + (unsigned)((8 * (lane >> 4) + ((lane & 15) >> 2)) * REC_VS + 8 * (lane & 3));
        uint2 vreg = *(const uint2*)vsrc;
        __builtin_amdgcn_sched_barrier(0); __builtin_amdgcn_s_waitcnt(0); __builtin_amdgcn_sched_barrier(0);
        if (VAR != 2) { rec_load(RA, p, ((size_t)(b * 64)) * 4 + hd, d0, w, lane); __builtin_amdgcn_sched_barrier(0);
                        rec_load(RB, p, ((size_t)(b * 64 + 1)) * 4 + hd, d0, w, lane); __builtin_amdgcn_sched_barrier(0); }
        *(uint2*)vwr = vreg; vreg = *(const uint2*)(vsrc + (size_t)64 * GLA_NM);
        __syncthreads();
#define REC_STEP(CUR, NXT, c) do {                                                                                                             \
            __builtin_amdgcn_sched_barrier(0);     \
            bf16x8 bv[2][2];                                                                                                                     \
            _Pragma("unroll") for (int n = 0; n < 2; ++n) _Pragma("unroll") for (int ks = 0; ks < 2; ++ks) { s16x4 lo_, hi_; const unsigned a_ = vrd + (unsigned)(((c) & 1) * REC_VBUF + 32 * ks * REC_VS + 32 * n); \
                asm volatile("ds_read_b64_tr_b16 %0, %1" : "=&v"(lo_) : "v"(a_) : "memory");                                                       \
                asm volatile("ds_read_b64_tr_b16 %0, %1 offset:%2" : "=&v"(hi_) : "v"(a_), "i"(4 * REC_VS) : "memory");                               \
                asm volatile("s_waitcnt lgkmcnt(0)" ::: "memory");                                                                                 \
                const uint2 l2_ = __builtin_bit_cast(uint2, lo_), h2_ = __builtin_bit_cast(uint2, hi_);                                             \
                bv[n][ks] = __builtin_bit_cast(bf16x8, ((u32x4){l2_.x, l2_.y, h2_.x, h2_.y})); }                                                     \
            f32x4 acc[4][2];                                                                                                                     \
            { bf16x8 bs[2];                                                                                                                      \
              _Pragma("unroll") for (int n = 0; n < 2; ++n) { u32x4 sw; sw.x = cvtpk(S[0][n][0], S[0][n][1]); sw.y = cvtpk(S[0][n][2], S[0][n][3]);     \
                  sw.z = cvtpk(S[1][n][0], S[1][n][1]); sw.w = cvtpk(S[1][n][2], S[1][n][3]); bs[n] = __builtin_bit_cast(bf16x8, sw); }              \
              _Pragma("unroll") for (int mt = 0; mt < 4; ++mt) _Pragma("unroll") for (int n = 0; n < 2; ++n) acc[mt][n] = MFMA16(CUR.aq[mt], bs[n], ((f32x4){0.f, 0.f, 0.f, 0.f})); } \
            const int mp = w >> 1, np = w & 1;                                                                                                   \
            f32x4 accp = MFMA16(CUR.ap[0], (np ? bv[1][0] : bv[0][0]), ((f32x4){0.f, 0.f, 0.f, 0.f}));                                     \
            accp = MFMA16(CUR.ap[1], (np ? bv[1][1] : bv[0][1]), accp);                                                                   \
            __builtin_amdgcn_sched_barrier(0);                                                                                                   \
            if (VAR != 2) rec_load_a(CUR, p, ((size_t)(b * 64 + ((c) + 2 < 64 ? (c) + 2 : 63))) * 4 + hd, w, lane);     \
            __builtin_amdgcn_sched_barrier(0);                                                                                                   \
            if (VAR != 2) { *(uint2*)(vwr + (((c) + 1) & 1) * REC_VBUF) = vreg;     \
                vreg = *(const uint2*)(vsrc + (size_t)((c) + 2 < 64 ? (c) + 2 : 63) * 64 * GLA_NM); }                                                \
            __builtin_amdgcn_sched_barrier(0);                                                                                                   \
            _Pragma("unroll") for (int mt = 0; mt < 4; ++mt) _Pragma("unroll") for (int n = 0; n < 2; ++n) {                                      \
                const f32x4 v_ = (mt == mp && n == np) ? acc[mt][n] + accp : acc[mt][n];                                                          \
                _Pragma("unroll") for (int r_ = 0; r_ < 4; ++r_) red[(w * 64 + 16 * mt + 4 * fq + r_) * REC_LD + 16 * n + fr] = v_[r_]; }            \
            if (VAR != 1) __syncthreads();                                                                                                       \
            { const int t_ = tid >> 3, c4_ = (tid & 7) * 4; f32x4 s_ = *(const f32x4*)(red + t_ * REC_LD + c4_);                                  \
              _Pragma("unroll") for (int ww = 1; ww < 8; ++ww) s_ += *(const f32x4*)(red + (ww * 64 + t_) * REC_LD + c4_);                          \
              *(uint2*)(p.o + (size_t)(b * SEQ + (c) * 64 + t_) * DM + hd * 512 + d0 + c4_) = make_uint2(cvtpk(s_[0], s_[1]), cvtpk(s_[2], s_[3])); }     \
            _Pragma("unroll") for (int i = 0; i < 2; ++i) _Pragma("unroll") for (int n = 0; n < 2; ++n) {                                          \
                S[i][n] = S[i][n] * CUR.dv[i]; S[i][n] = MFMA16(CUR.ak[i][0], bv[n][0], S[i][n]); S[i][n] = MFMA16(CUR.ak[i][1], bv[n][1], S[i][n]); } \
            __builtin_amdgcn_sched_barrier(0);                                                                                                   \
            if (VAR != 2) { const int cn_ = (c) + 2 < 64 ? (c) + 2 : 63; rec_load_b(CUR, p, ((size_t)(b * 64 + cn_)) * 4 + hd, d0, w, lane); }     \
            if (VAR != 1) __syncthreads(); } while (0)
        for (int c = 0; c < 64; c += 2) { REC_STEP(RA, RB, c); REC_STEP(RB, RA, c + 1); }
#undef REC_STEP
    }
}

__device__ __forceinline__ void phase_gla_onorm(int wv, const Params& p, int l) {
    const int tid = ltid(wv), wid = wv, lane = tid & 63;
    const int bid_ = lbid(), ngrid_ = lgrid();
    const float* gn = p.gla_norm + l * 512 + 8 * lane;
    const f32x4 ga = *(const f32x4*)gn, gb = *(const f32x4*)(gn + 4);
    for (int row = bid_ * NWAVE + wid; row < TT; row += ngrid_ * NWAVE) {
        u32x4 ow[4], gw[4];
#pragma unroll
        for (int i = 0; i < 4; ++i) { const int c = 512 * i + 8 * lane; ow[i] = *(const u32x4*)(p.o + (size_t)row * DM + c); gw[i] = *(const u32x4*)(p.proj + (size_t)row * GLA_NM + 4096 + c); }
#pragma unroll
        for (int i = 0; i < 4; ++i) { const int c = 512 * i + 8 * lane;
            float o8[8], g8[8]; unpack8(ow[i], o8); unpack8(gw[i], g8);
            float ss = 0.f;
#pragma unroll
            for (int e = 0; e < 8; ++e) ss = fmaf(o8[e], o8[e], ss);
            ss = wave_sum_shfl(ss, lane);
            const float rs = rsqrtf(ss * (1.f / 512.f) + RMS_EPS);
            float y[8];
#pragma unroll
            for (int e = 0; e < 4; ++e) { y[e] = o8[e] * rs * ga[e] * (g8[e] * __builtin_amdgcn_rcpf(1.f + __expf(-g8[e]))); y[4 + e] = o8[4 + e] * rs * gb[e] * (g8[4 + e] * __builtin_amdgcn_rcpf(1.f + __expf(-g8[4 + e]))); }
            *(u32x4*)(p.og + (size_t)row * DM + c) = pack8f(y); }
    }
}

constexpr int TK_SC = 0;
template <int N> __device__ __forceinline__ void top_insert(float (&L)[N], float v) {
#pragma unroll
    for (int j = N - 1; j >= 1; --j) L[j] = __builtin_amdgcn_fmed3f(L[j - 1], L[j], v);
    L[0] = fmaxf(L[0], v);
}
__device__ __forceinline__ void phase_peer_topk(int wv, const Params& p, int l, unsigned char* lds) {
    const int tid = ltid(wv), wid = wv, lane = tid & 63, fr = lane & 15, fq = lane >> 4;
    const int bid_ = lbid(), ngrid_ = lgrid();
    float* sc = (float*)(lds + TK_SC); unsigned* scu = (unsigned*)(lds + TK_SC);
    const int hd = bid_ & 7, nm = (ngrid_ - hd + 7) >> 3, pp = wid >> 2, mq = wid & 3;
    bf16x8 bfr[8][4];
    { const bf16_t* bp = p.subk + ((size_t)((l * 8 + hd) * 2 + pp) * 128 + fr) * 128 + 8 * fq;
#pragma unroll
      for (int nt = 0; nt < 8; ++nt)
#pragma unroll
          for (int ks = 0; ks < 4; ++ks) bfr[nt][ks] = *(const bf16x8*)(bp + (size_t)nt * 16 * 128 + 32 * ks); }
    for (int tile = bid_ >> 3; tile < TT / 128; tile += nm) {
        const int tok0 = tile * 128;
        { const bf16_t* ap = p.pq + (size_t)(tok0 + 32 * mq + fr) * DM + hd * 256 + pp * 128 + 8 * fq;
          bf16x8 a[2][4];
#pragma unroll
          for (int m = 0; m < 2; ++m)
#pragma unroll
              for (int ks = 0; ks < 4; ++ks) a[m][ks] = *(const bf16x8*)(ap + (size_t)m * 16 * DM + 32 * ks);
#pragma unroll
          for (int m = 0; m < 2; ++m)
#pragma unroll
              for (int nt = 0; nt < 8; ++nt) { f32x4 acc = (f32x4){0.f, 0.f, 0.f, 0.f};
#pragma unroll
                  for (int ks = 0; ks < 4; ++ks) acc = MFMA16(a[m][ks], bfr[nt][ks], acc);
#pragma unroll
                  for (int i = 0; i < 4; ++i) sc[(pp * 128 + 32 * mq + 16 * m + 4 * fq + i) * 129 + 16 * nt + fr] = acc[i]; } }
        __syncthreads();
        { const int q = tid >> 1, half = tid & 1; const float* sp = sc + q * 129 + 64 * half;
          float L[16];
#pragma unroll
          for (int j = 0; j < 16; ++j) L[j] = -3.0e38f;
#pragma unroll
          for (int n = 0; n < 16; ++n) { const float v = __uint_as_float((__float_as_uint(sp[n]) & ~127u) | (unsigned)(64 * half + n));
#pragma unroll
              for (int j = 15; j >= 1; --j) if (j <= n) L[j] = __builtin_amdgcn_fmed3f(L[j - 1], L[j], v);
              L[0] = fmaxf(L[0], v); }
#pragma unroll 8
          for (int n = 16; n < 64; ++n) { const float v = __uint_as_float((__float_as_uint(sp[n]) & ~127u) | (unsigned)(64 * half + n)); top_insert<16>(L, v); }
#pragma unroll
          for (int j = 0; j < 16; ++j) scu[q * 129 + 64 * half + j] = __float_as_uint(L[j]); }
        __syncthreads();
        if (tid < 256) { const int q = tid; float M[16];
#pragma unroll
            for (int j = 0; j < 16; ++j) M[j] = fmaxf(sc[q * 129 + j], sc[q * 129 + 64 + 15 - j]);
#pragma unroll
            for (int d = 8; d >= 1; d >>= 1)
#pragma unroll
                for (int i = 0; i < 16; ++i) if ((i & d) == 0) { const float hi = fmaxf(M[i], M[i + d]), lo = fminf(M[i], M[i + d]); M[i] = hi; M[i + d] = lo; }
#pragma unroll
            for (int j = 0; j < 16; ++j) sc[q * 129 + j] = M[j]; }
        __syncthreads();
        if (tid < 128) { const int t = tid; const unsigned* ta = scu + t * 129; const unsigned* tb = scu + (128 + t) * 129;
            float a[16], b[16], M[16];
#pragma unroll
            for (int j = 0; j < 16; ++j) { a[j] = __uint_as_float(ta[j]); b[j] = __uint_as_float(tb[j]); M[j] = -3.0e38f; }
            int cnt = 0;
#pragma unroll
            for (int i = 0; i < 16; ++i)
#pragma unroll
                for (int j = 0; j < 16; ++j) if ((i + 1) * (j + 1) <= 16) { const float s = a[i] + b[j]; const float v = __uint_as_float((__float_as_uint(s) & ~255u) | (unsigned)(i * 16 + j));
#pragma unroll
                    for (int q = 15; q >= 1; --q) if (q <= cnt) M[q] = __builtin_amdgcn_fmed3f(M[q - 1], M[q], v);
                    M[0] = fmaxf(M[0], v); ++cnt; }
            float e[16], sum = 0.f;
#pragma unroll
            for (int r = 0; r < 16; ++r) { e[r] = __expf(M[r] - M[0]); sum += e[r]; }
            const float inv = 1.f / sum;
            unsigned idp[8];
#pragma unroll
            for (int r = 0; r < 16; ++r) { const unsigned code = __float_as_uint(M[r]) & 255u; const unsigned ia = ta[code >> 4] & 127u, ib = tb[code & 15u] & 127u, id = ia * 128u + ib;
                if (r & 1) idp[r >> 1] |= id << 16; else idp[r >> 1] = id; e[r] *= inv; }
            { unsigned short* ip = (unsigned short*)p.ids + (size_t)(tok0 + t) * 128 + hd * 16; float* wp = p.wts + (size_t)(tok0 + t) * 128 + hd * 16;
              *(u32x4*)ip = (u32x4){idp[0], idp[1], idp[2], idp[3]}; *(u32x4*)(ip + 8) = (u32x4){idp[4], idp[5], idp[6], idp[7]};
#pragma unroll
              for (int q = 0; q < 4; ++q) *(f32x4*)(wp + 4 * q) = (f32x4){e[4 * q], e[4 * q + 1], e[4 * q + 2], e[4 * q + 3]}; } }
        __syncthreads();
    }
}

__device__ __forceinline__ float ub0(unsigned w) { return (float)(w & 0xffu); }
__device__ __forceinline__ float ub1(unsigned w) { return (float)((w >> 8) & 0xffu); }
__device__ __forceinline__ float ub2(unsigned w) { return (float)((w >> 16) & 0xffu); }
__device__ __forceinline__ float ub3(unsigned w) { return (float)(w >> 24); }
__device__ __forceinline__ float row16_sum(float v) { v += dpp_f<0xB1>(v); v += dpp_f<0x4E>(v); v += dpp_f<0x141>(v); v += dpp_f<0x128>(v); return v; }
#define G_IDS(idr) u32x4 idw = (u32x4){0u, 0u, 0u, 0u}; if (c < 4) idw = *(const u32x4*)((idr) + 8 * c)
#define G_LOADB(R, T, bb) do { const unsigned ix_ = (unsigned)dpp_i<0x150 + (bb)>((int)idw.x), iy_ = (unsigned)dpp_i<0x150 + (bb)>((int)idw.y), iz_ = (unsigned)dpp_i<0x150 + (bb)>((int)idw.z), iw_ = (unsigned)dpp_i<0x150 + (bb)>((int)idw.w); \
            R[0] = *(const u32x4*)((T) + ((ix_ & 0xffffu) * (unsigned)DM + lo)); R[1] = *(const u32x4*)((T) + ((ix_ >> 16) * (unsigned)DM + lo)); R[2] = *(const u32x4*)((T) + ((iy_ & 0xffffu) * (unsigned)DM + lo)); R[3] = *(const u32x4*)((T) + ((iy_ >> 16) * (unsigned)DM + lo)); \
            R[4] = *(const u32x4*)((T) + ((iz_ & 0xffffu) * (unsigned)DM + lo)); R[5] = *(const u32x4*)((T) + ((iz_ >> 16) * (unsigned)DM + lo)); R[6] = *(const u32x4*)((T) + ((iw_ & 0xffffu) * (unsigned)DM + lo)); R[7] = *(const u32x4*)((T) + ((iw_ >> 16) * (unsigned)DM + lo)); } while (0)
__device__ __forceinline__ void phase_peer_gather1(int wv, const Params& p, int l) {
    const int tid = ltid(wv), lane = tid & 63, j = lane >> 4, c = lane & 15;
    const int bid_ = lbid(), ngrid_ = lgrid();
    const int r = bid_ & 7, m = bid_ >> 3, nm = (ngrid_ - r + 7) >> 3;
    const unsigned char* Ub = p.U8 + (size_t)l * 16384 * DM + 256 * r; const unsigned lo = 16u * (unsigned)c;
    bf16_t* ap = (bf16_t*)p.apart + (size_t)r * TT * 128;
    for (int tok = m * NWAVE + wv; tok < TT; tok += nm * NWAVE) {
        float hf[16];
        { const bf16_t* hp = p.h2 + (size_t)tok * DM + 256 * r + 16 * c; float t8[8];
          unpack8(*(const u32x4*)hp, t8);
#pragma unroll
          for (int e = 0; e < 8; ++e) hf[e] = t8[e];
          unpack8(*(const u32x4*)(hp + 8), t8);
#pragma unroll
          for (int e = 0; e < 8; ++e) hf[8 + e] = t8[e]; }
        float am = 0.f;
#pragma unroll
        for (int e = 0; e < 16; ++e) am = fmaxf(am, fabsf(hf[e]));
        am = fmaxf(am, dpp_f<0xB1>(am)); am = fmaxf(am, dpp_f<0x4E>(am)); am = fmaxf(am, dpp_f<0x141>(am)); am = fmaxf(am, dpp_f<0x128>(am));
        const float sh = fmaxf(am, 1e-30f) * (1.f / 127.f), ish = 1.f / sh;
        int hq[4];
#pragma unroll
        for (int q = 0; q < 4; ++q) hq[q] = ((int)rintf(hf[4 * q] * ish) & 0xff) | (((int)rintf(hf[4 * q + 1] * ish) & 0xff) << 8) | (((int)rintf(hf[4 * q + 2] * ish) & 0xff) << 16) | ((int)rintf(hf[4 * q + 3] * ish) << 24);
        G_IDS((const unsigned short*)p.ids + (size_t)tok * 128 + 32 * j);
        int keep0 = 0, keep1 = 0;
        u32x4 RA[8], RB[8];
#define G_COMP1(R, bb) do { _Pragma("unroll") for (int i = 0; i < 8; ++i) { int d_ = __builtin_amdgcn_sdot4((int)R[i][0], hq[0], 0, false);              \
                d_ = __builtin_amdgcn_sdot4((int)R[i][1], hq[1], d_, false); d_ = __builtin_amdgcn_sdot4((int)R[i][2], hq[2], d_, false); d_ = __builtin_amdgcn_sdot4((int)R[i][3], hq[3], d_, false); \
                d_ += dpp_i<0xB1>(d_); d_ += dpp_i<0x4E>(d_); d_ += dpp_i<0x141>(d_); d_ += dpp_i<0x128>(d_);                                        \
                const int q_ = 8 * (bb) + i;                                                                                                      \
                if ((q_ & 1) == 0) keep0 = (c == (q_ >> 1)) ? d_ : keep0; else keep1 = (c == (q_ >> 1)) ? d_ : keep1; } } while (0)
        G_LOADB(RA, Ub, 0); G_LOADB(RB, Ub, 1); G_COMP1(RA, 0); G_LOADB(RA, Ub, 2); G_COMP1(RB, 1); G_LOADB(RB, Ub, 3); G_COMP1(RA, 2); G_COMP1(RB, 3);
#undef G_COMP1
        *(unsigned*)(ap + (size_t)tok * 128 + 32 * j + 2 * c) = cvtpk((float)keep0 * sh, (float)keep1 * sh);
    }
}
__device__ __forceinline__ void phase_peer_coef(int wv, const Params& p, int l) {
    const int tid = ltid(wv), lane = tid & 63;
    const int bid_ = lbid(), ngrid_ = lgrid();
    const float* su = p.su + (size_t)l * 16384; const float* sv = p.sv + (size_t)l * 16384;
    for (int t0 = (bid_ * NWAVE + wv) * 4; t0 < TT; t0 += ngrid_ * NWAVE * 4) {
        unsigned idw[4]; float w0[4], w1[4], a0[4], a1[4];
#pragma unroll
        for (int i = 0; i < 4; ++i) { const size_t tk = (size_t)(t0 + i) * 128 + 2 * lane; idw[i] = *(const unsigned*)((const unsigned short*)p.ids + tk); const float2 ww = *(const float2*)(p.wts + tk); w0[i] = ww.x; w1[i] = ww.y; a0[i] = 0.f; a1[i] = 0.f; }
#pragma unroll
        for (int rr = 0; rr < 8; ++rr)
#pragma unroll
            for (int i = 0; i < 4; ++i) { const unsigned qq = *(const unsigned*)((const bf16_t*)p.apart + ((size_t)rr * TT + t0 + i) * 128 + 2 * lane); a0[i] += __uint_as_float(qq << 16); a1[i] += __uint_as_float(qq & 0xffff0000u); }
        float u0[4], u1[4], v0[4], v1[4];
#pragma unroll
        for (int i = 0; i < 4; ++i) { const unsigned e0 = idw[i] & 0xffffu, e1 = idw[i] >> 16; u0[i] = su[e0]; u1[i] = su[e1]; v0[i] = sv[e0]; v1[i] = sv[e1]; }
#pragma unroll
        for (int i = 0; i < 4; ++i) { const int tok = t0 + i;
            const float c0 = w0[i] * gelu_tanh(a0[i] * u0[i]) * v0[i], c1 = w1[i] * gelu_tanh(a1[i] * u1[i]) * v1[i];
            float cm = fmaxf(fabsf(c0), fabsf(c1));
            cm = fmaxf(cm, dpp_f<0xB1>(cm)); cm = fmaxf(cm, dpp_f<0x4E>(cm)); cm = fmaxf(cm, dpp_f<0x141>(cm)); cm = fmaxf(cm, dpp_f<0x128>(cm));
            cm = fmaxf(fmaxf(rdlane(cm, 0), rdlane(cm, 16)), fmaxf(rdlane(cm, 32), rdlane(cm, 48)));
            const float sc = fmaxf(cm, 1e-30f) * (1.f / 127.f), isc = 1.f / sc;
            *(unsigned short*)(p.cqbuf + (size_t)tok * 128 + 2 * lane) = (unsigned short)(((int)rintf(c0 * isc) & 0xff) | (((int)rintf(c1 * isc) & 0xff) << 8));
            if (lane == 0) p.scbuf[tok] = sc; }
    }
}
__device__ __forceinline__ void phase_peer_gather2(int wv, const Params& p, int l, const float* gate  ) {
    const int tid = ltid(wv), lane = tid & 63, j = lane >> 4, c = lane & 15;
    const int bid_ = lbid(), ngrid_ = lgrid();
    const int r = bid_ & 7, m = bid_ >> 3, nm = (ngrid_ - r + 7) >> 3;
    const unsigned char* Vb = p.V8 + (size_t)l * 16384 * DM + 256 * r; const unsigned lo = 16u * (unsigned)c;
    for (int tok = m * NWAVE + wv; tok < TT; tok += nm * NWAVE) {
        const float sc = p.scbuf[tok];
        bf16_t* xp = p.xbuf + (size_t)tok * DM + 256 * r + 16 * c; const float* gp = gate + (size_t)(tok >> 12) * 12288 + 256 * r + 16 * c;
        f32x4 ga[4] = {}; u32x4 xw0 = (u32x4){0u, 0u, 0u, 0u}, xw1 = (u32x4){0u, 0u, 0u, 0u};
        if (j == 0) { xw0 = *(const u32x4*)xp; xw1 = *(const u32x4*)(xp + 8);
#pragma unroll
            for (int q = 0; q < 4; ++q) ga[q] = *(const f32x4*)(gp + 4 * q); }
        G_IDS((const unsigned short*)p.ids + (size_t)tok * 128 + 32 * j);
        int4 cqv = make_int4(0, 0, 0, 0); if (c < 2) cqv = *(const int4*)(p.cqbuf + (size_t)tok * 128 + 32 * j + 16 * c);
        const int cqw[8] = {dpp_i<0x150>(cqv.x), dpp_i<0x150>(cqv.y), dpp_i<0x150>(cqv.z), dpp_i<0x150>(cqv.w), dpp_i<0x151>(cqv.x), dpp_i<0x151>(cqv.y), dpp_i<0x151>(cqv.z), dpp_i<0x151>(cqv.w)};
        int yi[16];
#pragma unroll
        for (int e = 0; e < 16; ++e) yi[e] = 0;
        u32x4 RA[8], RB[8];
#define G_COMP2(R, bb) do { _Pragma("unroll") for (int g = 0; g < 2; ++g) { const int cq_ = cqw[2 * (bb) + g];                                            \
                _Pragma("unroll") for (int d = 0; d < 4; ++d) { const unsigned W0 = R[4 * g][d], W1 = R[4 * g + 1][d], W2 = R[4 * g + 2][d], W3 = R[4 * g + 3][d];       \
                    const unsigned A_ = __builtin_amdgcn_perm(W1, W0, 0x05010400u), B_ = __builtin_amdgcn_perm(W1, W0, 0x07030602u);                  \
                    const unsigned C_ = __builtin_amdgcn_perm(W3, W2, 0x05010400u), D_ = __builtin_amdgcn_perm(W3, W2, 0x07030602u);                  \
                    yi[4 * d + 0] = __builtin_amdgcn_sdot4((int)__builtin_amdgcn_perm(C_, A_, 0x05040100u), cq_, yi[4 * d + 0], false);                 \
                    yi[4 * d + 1] = __builtin_amdgcn_sdot4((int)__builtin_amdgcn_perm(C_, A_, 0x07060302u), cq_, yi[4 * d + 1], false);                 \
                    yi[4 * d + 2] = __builtin_amdgcn_sdot4((int)__builtin_amdgcn_perm(D_, B_, 0x05040100u), cq_, yi[4 * d + 2], false);                 \
                    yi[4 * d + 3] = __builtin_amdgcn_sdot4((int)__builtin_amdgcn_perm(D_, B_, 0x07060302u), cq_, yi[4 * d + 3], false); } } } while (0)
        G_LOADB(RA, Vb, 0); G_LOADB(RB, Vb, 1); G_COMP2(RA, 0); G_LOADB(RA, Vb, 2); G_COMP2(RB, 1); G_LOADB(RB, Vb, 3); G_COMP2(RA, 2); G_COMP2(RB, 3);
#undef G_COMP2
        float y[16];
#pragma unroll
        for (int e = 0; e < 16; ++e) { int v = yi[e]; v += __builtin_amdgcn_ds_bpermute((lane ^ 16) << 2, v); v += __builtin_amdgcn_ds_bpermute((lane ^ 32) << 2, v); y[e] = (float)v * sc; }
        if (j == 0) { float x0[8], x1[8]; unpack8(xw0, x0); unpack8(xw1, x1);
#pragma unroll
            for (int e = 0; e < 8; ++e) { x0[e] += ga[e >> 2][e & 3] * y[e]; x1[e] += ga[2 + (e >> 2)][e & 3] * y[8 + e]; }
            *(u32x4*)xp = pack8f(x0); *(u32x4*)(xp + 8) = pack8f(x1); }
    }
}
#undef G_LOADB
#undef G_IDS

__device__ __forceinline__ void phase_fl(int wv, const Params& p, unsigned char* lds) {
    const int tid = ltid(wv); float* gls = (float*)lds;
    const int bid_ = lbid(), ngrid_ = lgrid();
    for (int u = bid_; u < 256; u += ngrid_) {
        mini16(wv, p.hk + (size_t)u * 64 * DM, p.W16_kv, gls);
        __syncthreads();
#pragma unroll
        for (int i = 0; i < 2; ++i) { const int o = tid + NTHR * i; p.fl[(size_t)u * 1024 + o] = gls[o] + gls[1024 + o]; }
        __syncthreads();
    }
}
__device__ __forceinline__ void phase_fscan(int wv, const Params& p, unsigned char* lds) {
    const int tid = ltid(wv), lane = tid & 63;
    const int bid_ = lbid(), ngrid_ = lgrid();
    float* red = (float*)lds;
    for (int u = bid_; u < 64; u += ngrid_) {
        const int b = u >> 4, hd = u & 15; const float bf = p.fox_b_f[hd];
        const float* fp = p.fl + ((size_t)b * SEQ + 8 * tid) * 16 + hd;
        float x[8], v[8], tot = 0.f;
#pragma unroll
        for (int i = 0; i < 8; ++i) x[i] = fp[(size_t)i * 16];
#pragma unroll
        for (int i = 0; i < 8; ++i) { v[i] = log_sigmoidf(x[i] + bf); tot += v[i]; }
        float incl = tot;
#pragma unroll
        for (int d = 1; d < 64; d <<= 1) { const float n = shfl_idx(incl, (lane - d) & 63); if (lane >= d) incl += n; }
        __syncthreads();
        if (lane == 63) red[wv] = incl;
        __syncthreads();
        float run = incl - tot;
#pragma unroll
        for (int w = 0; w < NWAVE - 1; ++w) run += (w < wv) ? red[w] : 0.f;
        float o[8];
#pragma unroll
        for (int i = 0; i < 8; ++i) { run += v[i]; o[i] = run * (-11.313708498984761f); }
        float* op = p.Fa + (size_t)u * SEQ + 8 * tid;
        *(f32x4*)op = (f32x4){o[0], o[1], o[2], o[3]}; *(f32x4*)(op + 4) = (f32x4){o[4], o[5], o[6], o[7]};
    }
}
__device__ __forceinline__ float slab_max_norm2(int wv, const bf16_t* slab, float* red) {
    const int tid = ltid(wv), lane = tid & 63;
    const bf16_t* rp = slab + (size_t)(tid >> 4) * DM + (tid & 15) * 8;
    u32x4 w[8];
#pragma unroll
    for (int i = 0; i < 8; ++i) w[i] = *(const u32x4*)(rp + (size_t)i * 32 * DM);
    float m = 0.f;
#pragma unroll
    for (int i = 0; i < 8; ++i) { float v8[8]; unpack8(w[i], v8); float ss = 0.f;
#pragma unroll
        for (int e = 0; e < 8; ++e) ss = fmaf(v8[e], v8[e], ss);
        m = fmaxf(m, row16_sum(ss)); }
    m = fmaxf(fmaxf(rdlane(m, 0), rdlane(m, 16)), fmaxf(rdlane(m, 32), rdlane(m, 48)));
    __syncthreads();
    if (lane == 0) red[wv] = m;
    __syncthreads();
    float r = red[0];
#pragma unroll
    for (int w_ = 1; w_ < 8; ++w_) r = fmaxf(r, red[w_]);
    return r;
}
__device__ __forceinline__ void phase_knorm(int wv, const Params& p, unsigned char* lds) {
    const int tid = ltid(wv); const int bid_ = lbid(), ngrid_ = lgrid();
    for (int u = bid_; u < 1024; u += ngrid_) { const int bh = u >> 4, qb = u & 15;
        const float r = slab_max_norm2(wv, p.Kb + ((size_t)(bh >> 4) * SEQ + (size_t)qb * 256) * DM + (bh & 15) * 128, (float*)lds);
        if (tid == 0) p.kn2[u] = r; }
}
__device__ __forceinline__ void phase_qn(int wv, const Params& p, unsigned char* lds) {
    const int tid = ltid(wv), lane = tid & 63; const int bid_ = lbid(), ngrid_ = lgrid();
    for (int u = bid_; u < 1024; u += ngrid_) { const int bh = u >> 4, qb = u & 15, P0 = qb * 256;
        const float qn2 = slab_max_norm2(wv, p.qb + ((size_t)(bh >> 4) * SEQ + (size_t)P0) * DM + (bh & 15) * 128, (float*)lds);
        if (wv == 0) {
            float k2 = (lane <= qb) ? p.kn2[bh * 16 + lane] : 0.f;
            k2 = fmaxf(k2, dpp_f<0xB1>(k2)); k2 = fmaxf(k2, dpp_f<0x4E>(k2)); k2 = fmaxf(k2, dpp_f<0x141>(k2)); k2 = fmaxf(k2, dpp_f<0x128>(k2));
            k2 = rdlane(k2, 0);
            const float D = 2.02f * sqrtf(qn2 * k2) + 30.f * 11.313708498984761f;
            const float* Fb = p.Fa + (size_t)bh * SEQ; const float ref = Fb[P0] - D;
            const int e = 64 * lane + 63; const bool skip = (e < P0) && (Fb[e] < ref);
            const unsigned long long bal = __ballot(skip);
            const int j = (int)__builtin_ctzll(~bal);
            if (lane == 0) p.jlo[u] = j; }
    }
}
__device__ __forceinline__ void phase_fox_gate(int wv, const Params& p) {
    const int tid = ltid(wv); const int bid_ = lbid(), ngrid_ = lgrid();
    const size_t stride = (size_t)ngrid_ * NTHR * 8;
    for (size_t e0 = ((size_t)bid_ * NTHR + tid) * 8; e0 < (size_t)TT * DM; e0 += 4 * stride) {
        u32x4 ow[4], gw[4];
#pragma unroll
        for (int i = 0; i < 4; ++i) { const size_t e = e0 + i * stride; ow[i] = *(const u32x4*)(p.ob + e); gw[i] = *(const u32x4*)(p.gb + e); }
#pragma unroll
        for (int i = 0; i < 4; ++i) { float o8[8], g8[8], y[8]; unpack8(ow[i], o8); unpack8(gw[i], g8);
#pragma unroll
            for (int j = 0; j < 8; ++j) y[j] = o8[j] * sigmoidf_(g8[j]);
            *(u32x4*)(p.og + e0 + i * stride) = pack8f(y); }
    }
}

namespace fa {
constexpr int D = 128, RS = 2048;
constexpr float SCALE = 0.08838834764831845f, THR = 16.f;
constexpr int NW = 8, QBLK = 32, KVBLK = 64, QB = NW * QBLK;
constexpr int SHM_V = KVBLK * D * 2, SHM_K = KVBLK * D * 2, SHM_A = KVBLK * 4;
constexpr int OFF_K = 2 * SHM_V, OFF_WS = 2 * SHM_V + 2 * SHM_K, OFF_A = OFF_WS + NW * 64 * 4, LDS_BYTES = OFF_A + 2 * SHM_A;
#define KSWZ(row, colB) ((row) * 256 + ((colB) ^ (((row) & 7) << 4)))
#define SBAR() __builtin_amdgcn_sched_barrier(0)
__device__ __forceinline__ int v_st(int k, int c) { const int kk = (k & ~0xC) | ((k & 4) << 1) | ((k & 8) >> 1); return ((kk >> 3) * 4 + (c >> 5)) * 512 + ((kk & 7) * 32 + (c & 31)) * 2; }
__device__ __forceinline__ int v_rd_base(int lane) { return ((lane & 3) << 3) | (((lane >> 2) & 3) << 6) | (((lane >> 4) & 1) << 5) | (((lane >> 5) & 1) << 8); }
constexpr int v_rd_off(int d0, int ks, int half) { return d0 * 512 + ks * 4096 + half * 2048; }
__device__ __forceinline__ int crow(int r, int hi) { return (r & 3) + 8 * (r >> 2) + 4 * hi; }
__device__ __forceinline__ unsigned cvtpkv(float lo, float hi) { unsigned r; asm volatile("v_cvt_pk_bf16_f32 %0, %1, %2" : "=v"(r) : "v"(lo), "v"(hi)); return r; }
__device__ __forceinline__ bf16x8 load8(const bf16_t* p) { return *reinterpret_cast<const bf16x8*>(p); }
__device__ __forceinline__ void mask_tile(f32x16& p0, f32x16& p1, int dq) {
    const float NEG = -__builtin_inff();
#pragma unroll
    for (int r = 0; r < 16; ++r) { const int c = (r & 3) + 8 * (r >> 2); if (dq - c < 0) p0[r] = NEG; if (dq - c - 32 < 0) p1[r] = NEG; }
}
__device__ __forceinline__ void partialSM(f32x16& p0, f32x16& p1, float& m_reg, float& mn, float& alpha) {
    float pmax = p0[0]; for (int r = 1; r < 16; ++r) pmax = fmaxf(pmax, p0[r]); for (int r = 0; r < 16; ++r) pmax = fmaxf(pmax, p1[r]);
    { auto rr = __builtin_amdgcn_permlane32_swap(__float_as_uint(pmax), __float_as_uint(pmax), false, false);
      pmax = fmaxf(__uint_as_float(rr[0]), __uint_as_float(rr[1])); }
    constexpr float C2 = 1.4426950408889634f * SCALE;
    if (__builtin_expect(__all((pmax - m_reg) * SCALE <= THR), 1)) { mn = m_reg; alpha = 1.f; }
    else { mn = fmaxf(m_reg, pmax); alpha = __builtin_amdgcn_exp2f((m_reg - mn) * C2); m_reg = mn; }
    const float mnL = -mn * C2;
    for (int r = 0; r < 16; ++r) p0[r] = fmaf(p0[r], C2, mnL); for (int r = 0; r < 16; ++r) p1[r] = fmaf(p1[r], C2, mnL);
    for (int r = 0; r < 16; ++r) p0[r] = __builtin_amdgcn_exp2f(p0[r]);
}
__device__ __forceinline__ void finishSM(f32x16& p0, f32x16& p1, float alpha, float& l_reg, bf16x8& pa0, bf16x8& pa1, bf16x8& pa2, bf16x8& pa3) {
    for (int r = 0; r < 16; ++r) p1[r] = __builtin_amdgcn_exp2f(p1[r]);
    float ps = 0; for (int r = 0; r < 16; ++r) ps += p0[r]; for (int r = 0; r < 16; ++r) ps += p1[r];
    { auto rr = __builtin_amdgcn_permlane32_swap(__float_as_uint(ps), __float_as_uint(ps), false, false);
      ps = __uint_as_float(rr[0]) + __uint_as_float(rr[1]); }
    l_reg = l_reg * alpha + ps;
#define PK4(P, B_, OUT) do { unsigned a0 = cvtpkv(P[B_+0], P[B_+1]), a1 = cvtpkv(P[B_+2], P[B_+3]);                          \
        unsigned b0 = cvtpkv(P[B_+4], P[B_+5]), b1 = cvtpkv(P[B_+6], P[B_+7]);                                             \
        auto r0 = __builtin_amdgcn_permlane32_swap(a0, b0, false, false); auto r1 = __builtin_amdgcn_permlane32_swap(a1, b1, false, false); \
        u32x4 w = {r0[0], r1[0], r0[1], r1[1]}; OUT = *reinterpret_cast<bf16x8*>(&w); } while (0)
    PK4(p0, 0, pa0); PK4(p0, 8, pa1); PK4(p1, 0, pa2); PK4(p1, 8, pa3);
#undef PK4
}
template <int KB>
__device__ __forceinline__ void qkt(f32x16& p0, f32x16& p1, const char* K_lds, int r32, int hi, const bf16x8* qr) {
    p0 = f32x16{}; p1 = f32x16{};
    const char* kb[4];
#pragma unroll
    for (int dd = 0; dd < 4; ++dd) kb[dd] = K_lds + KB * SHM_K + KSWZ(r32, (dd * 16 + hi * 8) * 2);
#pragma unroll
    for (int d0 = 0; d0 < 8; ++d0) { const char* a = kb[d0 & 3] + (d0 >> 2) * 128;
        bf16x8 b0 = *reinterpret_cast<const bf16x8*>(a);
        bf16x8 b1 = *reinterpret_cast<const bf16x8*>(a + 32 * 256);
        p0 = __builtin_amdgcn_mfma_f32_32x32x16_bf16(b0, qr[d0], p0, 0, 0, 0);
        p1 = __builtin_amdgcn_mfma_f32_32x32x16_bf16(b1, qr[d0], p1, 0, 0, 0); }
}
template <int VB>
__device__ __forceinline__ void pv_tile(f32x16* o, int vb0, bf16x8 pa0, bf16x8 pa1, bf16x8 pa2, bf16x8 pa3) {
#define TRRD(dst, off) asm volatile("ds_read_b64_tr_b16 %0, %1 offset:%2" : "=&v"(dst) : "v"(vb0), "i"(off) : "memory")
#define PV_D0(d0) do { constexpr int b_ = VB * SHM_V + v_rd_off(d0, 0, 0); \
        { s16x4 l0, l1, h0, h1; TRRD(l0, b_); TRRD(h0, b_ + 2048); TRRD(l1, b_ + 4096); TRRD(h1, b_ + 6144); \
          asm volatile("s_waitcnt lgkmcnt(0)" ::: "memory"); SBAR();   \
          o[d0] = __builtin_amdgcn_mfma_f32_32x32x16_bf16(pa0, (bf16x8){l0[0], l0[1], l0[2], l0[3], h0[0], h0[1], h0[2], h0[3]}, o[d0], 0, 0, 0);   \
          o[d0] = __builtin_amdgcn_mfma_f32_32x32x16_bf16(pa1, (bf16x8){l1[0], l1[1], l1[2], l1[3], h1[0], h1[1], h1[2], h1[3]}, o[d0], 0, 0, 0); } \
        { s16x4 l2, l3, h2, h3; TRRD(l2, b_ + 8192); TRRD(h2, b_ + 10240); TRRD(l3, b_ + 12288); TRRD(h3, b_ + 14336); \
          asm volatile("s_waitcnt lgkmcnt(0)" ::: "memory"); SBAR();   \
          o[d0] = __builtin_amdgcn_mfma_f32_32x32x16_bf16(pa2, (bf16x8){l2[0], l2[1], l2[2], l2[3], h2[0], h2[1], h2[2], h2[3]}, o[d0], 0, 0, 0);   \
          o[d0] = __builtin_amdgcn_mfma_f32_32x32x16_bf16(pa3, (bf16x8){l3[0], l3[1], l3[2], l3[3], h3[0], h3[1], h3[2], h3[3]}, o[d0], 0, 0, 0); } } while (0)
    PV_D0(0); PV_D0(1); PV_D0(2); PV_D0(3);
#undef PV_D0
#undef TRRD
}
struct Ptrs { const bf16_t* qb; const bf16_t* Kb; const bf16_t* Vb; const float* Fa; bf16_t* ob; const bf16_t* gb; };
struct BlockRef { unsigned qo, ko, fo; int P0; };
struct Seam { bf16x8 qr[8]; bf16x8 st_v0, st_v1, st_k0, st_k1; };
#define VMW() asm volatile("s_waitcnt vmcnt(0)" ::: "memory")
#define VMWN(n) asm volatile("s_waitcnt vmcnt(%0)" :: "i"(n) : "memory")
#define SLOAD_H(Kp, Vp, k0) do { const bf16_t* kt_ = (Kp) + (size_t)(k0) * RS; const bf16_t* vt_ = (Vp) + (size_t)(k0) * RS;                       \
        S.st_v0 = load8(vt_ + svo); S.st_v1 = load8(vt_ + 32 * RS + svo); S.st_k0 = load8(kt_ + svo); S.st_k1 = load8(kt_ + 32 * RS + svo); } while (0)
#define ALOAD(Fp, k0, bf) do { if (wid == 0) __builtin_amdgcn_global_load_lds((const unsigned*)((Fp) + (size_t)((k0) + lane)), (LAS unsigned*)(ldsl + OFF_A + (bf) * SHM_A), 4, 0, 0); } while (0)
#define SWRITE_HK(bf) do { *(bf16x8*)(K_lds + (bf) * SHM_K + kws) = S.st_k0; *(bf16x8*)(K_lds + (bf) * SHM_K + kws + 32 * 256) = S.st_k1; } while (0)
#define SWRITE_HV(bf) do { *(bf16x8*)(V_lds + (bf) * SHM_V + vst0) = S.st_v0; *(bf16x8*)(V_lds + (bf) * SHM_V + vst1) = S.st_v1; } while (0)
#define SWRITE_H(bf) do { SWRITE_HV(bf); SWRITE_HK(bf); } while (0)
__device__ __forceinline__ void attn_prime(int wv, const Ptrs& P, const BlockRef& cur, char* lds, LAS unsigned char* ldsl, Seam& S) {
    const int tid = ltid(wv), wid = wv, lane = tid & 63, r32 = lane & 31, hi = lane >> 5;
    const int bid_ = lbid(), ngrid_ = lgrid();
    const int sr = tid >> 4, sc = (tid & 15) * 8, kws = KSWZ(sr, sc * 2); char* K_lds = lds + OFF_K;
    const unsigned svo = (unsigned)(sr * RS + sc), qvo = (unsigned)(r32 * RS + hi * 8);
    { const bf16_t* qw = P.qb + cur.qo + (size_t)(wid * QBLK) * RS;
      for (int d0 = 0; d0 < 8; ++d0) S.qr[d0] = load8(qw + qvo + d0 * 16); }
    SLOAD_H(P.Kb + cur.ko, P.Vb + cur.ko, 0); ALOAD(P.Fa + cur.fo, 0, 0); VMW(); SWRITE_HK(0);
    __syncthreads();
}
__device__ __forceinline__ void attn_block(int wv, const Ptrs& P, const BlockRef& cur, const BlockRef& nxt, char* lds, LAS unsigned char* ldsl, Seam& S) {
    const int tid = ltid(wv), wid = wv, lane = tid & 63, r32 = lane & 31, hi = lane >> 5;
    const int bid_ = lbid(), ngrid_ = lgrid();
    const int NT = (cur.P0 + QB - 1) / KVBLK + 1;
    const int qlo = cur.P0 + wid * QBLK, qm = qlo + r32 - 4 * hi;
    char* V_lds = lds; char* K_lds = lds + OFF_K; const char* A_lds = lds + OFF_A;
    float* ws = (float*)(lds + OFF_WS) + wid * 64; float* li_l = ws, * al_l = ws + 32;
    float m_reg = -1e30f, l_reg = 0; f32x16 o[4] = {};
    const int sr = tid >> 4, sc = (tid & 15) * 8, vst0 = v_st(sr, sc), vst1 = v_st(32 + sr, sc), kws = KSWZ(sr, sc * 2);
    const unsigned svo = (unsigned)(sr * RS + sc), qvo = (unsigned)(r32 * RS + hi * 8);
    const int vb0 = (int)(uintptr_t)V_lds + v_rd_base(lane);
    const bf16_t* Kh = P.Kb + cur.ko; const bf16_t* Vh = P.Vb + cur.ko; const float* Fh = P.Fa + cur.fo;
#define RESC(a) do { if (__any((a) < 1.f)) { if (hi == 0) al_l[r32] = (a); asm volatile("s_waitcnt lgkmcnt(0)" ::: "memory");              \
                     for (int d_ = 0; d_ < 4; ++d_) for (int r = 0; r < 16; ++r) o[d_][r] *= al_l[crow(r, hi)]; } } while (0)
#define KBASE(t) ((t) * KVBLK)
#define ADDB(P0_, P1_, KB) do { const float* bp_ = (const float*)(A_lds + (KB) * SHM_A) + 4 * hi;                                      \
        _Pragma("unroll") for (int q_ = 0; q_ < 4; ++q_) { const f32x4 b0_ = *(const f32x4*)(bp_ + 8 * q_), b1_ = *(const f32x4*)(bp_ + 32 + 8 * q_); \
            _Pragma("unroll") for (int e_ = 0; e_ < 4; ++e_) { P0_[4 * q_ + e_] += b0_[e_]; P1_[4 * q_ + e_] += b1_[e_]; } } } while (0)
#define MASKT(P0_, P1_, t) do { const int kb_ = KBASE(t); if (kb_ + KVBLK - 1 > qlo) mask_tile(P0_, P1_, qm - kb_); } while (0)
    constexpr int NQL = 8;
#define SEAM_K0() do { VMWN(NQL); SWRITE_HK(0); SBAR(); } while (0)
    f32x16 pA0, pA1, pB0, pB1; float mnA, mnB, alA, alB; bf16x8 pa0, pa1, pa2, pa3;
    SWRITE_HV(0); SBAR();
    SLOAD_H(Kh, Vh, KBASE(1)); ALOAD(Fh, KBASE(1), 1);
    SBAR(); qkt<0>(pA0, pA1, K_lds, r32, hi, S.qr);
    ADDB(pA0, pA1, 0); MASKT(pA0, pA1, 0); partialSM(pA0, pA1, m_reg, mnA, alA);
    VMW(); SWRITE_H(1);
    __syncthreads();
#define HALF_STEP(PX0, PX1, mnX, alX, PY0, PY1, alY, t, KB, VB, SB) do {                                                      \
        SBAR(); qkt<KB>(PX0, PX1, K_lds, r32, hi, S.qr);                                                         \
        finishSM(PY0, PY1, alY, l_reg, pa0, pa1, pa2, pa3); SBAR();                                                           \
        if ((t) + 1 < NT) { SLOAD_H(Kh, Vh, KBASE((t) + 1)); ALOAD(Fh, KBASE((t) + 1), SB); SBAR(); }                         \
        pv_tile<VB>(o, vb0, pa0, pa1, pa2, pa3); ADDB(PX0, PX1, KB); MASKT(PX0, PX1, (t)); partialSM(PX0, PX1, m_reg, mnX, alX);                  \
        __syncthreads();                                                                                                      \
        if ((t) + 1 < NT) { VMW(); SWRITE_H(SB); }                                                                            \
        RESC(alX); __syncthreads(); } while (0)
    for (int t = 1; t + 1 < NT; t += 2) {
        HALF_STEP(pB0, pB1, mnB, alB, pA0, pA1, alA, t, 1, 0, 0);
        HALF_STEP(pA0, pA1, mnA, alA, pB0, pB1, alB, t + 1, 0, 1, 1);
    }
    const bool even = (NT & 1) == 0;
    if (even) { SBAR(); qkt<1>(pB0, pB1, K_lds, r32, hi, S.qr); SBAR(); }
    SLOAD_H(P.Kb + nxt.ko, P.Vb + nxt.ko, 0); ALOAD(P.Fa + nxt.fo, 0, 0); SBAR();
    { const bf16_t* qw = P.qb + nxt.qo + (size_t)(wid * QBLK) * RS;
#pragma unroll
      for (int d0 = 0; d0 < 8; ++d0) S.qr[d0] = load8(qw + qvo + d0 * 16); }
    SBAR();
    finishSM(pA0, pA1, alA, l_reg, pa0, pa1, pa2, pa3); SBAR();
    pv_tile<0>(o, vb0, pa0, pa1, pa2, pa3);
    if (even) { ADDB(pB0, pB1, 1); MASKT(pB0, pB1, NT - 1); partialSM(pB0, pB1, m_reg, mnB, alB); __syncthreads(); RESC(alB);
        finishSM(pB0, pB1, alB, l_reg, pa0, pa1, pa2, pa3); SBAR(); pv_tile<1>(o, vb0, pa0, pa1, pa2, pa3); }
    SBAR(); SEAM_K0();
    if (hi == 0) li_l[r32] = l_reg; asm volatile("s_waitcnt lgkmcnt(0)" ::: "memory");
    float rli[16];
#pragma unroll
    for (int r = 0; r < 16; ++r) rli[r] = __builtin_amdgcn_rcpf(li_l[crow(r, hi)]);
    bf16_t* Ow = P.ob + cur.qo + (size_t)(wid * QBLK) * RS;
    const bf16_t* Gw = P.gb + cur.qo + (size_t)(wid * QBLK) * RS;
    const unsigned ovo = (unsigned)(4 * hi * RS + r32);
    unsigned short gq[16][4];
#pragma unroll
    for (int r = 0; r < 16; ++r) { const bf16_t* growp = Gw + (size_t)((r & 3) + 8 * (r >> 2)) * RS;
#pragma unroll
        for (int d0 = 0; d0 < 4; ++d0) gq[r][d0] = growp[ovo + d0 * 32]; }
#pragma unroll
    for (int r = 0; r < 16; ++r) { bf16_t* rowp = Ow + (size_t)((r & 3) + 8 * (r >> 2)) * RS;
#pragma unroll
        for (int d0 = 0; d0 < 4; ++d0) { const float gl_ = __uint_as_float((unsigned)gq[r][d0] << 16);
            const float v = o[d0][r] * rli[r] * __builtin_amdgcn_rcpf(1.f + __expf(-gl_)); const float vn = shfl_idx(v, lane ^ 1);
            if ((r32 & 1) == 0) *(unsigned*)(rowp + ovo + d0 * 32) = cvtpkv(v, vn); } }
    __syncthreads();
#undef RESC
#undef ADDB
#undef KBASE
#undef MASKT
#undef SEAM_K0
#undef HALF_STEP
}
#undef VMW
#undef VMWN
#undef SLOAD_H
#undef ALOAD
#undef SWRITE_HK
#undef SWRITE_HV
#undef SWRITE_H
__device__ __forceinline__ BlockRef make_ref(const int* jlo, int bh, int qb) {
    const int b = bh >> 4, hd = bh & 15; BlockRef r; const int j0 = jlo[bh * 16 + qb] * KVBLK;
    r.qo = (unsigned)((b * SEQ + qb * QB) * RS + hd * D); r.ko = (unsigned)((b * SEQ + j0) * RS + hd * D); r.fo = (unsigned)(bh * SEQ + j0); r.P0 = qb * QB - j0; return r;
}
__device__ __forceinline__ void attn_phase(int wv, LAS unsigned char* ldsl, const bf16_t* qb_, const bf16_t* Kb_, const bf16_t* Vb_, const float* Fa_, bf16_t* ob_, const bf16_t* gb_, const int* jlo, unsigned* qctr) {
    char* lds = (char*)ldsl; const Ptrs p{qb_, Kb_, Vb_, Fa_, ob_, gb_};
    volatile int* s_next = (volatile int*)(lds + LDS_BYTES);
    const int tid = ltid(wv);
    if (tid == 0) *s_next = (int)__hip_atomic_fetch_add(qctr, 1u, __ATOMIC_RELAXED, __HIP_MEMORY_SCOPE_AGENT);
    __syncthreads();
    int L = __builtin_amdgcn_readfirstlane(*s_next);
    if (L >= 1024) return;
    BlockRef cur = make_ref(jlo, L & 63, 15 - (L >> 6));
    Seam S;
    attn_prime(wv, p, cur, lds, ldsl, S);
    for (;;) {
        if (tid == 0) *s_next = (int)__hip_atomic_fetch_add(qctr, 1u, __ATOMIC_RELAXED, __HIP_MEMORY_SCOPE_AGENT);
        __syncthreads();
        const int Ln = __builtin_amdgcn_readfirstlane(*s_next); const bool last = Ln >= 1024;
        const BlockRef nxt = last ? cur : make_ref(jlo, Ln & 63, 15 - (Ln >> 6));
        attn_block(wv, p, cur, nxt, lds, ldsl, S);
        if (last) break;
        cur = nxt;
    }
}
}

constexpr int NSTEPS = 49;
__device__ __forceinline__ void gemm_bf16_nl(int wv, LAS unsigned char* smem, const bf16_t* A, const bf16_t* Bt, int N, bf16_t* O, int ldc, int split_cols, size_t split_stride) {
    pg8::Gemm g{A, Bt, TT, N, DM}; pg8::StaticOrder S; S.init(TT, N, lgrid(), lbid());
    pg8::EpiBf16<0> E{O, ldc, nullptr, split_cols, split_stride};
    pg8::gemm_phase<pg8::EpiBf16<0>, pg8::StaticOrder, false>(wv, smem, g, S, E, nullptr);
}
__device__ __forceinline__ void gemm_resid_nl(int wv, LAS unsigned char* smem, const bf16_t* A, const bf16_t* Bt, const void* xold, int xold_f32, bf16_t* xnew, const float* gate) {
    pg8::Gemm g{A, Bt, TT, DM, DM}; pg8::StaticOrder S; S.init(TT, DM, lgrid(), lbid());
    pg8::EpiResid E{xold, xold_f32, xnew, gate, 12288};
    pg8::gemm_phase<pg8::EpiResid, pg8::StaticOrder, false>(wv, smem, g, S, E, nullptr);
}
template <unsigned PHASE_MASK>
__global__ void __launch_bounds__(NTHR, 2) trunk_kernel(Params p_unused, int lo, int hi) {
    extern __shared__ __attribute__((aligned(16))) unsigned char smem[];
    LAS unsigned char* sl = (LAS unsigned char*)smem;
    const int wv0 = __builtin_amdgcn_readfirstlane((int)threadIdx.x >> 6);
    typedef const __attribute__((address_space(4))) Params* KP;
    KP kp0 = (KP)__builtin_amdgcn_kernarg_segment_ptr();
    XcdBarrier bar; bar.bar = kp0->bar; bar.x = 0; bar.st = nullptr; bar.wv = wv0;
    if (hi - lo > 1) {
        LAS unsigned* stw = (LAS unsigned*)(smem + LDS_BYTES - 16);
        if (xb_thread0(wv0)) { stw[0] = 0u; stw[1] = 0u; stw[2] = 0u; stw[3] = 0u; }
        __syncthreads();
        bar = xcd_barrier_post(kp0->bar, (volatile LAS unsigned*)stw, wv0);
    }
    int step = 0;
#define EN(k) (((PHASE_MASK) >> (k)) & 1u)
#ifndef DUP_MASK
#define DUP_MASK 0u
#endif
#define DUP(k) (((DUP_MASK) >> (k)) & 1u)
#define RUN(kind, ...) do { KP kq = kp0; asm volatile("" : "+s"(kq)); const int lo_ = ((const __attribute__((address_space(4))) int*)kq)[sizeof(Params) / 4], hi_ = ((const __attribute__((address_space(4))) int*)kq)[sizeof(Params) / 4 + 1]; \
        if (step >= lo_ && step < hi_) { if constexpr (EN(kind)) { const Params& p = *(const Params*)kq; int wv = wv0; asm volatile("" : "+s"(wv)); __VA_ARGS__; if constexpr (DUP(kind)) { xcd_barrier(bar); __VA_ARGS__; } } if (step + 1 < hi_) xcd_barrier(bar); } ++step; } while (0)
    RUN(0, phase_prologue(wv, p, smem, p.bar + 3712));
    RUN(1, (phase_norm<false, false, true>(wv, p.x, p.norm_mix, p.mod + 0, p.mod + 2048, 12288, p.h, nullptr, nullptr, nullptr, 0, nullptr, nullptr)));
    for (int l = 0; l < 2; ++l) {
        RUN(2, gemm_bf16_nl(wv, sl, p.h, p.Wt_in + (size_t)l * GLA_NM * DM, GLA_NM, p.proj, GLA_NM, 0, 0));
        RUN(3, {
#ifdef PREP_PROBE
            phase_gla_prep<PREP_PROBE>(wv, p, l, smem); xcd_barrier(bar);
#endif
            phase_gla_prep<0>(wv, p, l, smem); });
        RUN(4, {
#ifdef REC_PROBE
            phase_gla_rec<REC_PROBE>(wv, p, smem); xcd_barrier(bar);
#endif
            phase_gla_rec<0>(wv, p, smem); });
        RUN(5, phase_gla_onorm(wv, p, l));
        RUN(6, gemm_resid_nl(wv, sl, p.og, p.Wt_out + (size_t)l * DM * DM, l == 0 ? (const void*)p.x : (const void*)p.xbuf, l == 0 ? 1 : 0, p.xbuf, (p.mod + (size_t)l * NBATCH * 12288) + 4096));
        RUN(1, (phase_norm<false, false>(wv, p.xbuf, p.norm_ffn + l * DM, (p.mod + (size_t)l * NBATCH * 12288) + 6144, (p.mod + (size_t)l * NBATCH * 12288) + 8192, 12288, p.h2, nullptr, nullptr, nullptr, 0, nullptr, nullptr)));
        RUN(2, gemm_bf16_nl(wv, sl, p.h2, p.Wt_pq + (size_t)l * DM * DM, DM, p.pq, DM, 0, 0));
        RUN(7, phase_peer_topk(wv, p, l, smem));
        RUN(8, phase_peer_gather1(wv, p, l));
        RUN(13, phase_peer_coef(wv, p, l));
        RUN(14, phase_peer_gather2(wv, p, l, (p.mod + (size_t)l * NBATCH * 12288) + 10240));
        if (l == 0) RUN(1, (phase_norm<false, false>(wv, p.xbuf, p.norm_mix + DM, (p.mod + (size_t)l * NBATCH * 12288) + NBATCH * 12288, (p.mod + (size_t)l * NBATCH * 12288) + NBATCH * 12288 + 2048, 12288, p.h, nullptr, nullptr, nullptr, 0, nullptr, nullptr)));
        else RUN(1, (phase_norm<true, false>(wv, p.xbuf, p.kv_norm, p.kvmod, p.kvmod + 2048, 4096, p.hk, p.norm_mix + 2 * DM, (p.mod + (size_t)l * NBATCH * 12288) + NBATCH * 12288, (p.mod + (size_t)l * NBATCH * 12288) + NBATCH * 12288 + 2048, 12288, p.h, nullptr)));
    }
    RUN(2, { gemm_bf16_nl(wv, sl, p.hk, p.Wt_kv, KV_NM, p.Kb, DM, DM, (size_t)TT * DM); __syncthreads(); if constexpr (EN(9)) phase_fl(wv, p, smem); });
    for (int l = 2; l < 4; ++l) {
        RUN(2, { gemm_bf16_nl(wv, sl, p.h, p.Wt_q + (size_t)(l - 2) * 4096 * DM, 4096, p.qb, DM, DM, (size_t)TT * DM); if constexpr (EN(10)) { if (l == 2) { phase_fscan(wv, p, smem); phase_knorm(wv, p, smem); } } });
        RUN(15, phase_qn(wv, p, smem));
        RUN(11, fa::attn_phase(wv, sl, p.qb, p.Kb, p.Vb, p.Fa, p.og, p.gb, p.jlo, p.bar + 3584 + 64 * (l - 2)));
        RUN(6, gemm_resid_nl(wv, sl, p.og, p.Wt_fo + (size_t)(l - 2) * DM * DM, (const void*)p.xbuf, 0, p.xbuf, (p.mod + (size_t)l * NBATCH * 12288) + 4096));
        RUN(1, (phase_norm<false, false>(wv, p.xbuf, p.norm_ffn + l * DM, (p.mod + (size_t)l * NBATCH * 12288) + 6144, (p.mod + (size_t)l * NBATCH * 12288) + 8192, 12288, p.h2, nullptr, nullptr, nullptr, 0, nullptr, nullptr)));
        RUN(2, gemm_bf16_nl(wv, sl, p.h2, p.Wt_pq + (size_t)l * DM * DM, DM, p.pq, DM, 0, 0));
        RUN(7, phase_peer_topk(wv, p, l, smem));
        RUN(8, phase_peer_gather1(wv, p, l));
        RUN(13, phase_peer_coef(wv, p, l));
        RUN(14, phase_peer_gather2(wv, p, l, (p.mod + (size_t)l * NBATCH * 12288) + 10240));
        if (l == 2) RUN(1, (phase_norm<false, false>(wv, p.xbuf, p.norm_mix + 3 * DM, (p.mod + (size_t)l * NBATCH * 12288) + NBATCH * 12288, (p.mod + (size_t)l * NBATCH * 12288) + NBATCH * 12288 + 2048, 12288, p.h, nullptr, nullptr, nullptr, 0, nullptr, nullptr)));
        else RUN(1, (phase_norm<false, true>(wv, p.xbuf, p.final_norm, nullptr, nullptr, 0, nullptr, nullptr, nullptr, nullptr, 0, nullptr, p.out)));
    }
#undef RUN
}

extern "C" void kernel_launch(void* const* d_in, const int* in_sizes, int n_in, void* d_out, int out_size, void* d_ws, size_t ws_size, hipStream_t stream) {
    static int grid = 0;
    if (grid == 0) {
        int dev = 0, cus = 0;
        if (hipGetDevice(&dev) != hipSuccess || hipDeviceGetAttribute(&cus, hipDeviceAttributeMultiprocessorCount, dev) != hipSuccess || cus <= 0) cus = 256;
        const bool ok = hipFuncSetAttribute((const void*)trunk_kernel<0xffffffffu>, hipFuncAttributeMaxDynamicSharedMemorySize, LDS_BYTES) == hipSuccess;
        if (!ok) { fprintf(stderr, "kernel_launch: hipFuncSetAttribute failed\n"); grid = -1; return; }
        (void)hipGetLastError();
        grid = cus;
    }
    if (grid < 0 || n_in != 23) return;
    Params p{};
    const float* const* in = (const float* const*)d_in;
    p.x = in[0]; p.c = in[1]; p.ada_w = in[2]; p.ada_b = in[3]; p.norm_mix = in[4]; p.norm_ffn = in[5]; p.gla_w_in = in[6]; p.gla_wg2 = in[7]; p.gla_bg2 = in[8]; p.gla_norm = in[9];
    p.gla_w_out = in[10]; p.kv_norm = in[11]; p.kv_ada_w = in[12]; p.kv_ada_b = in[13]; p.fox_w_kv = in[14]; p.fox_b_f = in[15]; p.fox_w_q = in[16]; p.fox_w_out = in[17];
    p.peer_w_q = in[18]; p.peer_subk = in[19]; p.peer_u = in[20]; p.peer_v = in[21]; p.final_norm = in[22];
    p.out = (float*)d_out;
    unsigned char* ws = (unsigned char*)d_ws; size_t off = 0;
    auto take = [&](size_t bytes) { unsigned char* r = ws + off; off += (bytes + 255) & ~(size_t)255; return r; };
    p.bar = (unsigned*)take(16384);
    p.mod = (float*)take((size_t)4 * NBATCH * 12288 * 4); p.kvmod = (float*)take((size_t)NBATCH * 4096 * 4);
    p.Wt_in = (bf16_t*)take((size_t)2 * GLA_NM * DM * 2); p.W16_in = (bf16_t*)take((size_t)2 * 16 * DM * 2);
    p.Wt_out = (bf16_t*)take((size_t)2 * DM * DM * 2); p.Wt_kv = (bf16_t*)take((size_t)KV_NM * DM * 2); p.W16_kv = (bf16_t*)take((size_t)16 * DM * 2);
    p.Wt_q = (bf16_t*)take((size_t)2 * 4096 * DM * 2); p.Wt_fo = (bf16_t*)take((size_t)2 * DM * DM * 2); p.Wt_pq = (bf16_t*)take((size_t)4 * DM * DM * 2);
    p.subk = (bf16_t*)take((size_t)4 * 8 * 2 * 128 * 128 * 2);
    p.U8 = (unsigned char*)take((size_t)4 * 16384 * DM); p.V8 = (unsigned char*)take((size_t)4 * 16384 * DM); p.su = (float*)take((size_t)4 * 16384 * 4); p.sv = (float*)take((size_t)4 * 16384 * 4);
    p.xbuf = (bf16_t*)take((size_t)TT * DM * 2);
    p.h = (bf16_t*)take((size_t)TT * DM * 2); p.hk = (bf16_t*)take((size_t)TT * DM * 2); p.h2 = (bf16_t*)take((size_t)TT * DM * 2);
    p.og = (bf16_t*)take((size_t)TT * DM * 2); p.pq = (bf16_t*)take((size_t)TT * DM * 2);
    p.ids = (int*)take((size_t)TT * 128 * 4); p.wts = (float*)take((size_t)TT * 128 * 4); p.fl = (float*)take((size_t)TT * 16 * 4); p.apart = (float*)take((size_t)8 * TT * 128 * 4); p.cqbuf = (signed char*)take((size_t)TT * 128); p.scbuf = (float*)take((size_t)TT * 4); p.kn2 = (float*)take(1024 * 4); p.jlo = (int*)take(1024 * 4);
    const size_t region = off;
    p.proj = (bf16_t*)take((size_t)TT * GLA_NM * 2); p.qt = (bf16_t*)take((size_t)TT * 1024 * 2); p.khT = (bf16_t*)take((size_t)TT * 1024 * 2);
    p.vT = (bf16_t*)take((size_t)TT * DM * 2); p.Pm = (bf16_t*)take((size_t)TT * 4 * 64 * 2); p.dec = (float*)take((size_t)1024 * 256 * 4); p.o = (bf16_t*)take((size_t)TT * DM * 2);
    const size_t end_gla = off; off = region;
    p.qb = (bf16_t*)take((size_t)TT * DM * 2); p.gb = (bf16_t*)take((size_t)TT * DM * 2); p.Kb = (bf16_t*)take((size_t)TT * DM * 2); p.Vb = (bf16_t*)take((size_t)TT * DM * 2);
    p.ob = (bf16_t*)take((size_t)TT * DM * 2); p.Fa = (float*)take((size_t)64 * SEQ * 4);
    const size_t end_all = off > end_gla ? off : end_gla;
    if (end_all > ws_size) { fprintf(stderr, "kernel_launch: workspace too small: need %zu have %zu\n", end_all, ws_size); return; }
    { int first = 0, m = 0;
      auto add = [&](const float* src, bf16_t* dst, bf16_t* dst16, int N, int Nmain) { TMat& t = p.tm[m++]; t.src = src; t.dst = dst; t.dst16 = dst16; t.N = N; t.Nmain = Nmain; t.ntn = (N + 255) / 256; t.first = first; first += 32 * t.ntn; };
      for (int l = 0; l < 2; ++l) add(p.gla_w_in + (size_t)l * DM * GLA_N, p.Wt_in + (size_t)l * GLA_NM * DM, p.W16_in + (size_t)l * 16 * DM, GLA_N, GLA_NM);
      for (int l = 0; l < 2; ++l) add(p.gla_w_out + (size_t)l * DM * DM, p.Wt_out + (size_t)l * DM * DM, nullptr, DM, DM);
      add(p.fox_w_kv, p.Wt_kv, p.W16_kv, KV_N, KV_NM);
      for (int l = 0; l < 2; ++l) add(p.fox_w_q + (size_t)l * DM * 4096, p.Wt_q + (size_t)l * 4096 * DM, nullptr, 4096, 4096);
      for (int l = 0; l < 2; ++l) add(p.fox_w_out + (size_t)l * DM * DM, p.Wt_fo + (size_t)l * DM * DM, nullptr, DM, DM);
      for (int l = 0; l < 4; ++l) add(p.peer_w_q + (size_t)l * DM * DM, p.Wt_pq + (size_t)l * DM * DM, nullptr, DM, DM);
      p.ntr_jobs = first; p.pad0 = 0; }
    (void)hipMemsetAsync(p.bar, 0, 16384, stream);
    hipLaunchKernelGGL(trunk_kernel<0xffffffffu>, dim3(grid), dim3(NTHR), LDS_BYTES, stream, p, 0, NSTEPS);
    const hipError_t le = hipPeekAtLastError();
    if (le != hipSuccess) fprintf(stderr, "kernel_launch: launch failed: %s\n", hipGetErrorName(le));
}
```

```cpp
#include <hip/hip_runtime.h>
#include <stdint.h>
#include <stdio.h>

#define LAS __attribute__((address_space(3)))
typedef unsigned short bf16_t;
typedef float f32x16 __attribute__((ext_vector_type(16)));
typedef float fl2 __attribute__((ext_vector_type(2)));
typedef short s16x4 __attribute__((ext_vector_type(4)));
typedef __bf16 bf16x2 __attribute__((ext_vector_type(2)));

__device__ __forceinline__ int ltid(int wv) { unsigned m = ~0u; asm volatile("" : "+s"(m)); return (wv << 6) | (int)__builtin_amdgcn_mbcnt_hi(m, __builtin_amdgcn_mbcnt_lo(m, 0u)); }

__device__ __forceinline__ int lbid() { int b = (int)blockIdx.x; asm volatile("" : "+s"(b)); return b; }
__device__ __forceinline__ int lgrid() { int g = (int)gridDim.x; asm volatile("" : "+s"(g)); return g; }

namespace pg8 {
#define PG8_LAS __attribute__((address_space(3)))
typedef unsigned short bf16_t;
typedef short bf16x8 __attribute__((ext_vector_type(8)));
typedef float f32x4 __attribute__((ext_vector_type(4)));
typedef unsigned u32x4 __attribute__((ext_vector_type(4)));
constexpr int BM = 256, BK = 64, HALF = 128, HTB = HALF * BK * 2  , STAGE_BYTES = 8 * HTB, NXCD = 8, WGM = 8;

__host__ __device__ __forceinline__ int lds_byte(int r, int c) { const int st = (r >> 4) * 2 + (c >> 5), rr = r & 15, cc = c & 31, ob = rr * 64 + cc * 2; return st * 1024 + (ob ^ (((ob >> 9) & 1) << 5)); }
__host__ __device__ __forceinline__ void stage_rc(int b, int& R, int& C) { const int st = b / 1024, sb = b % 1024, swz = sb ^ (((sb >> 9) & 1) << 5); R = (st >> 1) * 16 + swz / 64; C = (st & 1) * 32 + (swz % 64) / 2; }
__host__ __device__ __forceinline__ int perm32(int rho) { const int n = rho >> 4, i = rho & 15; return 8 * (i >> 2) + 4 * n + (i & 3); }

struct Unit { int pm, pn; };
struct Gemm { const bf16_t* A; const bf16_t* Bt; int M, N, K; };

struct StaticOrder {
    int nM, nN, nwg, G, c;
    __host__ __device__ void init(int M, int N, int G_, int c_) { nM = M / BM; nN = N / BM; nwg = nM * nN; G = G_; c = c_; }
    __host__ __device__ bool next(int i, Unit& u) const {
        const long L = (long)i * G + c; if (L >= nwg) return false;
        int wgid = (int)L; { const int q = nwg / NXCD, r = nwg % NXCD, xcd = wgid % NXCD, off = wgid / NXCD; wgid = (xcd < r ? xcd * (q + 1) : r * (q + 1) + (xcd - r) * q) + off; }
        const int nig = WGM * nN, gid = wgid / nig, fm = gid * WGM, gsz = (nM - fm) < WGM ? (nM - fm) : WGM;
        u.pm = fm + ((wgid % nig) % gsz); u.pn = (wgid % nig) / gsz; return true;
    }
    __device__ __forceinline__ void a_ready(const Unit&) const {}
    __device__ __forceinline__ void done(const Unit&) const {}
};
struct CountedOrder : StaticOrder {
    const unsigned* ready; unsigned need; unsigned* tmo;
    __device__ __forceinline__ void a_ready(const Unit& u) const {
        if (threadIdx.x < 64) {
            const unsigned long long t0 = __builtin_amdgcn_s_memrealtime(); unsigned polls = 0;
            while ((unsigned)__builtin_amdgcn_readfirstlane(__hip_atomic_load(ready + 64 * u.pm, __ATOMIC_RELAXED, __HIP_MEMORY_SCOPE_AGENT)) < need) {
                if ((++polls & 255u) == 0u && __builtin_amdgcn_readfirstlane(__hip_atomic_load(tmo, __ATOMIC_RELAXED, __HIP_MEMORY_SCOPE_AGENT)) != 0u) break;
                if (__builtin_amdgcn_s_memrealtime() - t0 > 2000000ull) {
                    if (threadIdx.x == 0) { unsigned expect = 0u; __hip_atomic_compare_exchange_strong(tmo + 1, &expect, 0x600u | (unsigned)(u.pm & 0xff), __ATOMIC_RELAXED, __ATOMIC_RELAXED, __HIP_MEMORY_SCOPE_AGENT); __hip_atomic_store(tmo, 1u, __ATOMIC_RELAXED, __HIP_MEMORY_SCOPE_AGENT); }
                    break; }
                __builtin_amdgcn_s_sleep(2); }
            __builtin_amdgcn_fence(__ATOMIC_ACQUIRE, "agent");
            asm volatile("s_waitcnt vmcnt(0)" ::: "memory");
        }
#if !defined(BROKEN_HOOK_NO_BARRIER)
        asm volatile("" ::: "memory"); __builtin_amdgcn_s_barrier(); asm volatile("" ::: "memory");
#endif
    }
};

__device__ __forceinline__ unsigned cvt_pk_bf16(float lo, float hi) { unsigned r; asm volatile("v_cvt_pk_bf16_f32 %0, %1, %2" : "=v"(r) : "v"(lo), "v"(hi)); return r; }
typedef float f32x2 __attribute__((ext_vector_type(2)));
__device__ __forceinline__ f32x2 gelu_pk(f32x2 v) {
    const f32x2 av = __builtin_elementwise_abs(v), d = av * 0.2316418882f + 1.0f;
    f32x2 t; t.x = __builtin_amdgcn_rcpf(d.x); t.y = __builtin_amdgcn_rcpf(d.y);
    f32x2 q = t * 0.5307027145f + (-0.7265760135f); q = q * t + 0.7107068705f; q = q * t + (-0.142248368f); q = q * t + 0.127414796f; q = q * t;
    const f32x2 s = (v * v) * (-0.72134752044f);
    f32x2 e; e.x = __builtin_amdgcn_exp2f(s.x); e.y = __builtin_amdgcn_exp2f(s.y);
    const f32x2 m = v * (q * e), r = v - m;
    f32x2 o; o.x = v.x < 0.f ? m.x : r.x; o.y = v.y < 0.f ? m.y : r.y; return o;
}

struct EpiF32 {
    static constexpr bool PERM = false, AFTER_DRAIN = false;
    float* C; int ldc; const float* bias;
    __device__ __forceinline__ void operator()(const f32x4 (&acc)[2][2][4][2], const Unit& u, int wr, int wc, int fr, int fq) const {
        const int row0 = u.pm * BM + wr * 64 + fr, col0 = u.pn * BM + wc * 32 + 4 * fq;
        f32x4 bv[2][2];
#pragma unroll
        for (int bj = 0; bj < 2; ++bj)
#pragma unroll
            for (int n = 0; n < 2; ++n) bv[bj][n] = bias ? *(const f32x4*)(bias + col0 + bj * HALF + n * 16) : (f32x4){0.f, 0.f, 0.f, 0.f};
#pragma unroll
        for (int ai = 0; ai < 2; ++ai)
#pragma unroll
            for (int m = 0; m < 4; ++m) { float* rowp = C + (size_t)(row0 + ai * HALF + m * 16) * ldc + col0;
#pragma unroll
                for (int bj = 0; bj < 2; ++bj)
#pragma unroll
                    for (int n = 0; n < 2; ++n) *(f32x4*)(rowp + bj * HALF + n * 16) = acc[ai][bj][m][n] + bv[bj][n]; }
    }
};
template <int ACT  > struct EpiBf16 {
    static constexpr bool PERM = true, AFTER_DRAIN = false;
    bf16_t* O; int ldc; const float* bias; int split_cols; size_t split_stride;
    __device__ __forceinline__ void operator()(const f32x4 (&acc)[2][2][4][2], const Unit& u, int wr, int wc, int fr, int fq) const {
        const int row0 = u.pm * BM + wr * 64 + fr; int colt = u.pn * BM; bf16_t* base = O;
        if (split_cols) { const int t = colt / split_cols; base += (size_t)t * split_stride; colt -= t * split_cols; }
        const int col0 = colt + wc * 32 + 8 * fq, bcol0 = u.pn * BM + wc * 32 + 8 * fq;
        f32x4 bv[2][2];
#pragma unroll
        for (int bj = 0; bj < 2; ++bj)
#pragma unroll
            for (int n = 0; n < 2; ++n) bv[bj][n] = bias ? *(const f32x4*)(bias + bcol0 + bj * HALF + 4 * n) : (f32x4){0.f, 0.f, 0.f, 0.f};
#pragma unroll
        for (int ai = 0; ai < 2; ++ai)
#pragma unroll
            for (int m = 0; m < 4; ++m) { bf16_t* rowp = base + (size_t)(row0 + ai * HALF + m * 16) * ldc + col0;
#pragma unroll
                for (int bj = 0; bj < 2; ++bj) { f32x4 v0 = acc[ai][bj][m][0] + bv[bj][0], v1 = acc[ai][bj][m][1] + bv[bj][1];
                    if (ACT == 1) { f32x2 a = gelu_pk((f32x2){v0[0], v0[1]}), b = gelu_pk((f32x2){v0[2], v0[3]}), c = gelu_pk((f32x2){v1[0], v1[1]}), d = gelu_pk((f32x2){v1[2], v1[3]});
                        v0 = (f32x4){a.x, a.y, b.x, b.y}; v1 = (f32x4){c.x, c.y, d.x, d.y}; }
                    if (ACT == 2) {
#pragma unroll
                        for (int j = 0; j < 4; ++j) { v0[j] = 0.5f * v0[j] * (1.0f + erff(v0[j] * 0.70710678f)); v1[j] = 0.5f * v1[j] * (1.0f + erff(v1[j] * 0.70710678f)); } }
                    u32x4 w; w.x = cvt_pk_bf16(v0[0], v0[1]); w.y = cvt_pk_bf16(v0[2], v0[3]); w.z = cvt_pk_bf16(v1[0], v1[1]); w.w = cvt_pk_bf16(v1[2], v1[3]);
                    *(u32x4*)(rowp + bj * HALF) = w; } }
    }
};
struct EpiResid {
    static constexpr bool PERM = false, AFTER_DRAIN = false;
    const void* xold; int xold_f32; bf16_t* xnew; const float* gate; int gstride;
    __device__ __forceinline__ void operator()(const f32x4 (&acc)[2][2][4][2], const Unit& u, int wr, int wc, int fr, int fq) const {
        const int row0 = u.pm * BM + wr * 64 + fr, col0 = u.pn * BM + wc * 32 + 4 * fq;
        const float* gp = gate + (size_t)((u.pm * BM) >> 12) * gstride + col0;
        f32x4 gv[2][2];
#pragma unroll
        for (int bj = 0; bj < 2; ++bj)
#pragma unroll
            for (int n = 0; n < 2; ++n) gv[bj][n] = *(const f32x4*)(gp + bj * HALF + n * 16);
#pragma unroll
        for (int ai = 0; ai < 2; ++ai) {
            f32x4 xo[4][2][2];
            if (xold_f32) {
#pragma unroll
                for (int m = 0; m < 4; ++m) { const size_t off = (size_t)(row0 + ai * HALF + m * 16) * 2048 + col0;
#pragma unroll
                    for (int bj = 0; bj < 2; ++bj)
#pragma unroll
                        for (int n = 0; n < 2; ++n) xo[m][bj][n] = *(const f32x4*)((const float*)xold + off + bj * HALF + n * 16); }
            } else {
#pragma unroll
                for (int m = 0; m < 4; ++m) { const size_t off = (size_t)(row0 + ai * HALF + m * 16) * 2048 + col0;
#pragma unroll
                    for (int bj = 0; bj < 2; ++bj)
#pragma unroll
                        for (int n = 0; n < 2; ++n) { const uint2 w = *(const uint2*)((const bf16_t*)xold + off + bj * HALF + n * 16);
                            xo[m][bj][n] = (f32x4){__uint_as_float(w.x << 16), __uint_as_float(w.x & 0xffff0000u), __uint_as_float(w.y << 16), __uint_as_float(w.y & 0xffff0000u)}; } }
            }
#pragma unroll
            for (int m = 0; m < 4; ++m) { const size_t off = (size_t)(row0 + ai * HALF + m * 16) * 2048 + col0;
#pragma unroll
                for (int bj = 0; bj < 2; ++bj)
#pragma unroll
                    for (int n = 0; n < 2; ++n) { const f32x4 y = xo[m][bj][n] + gv[bj][n] * acc[ai][bj][m][n];
                        *(uint2*)(xnew + off + bj * HALF + n * 16) = make_uint2(cvt_pk_bf16(y[0], y[1]), cvt_pk_bf16(y[2], y[3])); } } }
    }
};

template <class Epi, class Sched, bool STAMP = false>
__device__ __forceinline__ void gemm_phase(int wv, PG8_LAS unsigned char* lds, const Gemm g, const Sched& S, const Epi& E, unsigned long long* stamps) {
    const int tid = ltid(wv), wid = wv, lane = tid & 63, wr = wid >> 2, wc = wid & 3, fr = lane & 15, fq = lane >> 4;
    const int K = g.K, nt = K / BK;
    int ts_lo = 0, ts_hi = 0, nts = 0; const unsigned long long rt_entry = STAMP ? (unsigned long long)wall_clock64() : 0ull;
#define PG8_STAMP() do { if (STAMP && wid == 0 && nts < 64) { const unsigned long long _c = (unsigned long long)clock64(); \
        ts_lo = (lane == nts) ? (int)(unsigned)_c : ts_lo; ts_hi = (lane == nts) ? (int)(unsigned)(_c >> 32) : ts_hi; ++nts; } } while (0)
    PG8_STAMP();
    unsigned voffA[2], voffB[2];
#pragma unroll
    for (int i = 0; i < 2; ++i) { int R, C; stage_rc(tid * 16 + i * 8192, R, C); const int Rb = Epi::PERM ? ((R & ~31) + perm32(R & 31)) : R;
        voffA[i] = (unsigned)(R * K + C) * 2u; voffB[i] = (unsigned)(Rb * K + C) * 2u; }
    const size_t kstep = (size_t)(BK * 2);
    const size_t hstep = (size_t)HALF * K * 2;
    const size_t tstep = 2 * hstep;
    const unsigned ldsw = (unsigned)wid * 1024u;
    const int aoff = lds_byte(wr * 64 + fr, fq * 8), boff = lds_byte(wc * 32 + fr, fq * 8);
#define PG8_SA(b, h) (((b) * 2 + (h)) * HTB)
#define PG8_SB(b, h) ((4 + (b) * 2 + (h)) * HTB)
#define PG8_STAGE(bufoff, gbase, voff) do { _Pragma("unroll") for (int _i = 0; _i < 2; ++_i) \
        __builtin_amdgcn_global_load_lds((const unsigned*)((const char*)(gbase) + (voff)[_i]), (PG8_LAS unsigned*)(lds + (bufoff) + ldsw + _i * 8192), 16, 0, 0); } while (0)
#define PG8_LDA(dst, b, h) do { _Pragma("unroll") for (int m = 0; m < 4; ++m) _Pragma("unroll") for (int k = 0; k < 2; ++k) dst[m][k] = *(const PG8_LAS bf16x8*)(lds + PG8_SA(b, h) + aoff + m * 2048 + k * 1024); } while (0)
#define PG8_LDB(dst, b, h) do { _Pragma("unroll") for (int n = 0; n < 2; ++n) _Pragma("unroll") for (int k = 0; k < 2; ++k) dst[n][k] = *(const PG8_LAS bf16x8*)(lds + PG8_SB(b, h) + boff + n * 2048 + k * 1024); } while (0)
#define PG8_MMA(ai, bj, At, Bt) do { __builtin_amdgcn_s_setprio(1); _Pragma("unroll") for (int m = 0; m < 4; ++m) _Pragma("unroll") for (int n = 0; n < 2; ++n) _Pragma("unroll") for (int k = 0; k < 2; ++k) \
        acc[ai][bj][m][n] = __builtin_amdgcn_mfma_f32_16x16x32_bf16(Bt[n][k], At[m][k], acc[ai][bj][m][n], 0, 0, 0); __builtin_amdgcn_s_setprio(0); } while (0)
#define PG8_WAIT_V(n) asm volatile("s_waitcnt vmcnt(" #n ")" ::: "memory")
#define PG8_WAIT_L(n) asm volatile("s_waitcnt lgkmcnt(" #n ")" ::: "memory")
#define PG8_BAR __builtin_amdgcn_s_barrier()
#define PG8_SCHED __builtin_amdgcn_sched_barrier(0)
    Unit cur, nxt; int ui = 0;
    if (!S.next(0, cur)) return;
    f32x4 acc[2][2][4][2];
#pragma unroll
    for (int a = 0; a < 2; ++a)
#pragma unroll
        for (int b = 0; b < 2; ++b)
#pragma unroll
            for (int m = 0; m < 4; ++m)
#pragma unroll
                for (int n = 0; n < 2; ++n) acc[a][b][m][n] = (f32x4){0.f, 0.f, 0.f, 0.f};
    bf16x8 At[4][2], B0[2][2], B1[2][2];
    const char* cA = (const char*)g.A + (size_t)cur.pm * tstep; const char* cB = (const char*)g.Bt + (size_t)cur.pn * tstep;
    S.a_ready(cur);
    PG8_STAGE(PG8_SB(0, 0), cB, voffB); PG8_STAGE(PG8_SA(0, 0), cA, voffA); PG8_STAGE(PG8_SB(0, 1), cB + hstep, voffB); PG8_STAGE(PG8_SA(0, 1), cA + hstep, voffA);
    if (wr == 1) PG8_BAR;
    PG8_WAIT_V(4); PG8_BAR;
    PG8_STAGE(PG8_SB(1, 0), cB + kstep, voffB); PG8_STAGE(PG8_SA(1, 0), cA + kstep, voffA); PG8_STAGE(PG8_SB(1, 1), cB + hstep + kstep, voffB);
    PG8_WAIT_V(6); PG8_BAR;
    PG8_STAMP();
    for (;;) {
        const bool has_next = S.next(ui + 1, nxt);
        const char* nA = has_next ? (const char*)g.A + (size_t)nxt.pm * tstep : cA; const char* nB = has_next ? (const char*)g.Bt + (size_t)nxt.pn * tstep : cB;
        for (int t = 0; t < nt; t += 2) {
            const bool last = (t == nt - 2);
            const char* a1 = cA + (size_t)(t + 1) * kstep;
            const char* a2 = last ? nA : cA + (size_t)(t + 2) * kstep; const char* b2 = last ? nB : cB + (size_t)(t + 2) * kstep;
            const char* a3 = a2 + kstep; const char* b3 = b2 + kstep;
            if (last && has_next) S.a_ready(nxt);
            PG8_LDB(B0, 0, 0); PG8_SCHED; PG8_LDA(At, 0, 0); PG8_STAGE(PG8_SA(1, 1), a1 + hstep, voffA);
            PG8_WAIT_L(8); PG8_BAR; PG8_WAIT_L(0); PG8_MMA(0, 0, At, B0); PG8_BAR; PG8_SCHED;
            PG8_LDB(B1, 0, 1); PG8_STAGE(PG8_SB(0, 0), b2, voffB);
            PG8_BAR; PG8_WAIT_L(0); PG8_MMA(0, 1, At, B1); PG8_BAR;
            PG8_LDA(At, 0, 1); PG8_STAGE(PG8_SA(0, 0), a2, voffA);
            PG8_BAR; PG8_WAIT_L(0); PG8_MMA(1, 0, At, B0); PG8_BAR; PG8_SCHED;
            PG8_STAGE(PG8_SB(0, 1), b2 + hstep, voffB);
            PG8_WAIT_V(6); PG8_BAR; PG8_MMA(1, 1, At, B1); PG8_BAR;
            PG8_LDB(B0, 1, 0); PG8_SCHED; PG8_LDA(At, 1, 0); PG8_STAGE(PG8_SA(0, 1), a2 + hstep, voffA);
            PG8_WAIT_L(8); PG8_BAR; PG8_WAIT_L(0); PG8_MMA(0, 0, At, B0); PG8_BAR; PG8_SCHED;
            PG8_LDB(B1, 1, 1); PG8_STAGE(PG8_SB(1, 0), b3, voffB);
            PG8_BAR; PG8_WAIT_L(0); PG8_MMA(0, 1, At, B1); PG8_BAR;
            PG8_LDA(At, 1, 1); PG8_STAGE(PG8_SA(1, 0), a3, voffA);
            PG8_BAR; PG8_WAIT_L(0); PG8_MMA(1, 0, At, B0); PG8_BAR; PG8_SCHED;
            PG8_STAGE(PG8_SB(1, 1), b3 + hstep, voffB);
            PG8_WAIT_V(6); PG8_BAR; PG8_MMA(1, 1, At, B1); PG8_BAR;
        }
        PG8_STAMP();
        if constexpr (!Epi::AFTER_DRAIN) { E(acc, cur, wr, wc, fr, fq); S.done(cur); }
        PG8_STAMP();
        if (!has_next) break;
#pragma unroll
        for (int a = 0; a < 2; ++a)
#pragma unroll
            for (int b = 0; b < 2; ++b)
#pragma unroll
                for (int m = 0; m < 4; ++m)
#pragma unroll
                    for (int n = 0; n < 2; ++n) acc[a][b][m][n] = (f32x4){0.f, 0.f, 0.f, 0.f};
        cur = nxt; cA = nA; cB = nB; ++ui;
    }
    PG8_WAIT_V(0);
    if (wr == 0) PG8_BAR;
    PG8_BAR;
    if constexpr (Epi::AFTER_DRAIN) { E.fused(acc, cur, wr, wc, fr, fq, lds, wid, lane); S.done(cur); }
    PG8_STAMP();
    if (STAMP && wid == 0) { stamps[lane] = lane < nts ? (((unsigned long long)(unsigned)ts_hi << 32) | (unsigned)ts_lo) : 0ull;
        if (lane == 62) stamps[62] = rt_entry; if (lane == 63) stamps[63] = (unsigned long long)wall_clock64(); }
#undef PG8_STAMP
#undef PG8_SA
#undef PG8_SB
#undef PG8_STAGE
#undef PG8_LDA
#undef PG8_LDB
#undef PG8_MMA
#undef PG8_WAIT_V
#undef PG8_WAIT_L
#undef PG8_BAR
#undef PG8_SCHED
}
}
#define XB_TMO      128
#define XB_XCNT(j)  (256  + 64 * (j))
#define XB_XSUB(j)  (1280 + 64 * (j))
#define XB_XGEN(j)  (2304 + 64 * (j))
#define XB_TOP      3328
#define XB_TOPGEN   3392
#define XCD_BAR_WORDS 3456
#define XB_SPIN_CAP (1u << 18)
#define LAS __attribute__((address_space(3)))

__device__ __forceinline__ unsigned xb_ld(unsigned* p)              { return __hip_atomic_load(p, __ATOMIC_RELAXED, __HIP_MEMORY_SCOPE_AGENT); }
__device__ __forceinline__ unsigned xb_add(unsigned* p, unsigned v) { return __hip_atomic_fetch_add(p, v, __ATOMIC_RELAXED, __HIP_MEMORY_SCOPE_AGENT); }
__device__ __forceinline__ unsigned xb_xcc_id() { return (unsigned)__builtin_amdgcn_s_getreg((3 << 11) | 20) & 0xFu; }
#define XB_SPIN(cond, bar) do { unsigned _sp = 0; while (cond) { __builtin_amdgcn_s_sleep(1); \
    if ((++_sp & 255u) == 0u) { if (xb_ld(&(bar)[XB_TMO])) break; if (_sp > XB_SPIN_CAP) { atomicAdd(&(bar)[XB_TMO], 1u); break; } } } } while (0)

struct XcdBarrier {
    unsigned* bar; unsigned x; int wv;
    volatile LAS unsigned* st;
};

__device__ __forceinline__ bool xb_thread0(int wv) { unsigned m = ~0u; asm volatile("" : "+s"(m)); return wv == 0 && __builtin_amdgcn_mbcnt_hi(m, __builtin_amdgcn_mbcnt_lo(m, 0u)) == 0u; }
__device__ __forceinline__ XcdBarrier xcd_barrier_post(unsigned* bar, volatile LAS unsigned* st, int wv) {
    XcdBarrier b; b.bar = bar; b.x = xb_xcc_id(); b.st = st; b.wv = wv;
    if (xb_thread0(wv)) (void)xb_add(&bar[XB_XCNT(b.x)], 1u);
    return b;
}
__device__ __forceinline__ void xcd_barrier_complete(unsigned* bar, unsigned x, unsigned& nloc, unsigned& nx) {
    const unsigned G = gridDim.x * gridDim.y * gridDim.z;
    unsigned sum, cnt, mine, sp = 0u;
    for (;;) {
        sum = 0u; cnt = 0u; mine = 0u;
#pragma unroll
        for (unsigned j = 0; j < 16; ++j) { const unsigned c = xb_ld(&bar[XB_XCNT(j)]); sum += c; cnt += (c > 0u) ? 1u : 0u; mine = (j == x) ? c : mine; }
        if (sum == G) break;
        __builtin_amdgcn_s_sleep(1);
        if ((++sp & 255u) == 0u) { if (xb_ld(&bar[XB_TMO])) break; if (sp > XB_SPIN_CAP) { atomicAdd(&bar[XB_TMO], 1u); break; } }
    }
    nloc = mine > 0u ? mine : 1u; nx = cnt > 0u ? cnt : 1u;
}

__device__ __forceinline__ void xcd_barrier(const XcdBarrier& b) {
    asm volatile("s_waitcnt vmcnt(0)" ::: "memory");
    __syncthreads();
    if (xb_thread0(b.wv)) {
        unsigned* bar = b.bar; asm volatile("" : "+s"(bar)); unsigned bx = b.x; asm volatile("" : "+s"(bx));
        __builtin_amdgcn_s_waitcnt(0);
        unsigned nloc = b.st[0], nx = b.st[1];
        if (nloc == 0u) { xcd_barrier_complete(bar, bx, nloc, nx); b.st[0] = nloc; b.st[1] = nx; }
        const unsigned old = xb_add(&bar[XB_XSUB(bx)], 1u);
        const unsigned gen = old / nloc;
        if (old + 1u == (gen + 1u) * nloc) {
            __builtin_amdgcn_fence(__ATOMIC_RELEASE, "agent");
            asm volatile("s_waitcnt vmcnt(0)" ::: "memory");
            const unsigned og = xb_add(&bar[XB_TOP], 1u);
            const unsigned tg = og / nx;
            if (og + 1u == (tg + 1u) * nx) xb_add(&bar[XB_TOPGEN], 1u);
            else XB_SPIN(xb_ld(&bar[XB_TOPGEN]) == tg, bar);
            __builtin_amdgcn_fence(__ATOMIC_ACQUIRE, "agent");
            xb_add(&bar[XB_XGEN(bx)], 1u);
            asm volatile("s_waitcnt vmcnt(0)" ::: "memory");
        } else {
            XB_SPIN(xb_ld(&bar[XB_XGEN(bx)]) == gen, bar);
            __builtin_amdgcn_fence(__ATOMIC_ACQUIRE, "agent");
            asm volatile("s_waitcnt vmcnt(0)" ::: "memory");
        }
    }
    __syncthreads();
    __builtin_amdgcn_s_waitcnt(0);
}

constexpr int NTHR = 512, NWAVE = 8;
constexpr int TT = 16384, DM = 2048, SEQ = 4096, NBATCH = 4;
constexpr int GLA_N = 6160, GLA_NM = 6144;
constexpr int KV_N = 4112, KV_NM = 4096;
constexpr float RMS_EPS = 1e-6f;
constexpr int LDS_BYTES = 155648;

typedef pg8::bf16x8 bf16x8;
typedef pg8::f32x4 f32x4;
typedef pg8::u32x4 u32x4;

struct TMat { const float* src; bf16_t* dst; bf16_t* dst16; int N, Nmain, ntn, first; };
constexpr int NTMAT = 13;
struct Params {
    const float *x, *c, *ada_w, *ada_b, *norm_mix, *norm_ffn, *gla_w_in, *gla_wg2, *gla_bg2, *gla_norm, *gla_w_out, *kv_norm, *kv_ada_w, *kv_ada_b,
                *fox_w_kv, *fox_b_f, *fox_w_q, *fox_w_out, *peer_w_q, *peer_subk, *peer_u, *peer_v, *final_norm;
    float* out;
    unsigned* bar; float* mod; float* kvmod;
    bf16_t *Wt_in, *W16_in, *Wt_out, *Wt_kv, *W16_kv, *Wt_q, *Wt_fo, *Wt_pq, *subk; unsigned char *U8, *V8; float *su, *sv;
    bf16_t* xbuf; bf16_t *h, *hk, *h2, *og, *pq; int* ids; float* wts; float* fl; float* apart; signed char* cqbuf; float* scbuf; float* kn2; int* jlo;
    bf16_t *proj, *qt, *khT, *vT, *Pm; float* dec; bf16_t* o;
    bf16_t *qb, *gb, *Kb, *Vb, *ob; float* Fa;
    TMat tm[NTMAT];
    int ntr_jobs, pad0;
};

__device__ __forceinline__ unsigned cvtpk(float lo, float hi) { unsigned r; asm("v_cvt_pk_bf16_f32 %0, %1, %2" : "=v"(r) : "v"(lo), "v"(hi)); return r; }
__device__ __forceinline__ float bflo(unsigned w) { return __uint_as_float(w << 16); }
__device__ __forceinline__ float bfhi(unsigned w) { return __uint_as_float(w & 0xffff0000u); }
__device__ __forceinline__ bf16_t f2bf(float f) { return (bf16_t)(cvtpk(f, f) & 0xffffu); }
__device__ __forceinline__ float shfl_idx(float v, int src_lane) { return __builtin_bit_cast(float, __builtin_amdgcn_ds_bpermute(src_lane << 2, __builtin_bit_cast(int, v))); }
__device__ __forceinline__ float wave_sum_shfl(float v, int lane) {
#pragma unroll
    for (int o = 32; o > 0; o >>= 1) v += shfl_idx(v, lane ^ o);
    return v;
}
template <int CTRL> __device__ __forceinline__ int dpp_i(int x) { return __builtin_amdgcn_mov_dpp(x, CTRL, 0xf, 0xf, true); }
template <int CTRL> __device__ __forceinline__ float dpp_f(float x) { return __builtin_bit_cast(float, __builtin_amdgcn_mov_dpp(__builtin_bit_cast(int, x), CTRL, 0xf, 0xf, true)); }
__device__ __forceinline__ float rdlane(float v, int l) { return __builtin_bit_cast(float, __builtin_amdgcn_readlane(__builtin_bit_cast(int, v), l)); }
__device__ __forceinline__ float wave_sum_dpp(float v) {
    v += dpp_f<0xB1>(v); v += dpp_f<0x4E>(v); v += dpp_f<0x141>(v); v += dpp_f<0x128>(v);
    return (rdlane(v, 0) + rdlane(v, 16)) + (rdlane(v, 32) + rdlane(v, 48));
}
__device__ __forceinline__ float dot2bf(unsigned a, unsigned b, float acc) { return __builtin_amdgcn_fdot2_f32_bf16(__builtin_bit_cast(bf16x2, a), __builtin_bit_cast(bf16x2, b), acc, false); }
__device__ __forceinline__ float log_sigmoidf(float z) { return fminf(z, 0.f) - log1pf(expf(-fabsf(z))); }
__device__ __forceinline__ float log_sigmoid_fast(float z) { return fminf(z, 0.f) - __logf(1.f + __expf(-fabsf(z))); }
__device__ __forceinline__ float siluf(float z) { return z / (1.f + expf(-z)); }
__device__ __forceinline__ float sigmoidf_(float z) { return 1.f / (1.f + expf(-z)); }
__device__ __forceinline__ float gelu_tanh(float x) { const float u = 0.7978845608028654f * (x + 0.044715f * x * x * x); return 0.5f * x * (1.f + tanhf(u)); }
__device__ __forceinline__ u32x4 pack8f(const float (&v)[8]) { u32x4 w; w.x = cvtpk(v[0], v[1]); w.y = cvtpk(v[2], v[3]); w.z = cvtpk(v[4], v[5]); w.w = cvtpk(v[6], v[7]); return w; }
__device__ __forceinline__ void unpack8(const u32x4 w, float (&v)[8]) { v[0] = bflo(w.x); v[1] = bfhi(w.x); v[2] = bflo(w.y); v[3] = bfhi(w.y); v[4] = bflo(w.z); v[5] = bfhi(w.z); v[6] = bflo(w.w); v[7] = bfhi(w.w); }
#define MFMA16(a, b, c) __builtin_amdgcn_mfma_f32_16x16x32_bf16((a), (b), (c), 0, 0, 0)

constexpr int NGEMV = 208, NCONV = 2048 + 2048 + 16;
__device__ __forceinline__ void phase_prologue(int wv, const Params& p, unsigned char* lds, unsigned* qctr) {
    const int tid = ltid(wv), wid = wv, lane = tid & 63;
    const int bid_ = lbid(), ngrid_ = lgrid();
    float* cact = (float*)lds;
    float* red = (float*)(lds + 32768);
    float* tile = (float*)(lds + 65536);
    for (int i = tid; i < NBATCH * DM; i += NTHR) cact[i] = siluf(p.c[i]);
    __syncthreads();
    const int njobs = NGEMV + p.ntr_jobs + NCONV;
    volatile int* s_job = (volatile int*)(lds + 140 * 1024);
    (void)bid_; (void)ngrid_;
    if (tid == 0) *s_job = (int)__hip_atomic_fetch_add(qctr, 1u, __ATOMIC_RELAXED, __HIP_MEMORY_SCOPE_AGENT);
    __syncthreads();
    int job = __builtin_amdgcn_readfirstlane(*s_job);
    __syncthreads();
    for (; job < njobs; ) {
        if (tid == 0) *s_job = (int)__hip_atomic_fetch_add(qctr, 1u, __ATOMIC_RELAXED, __HIP_MEMORY_SCOPE_AGENT);
        if (job < NGEMV) {
            const float* W; const float* bias; float* outp; int N, ostride, cb;
            if (job < 192) { const int l = job / 48; cb = job % 48; W = p.ada_w + (size_t)l * DM * 12288; bias = p.ada_b + l * 12288; outp = p.mod + (size_t)l * NBATCH * 12288; N = 12288; ostride = 12288; }
            else { cb = job - 192; W = p.kv_ada_w; bias = p.kv_ada_b; outp = p.kvmod; N = 4096; ostride = 4096; }
            const int col = cb * 256 + 4 * lane;
            f32x4 acc[4];
#pragma unroll
            for (int b = 0; b < 4; ++b) acc[b] = (f32x4){0.f, 0.f, 0.f, 0.f};
            const float* wp = W + (size_t)(wid * 256) * N + col;
#pragma unroll 8
            for (int k = 0; k < 256; ++k) {
                const f32x4 w4 = *(const f32x4*)(wp + (size_t)k * N);
#pragma unroll
                for (int b = 0; b < 4; ++b) acc[b] += cact[b * DM + wid * 256 + k] * w4;
            }
#pragma unroll
            for (int b = 0; b < 4; ++b) *(f32x4*)(red + (wid * 4 + b) * 256 + 4 * lane) = acc[b];
            __syncthreads();
#pragma unroll
            for (int i = 0; i < 2; ++i) { const int o = tid + NTHR * i, b = o >> 8, cl = o & 255; float s = bias[cb * 256 + cl];
#pragma unroll
                for (int ks = 0; ks < 8; ++ks) s += red[(ks * 4 + b) * 256 + cl];
                outp[(size_t)b * ostride + cb * 256 + cl] = s; }
            __syncthreads();
        } else if (job < NGEMV + p.ntr_jobs) {
            const int j = job - NGEMV; int m = 0;
#pragma unroll
            for (int q = 1; q < NTMAT; ++q) if (j >= p.tm[q].first) m = q;
            const TMat M = p.tm[m];
            const int r = j - M.first, kt = r / M.ntn, nt4 = r - kt * M.ntn;
#pragma unroll
            for (int i = 0; i < 8; ++i) { const int idx = tid + NTHR * i, rr = idx >> 6, c4 = idx & 63, n = nt4 * 256 + 4 * c4;
                f32x4 v = (f32x4){0.f, 0.f, 0.f, 0.f};
                if (n < M.N) v = *(const f32x4*)(M.src + (size_t)(kt * 64 + rr) * M.N + n);
                float* tp = tile + ((c4 >> 4) * 64 + rr) * 65 + 4 * (c4 & 15); tp[0] = v[0]; tp[1] = v[1]; tp[2] = v[2]; tp[3] = v[3]; }
            __syncthreads();
#pragma unroll
            for (int q = 0; q < 4; ++q) { const int nl = tid >> 3, ks = tid & 7, n = nt4 * 256 + q * 64 + nl; float v[8];
#pragma unroll
              for (int e = 0; e < 8; ++e) v[e] = tile[(q * 64 + 8 * ks + e) * 65 + nl];
              const u32x4 w = pack8f(v);
              if (n < M.Nmain) *(u32x4*)(M.dst + (size_t)n * DM + kt * 64 + 8 * ks) = w;
              else if (n < M.N) *(u32x4*)(M.dst16 + (size_t)(n - M.Nmain) * DM + kt * 64 + 8 * ks) = w; }
            __syncthreads();
        } else {
            const int j = job - NGEMV - p.ntr_jobs;
            if (j < 4096) {
                const float* src = j < 2048 ? p.peer_u : p.peer_v; unsigned char* dst = j < 2048 ? p.U8 : p.V8; float* sc = j < 2048 ? p.su : p.sv; const int jj = j & 2047;
#pragma unroll
                for (int i = 0; i < 4; ++i) { const size_t row = (size_t)jj * 32 + wid * 4 + i; const float* rp = src + row * DM + 16 * lane;
                    f32x4 v[8];
#pragma unroll
                    for (int q = 0; q < 4; ++q) { v[q] = *(const f32x4*)(rp + 4 * q); v[4 + q] = *(const f32x4*)(rp + 1024 + 4 * q); }
                    float am = 0.f;
#pragma unroll
                    for (int q = 0; q < 8; ++q) am = fmaxf(fmaxf(fmaxf(am, fabsf(v[q][0])), fmaxf(fabsf(v[q][1]), fabsf(v[q][2]))), fabsf(v[q][3]));
#pragma unroll
                    for (int o = 32; o > 0; o >>= 1) am = fmaxf(am, shfl_idx(am, lane ^ o));
                    const float s = fmaxf(am, 1e-30f) * (1.f / 127.f), inv = 1.f / s;
                    unsigned w[8];
#pragma unroll
                    for (int q = 0; q < 8; ++q) { unsigned ww = 0u;
#pragma unroll
                        for (int e = 0; e < 4; ++e) { const int qi = (int)rintf(v[q][e] * inv); ww |= (unsigned)(qi & 0xff) << (8 * e); }
                        w[q] = ww; }
                    *(u32x4*)(dst + row * DM + 16 * lane) = (u32x4){w[0], w[1], w[2], w[3]}; *(u32x4*)(dst + row * DM + 1024 + 16 * lane) = (u32x4){w[4], w[5], w[6], w[7]};
                    if (lane == 0) sc[row] = s; }
            } else {
                const size_t base = (size_t)(j - 4096) * 65536; const float* src = p.peer_subk; bf16_t* dst = p.subk;
#pragma unroll 4
                for (int i = 0; i < 16; ++i) { const size_t e = base + (size_t)(i * NTHR + tid) * 8;
                    const f32x4 a = *(const f32x4*)(src + e), b = *(const f32x4*)(src + e + 4);
                    u32x4 w; w.x = cvtpk(a[0], a[1]); w.y = cvtpk(a[2], a[3]); w.z = cvtpk(b[0], b[1]); w.w = cvtpk(b[2], b[3]);
                    *(u32x4*)(dst + e) = w; }
            }
        }
        __syncthreads();
        job = __builtin_amdgcn_readfirstlane(*s_job);
        __syncthreads();
    }
}

template <bool TWO, bool FINAL, bool XF32 = false>
__device__ __forceinline__ void phase_norm(int wv, const void* xv, const float* g1, const float* sh1, const float* sc1, int ms1, bf16_t* out1,
                                           const float* g2, const float* sh2, const float* sc2, int ms2, bf16_t* out2, float* outf) {
    const int tid = ltid(wv), lane = tid & 63;
    const int bid_ = lbid(), ngrid_ = lgrid();
    for (int r0 = (bid_ * NWAVE + wv) * 8; r0 < TT; r0 += ngrid_ * NWAVE * 8) {
        const int b = r0 >> 12;
        f32x4 a1[8], s1[8], a2[8], s2[8];
#pragma unroll
        for (int i = 0; i < 4; ++i)
#pragma unroll
            for (int hh = 0; hh < 2; ++hh) { const int c = 8 * (lane + 64 * i) + 4 * hh;
                if constexpr (FINAL) { a1[2 * i + hh] = *(const f32x4*)(g1 + c); }
                else { a1[2 * i + hh] = *(const f32x4*)(g1 + c) * (1.f + *(const f32x4*)(sc1 + (size_t)b * ms1 + c)); s1[2 * i + hh] = *(const f32x4*)(sh1 + (size_t)b * ms1 + c); }
                if constexpr (TWO) { a2[2 * i + hh] = *(const f32x4*)(g2 + c) * (1.f + *(const f32x4*)(sc2 + (size_t)b * ms2 + c)); s2[2 * i + hh] = *(const f32x4*)(sh2 + (size_t)b * ms2 + c); } }
        for (int rr = 0; rr < 8; ++rr) { const int row = r0 + rr;
            f32x4 v[8]; float ss = 0.f;
            if constexpr (XF32) { const float* xr = (const float*)xv + (size_t)row * DM;
#pragma unroll
                for (int i = 0; i < 4; ++i) { const int c = 8 * (lane + 64 * i); v[2 * i] = *(const f32x4*)(xr + c); v[2 * i + 1] = *(const f32x4*)(xr + c + 4); } }
            else { const bf16_t* xr = (const bf16_t*)xv + (size_t)row * DM;
#pragma unroll
                for (int i = 0; i < 4; ++i) { float t8[8]; unpack8(*(const u32x4*)(xr + 8 * (lane + 64 * i)), t8); v[2 * i] = (f32x4){t8[0], t8[1], t8[2], t8[3]}; v[2 * i + 1] = (f32x4){t8[4], t8[5], t8[6], t8[7]}; } }
#pragma unroll
            for (int i = 0; i < 8; ++i) ss += v[i][0] * v[i][0] + v[i][1] * v[i][1] + v[i][2] * v[i][2] + v[i][3] * v[i][3];
            ss = wave_sum_shfl(ss, lane);
            const float rs = rsqrtf(ss * (1.f / DM) + RMS_EPS);
#pragma unroll
            for (int i = 0; i < 4; ++i) { const int c = 8 * (lane + 64 * i);
                if constexpr (FINAL) { *(f32x4*)(outf + (size_t)row * DM + c) = v[2 * i] * rs * a1[2 * i]; *(f32x4*)(outf + (size_t)row * DM + c + 4) = v[2 * i + 1] * rs * a1[2 * i + 1]; }
                else {
                    { const f32x4 ya = v[2 * i] * rs * a1[2 * i] + s1[2 * i], yb = v[2 * i + 1] * rs * a1[2 * i + 1] + s1[2 * i + 1];
                      u32x4 w; w.x = cvtpk(ya[0], ya[1]); w.y = cvtpk(ya[2], ya[3]); w.z = cvtpk(yb[0], yb[1]); w.w = cvtpk(yb[2], yb[3]);
                      *(u32x4*)(out1 + (size_t)row * DM + c) = w; }
                    if constexpr (TWO) { const f32x4 ya = v[2 * i] * rs * a2[2 * i] + s2[2 * i], yb = v[2 * i + 1] * rs * a2[2 * i + 1] + s2[2 * i + 1];
                      u32x4 w; w.x = cvtpk(ya[0], ya[1]); w.y = cvtpk(ya[2], ya[3]); w.z = cvtpk(yb[0], yb[1]); w.w = cvtpk(yb[2], yb[3]);
                      *(u32x4*)(out2 + (size_t)row * DM + c) = w; }
                }
            }
        }
    }
}

__device__ __forceinline__ void mini16(int wv, const bf16_t* A  , const bf16_t* W16, float* gls) {
    const int tid = ltid(wv), wid = wv, lane = tid & 63, fr = lane & 15, fq = lane >> 4, mt = wid & 3, kh = wid >> 2;
    f32x4 acc = (f32x4){0.f, 0.f, 0.f, 0.f};
    const bf16_t* ap = A + (size_t)(16 * mt + fr) * DM + kh * 1024 + 8 * fq;
    const bf16_t* bp = W16 + (size_t)fr * DM + kh * 1024 + 8 * fq;
    bf16x8 af[12], bfr[12];
#define MINI_BATCH(k0, n) do { __builtin_amdgcn_sched_barrier(0);                                                                                  \
        _Pragma("unroll") for (int j = 0; j < (n); ++j) { af[j] = *(const bf16x8*)(ap + 32 * ((k0) + j)); bfr[j] = *(const bf16x8*)(bp + 32 * ((k0) + j)); } \
        __builtin_amdgcn_sched_barrier(0);                                                                                                         \
        _Pragma("unroll") for (int j = 0; j < (n); ++j) acc = MFMA16(af[j], bfr[j], acc); } while (0)
    MINI_BATCH(0, 12); MINI_BATCH(12, 12); MINI_BATCH(24, 8);
#undef MINI_BATCH
    __builtin_amdgcn_sched_barrier(0);
#pragma unroll
    for (int i = 0; i < 4; ++i) gls[(kh * 64 + 16 * mt + 4 * fq + i) * 16 + fr] = acc[i];
}

constexpr int PREP_GLS = 0, PREP_TOT = 8192, PREP_BLOC = 10240, PREP_X = 75776, PREP_Y = 109568, PREP_PS = 143360;
constexpr int XLD = 264, TLD = 72;
template <int PV>
__device__ __forceinline__ void phase_gla_prep(int wv, const Params& p, int l, unsigned char* lds) {
    const int tid = ltid(wv), wid = wv, lane = tid & 63, fr = lane & 15, fq = lane >> 4;
    const int bid_ = lbid(), ngrid_ = lgrid();
    float* gls = (float*)(lds + PREP_GLS); float* tot0 = (float*)(lds + PREP_TOT); float* bloc = (float*)(lds + PREP_BLOC);
    const unsigned xlds = (unsigned)(uintptr_t)(LAS unsigned char*)(lds + PREP_X);
    bf16_t* X = (bf16_t*)(lds + PREP_X); bf16_t* Y = (bf16_t*)(lds + PREP_Y); bf16_t* Ps = (bf16_t*)(lds + PREP_PS);
    const float* wg2 = p.gla_wg2 + (size_t)l * 16 * 1024; const float* bg2 = p.gla_bg2 + l * 1024;
    const bf16_t* W16 = p.W16_in + (size_t)l * 16 * DM;
    for (int u = bid_; u < 256; u += ngrid_) {
        const int tok0 = (u >> 6) * SEQ + (u & 63) * 64;
        if (PV != 4) mini16(wv, p.h + (size_t)tok0 * DM, W16, gls);
        __syncthreads();
        { const float s0 = gls[tid] + gls[1024 + tid], s1 = gls[NTHR + tid] + gls[1024 + NTHR + tid]; gls[tid] = s0; gls[NTHR + tid] = s1; }
        __syncthreads();
        for (int hd = 0; hd < 4; ++hd) {
            const size_t uh = (size_t)u * 4 + hd;
            u32x4 qw[4], kw[4];
#pragma unroll
            for (int i = 0; i < 4; ++i) { const int idx = tid + NTHR * i, t = idx >> 5, k0 = 8 * (idx & 31);
                const bf16_t* pr = p.proj + (size_t)(tok0 + t) * GLA_NM + hd * 256 + k0; qw[i] = *(const u32x4*)pr; kw[i] = *(const u32x4*)(pr + 1024); }
            for (int rep_ = 0; rep_ < (PV == 6 ? 2 : 1); ++rep_) if (PV != 1) { if (rep_) __syncthreads(); const int k = tid & 255, half = tid >> 8; float wg[16];
#pragma unroll
              for (int r = 0; r < 16; ++r) wg[r] = wg2[r * 1024 + hd * 256 + k];
              const float bg = bg2[hd * 256 + k]; float run = 0.f;
              fl2 wp[8];
#pragma unroll
              for (int r = 0; r < 8; ++r) wp[r] = (fl2){wg[2 * r], wg[2 * r + 1]};
              for (int tt = 0; tt < 32; tt += 4) { const int t = 32 * half + tt; const f32x4* gp = (const f32x4*)(gls + t * 16);
                  f32x4 gq[16];
                  __builtin_amdgcn_sched_barrier(0);
#pragma unroll
                  for (int i = 0; i < 16; ++i) gq[i] = gp[i];
                  __builtin_amdgcn_sched_barrier(0);
                  fl2 z2[4];
#pragma unroll
                  for (int j = 0; j < 4; ++j) z2[j] = (fl2){bg, 0.f};
#pragma unroll
                  for (int q = 0; q < 4; ++q)
#pragma unroll
                      for (int j = 0; j < 4; ++j) { const f32x4 g = gq[4 * j + q]; z2[j] += (fl2){g[0], g[1]} * wp[2 * q]; z2[j] += (fl2){g[2], g[3]} * wp[2 * q + 1]; }
                  float ls[4];
#pragma unroll
                  for (int j = 0; j < 4; ++j) { const float z = z2[j][0] + z2[j][1];
                      ls[j] = fminf(z, 0.f) - 0.6931471805599453f * __builtin_amdgcn_logf(1.f + __builtin_amdgcn_exp2f(-1.4426950408889634f * fabsf(z))); }
#pragma unroll
                  for (int j = 0; j < 4; ++j) { run += ls[j] * (1.f / 16.f); bloc[(t + j) * 256 + k] = run; } }
              if (half == 0) tot0[k] = run; }
            __syncthreads();
            f32x4 Lacc[2];
#pragma unroll
            for (int pass = 0; pass < 2; ++pass) {
#pragma unroll
                for (int i = 0; i < 4; ++i) { const int idx = tid + NTHR * i, t = idx >> 5, g = idx & 31, k0 = 8 * g;
                    float q8[8], k8[8]; unpack8(qw[i], q8); unpack8(kw[i], k8);
                    float xo[8], yo[8];
#pragma unroll
                    for (int e = 0; e < 8; ++e) { const float ep = __expf(bloc[t * 256 + k0 + e] + (t >= 32 ? tot0[k0 + e] : 0.f)), em = __frcp_rn(ep);
                        xo[e] = q8[e] * 0.0625f * (pass == 0 ? ep : em); yo[e] = k8[e] * (pass == 0 ? em : ep); }
                    const u32x4 xw = pack8f(xo), yw = pack8f(yo);
                    *(u32x4*)(X + t * XLD + k0) = xw; *(u32x4*)(Y + t * XLD + k0) = yw;
                    if (pass == 0) { const int G = g >> 2, a = g & 3, p1 = ((a & 1) << 4) | ((a >> 1) << 2);
                        bf16_t* qo = p.qt + uh * 16384 + ((size_t)((G * 4 + (t >> 4)) * 64 + (p1 >> 3) * 16 + (t & 15))) * 8 + (p1 & 7);
                        if (PV != 9) { *(uint2*)qo = make_uint2(xw.x, xw.y); *(uint2*)(qo + 128) = make_uint2(xw.z, xw.w); } } }
                __syncthreads();
#pragma unroll
                for (int j = 0; j < (PV == 3 ? 0 : 2); ++j) { const int tt = 2 * wid + j, mt = tt >> 2, nt = tt & 3; f32x4 acc = (f32x4){0.f, 0.f, 0.f, 0.f};
#pragma unroll
                    for (int ks = 0; ks < 8; ++ks) { const bf16x8 a = *(const bf16x8*)(X + (16 * mt + fr) * XLD + 32 * ks + 8 * fq), b = *(const bf16x8*)(Y + (16 * nt + fr) * XLD + 32 * ks + 8 * fq);
                        acc = MFMA16(a, b, acc); }
                    if (pass == 0) Lacc[j] = acc;
                    else {
#pragma unroll
                        for (int i = 0; i < 4; ++i) { const int t = 16 * mt + 4 * fq + i, s = 16 * nt + fr; Ps[t * TLD + s] = f2bf(s <= t ? Lacc[j][i] : acc[i]); } } }
                __syncthreads();
            }
            { const int row = tid >> 3, seg = tid & 7;
              if (PV != 9) *(u32x4*)(p.Pm + uh * 4096 + ((size_t)(((row >> 4) * 2 + (seg >> 2)) * 64 + (seg & 3) * 16 + (row & 15))) * 8) = *(const u32x4*)(Ps + row * TLD + 8 * seg); }
            if (PV != 5) { float eb[8];
#pragma unroll
              for (int e = 0; e < 8; ++e) eb[e] = __expf(bloc[63 * 256 + 8 * (tid & 31) + e] + tot0[8 * (tid & 31) + e]);
#pragma unroll
              for (int i = 0; i < 4; ++i) { const int idx = tid + NTHR * i, t = idx >> 5, g = idx & 31, k0 = 8 * g;
                float k8[8], kh[8]; unpack8(kw[i], k8);
#pragma unroll
                for (int e = 0; e < 8; ++e) { kh[e] = k8[e] * eb[e] * __expf(-(bloc[t * 256 + k0 + e] + (t >= 32 ? tot0[k0 + e] : 0.f)));
                    if (PV != 9 && t == 0) p.dec[uh * 256 + k0 + e] = eb[e]; }
                *(u32x4*)(X + t * XLD + k0) = pack8f(kh); } }
            __syncthreads();
#define PREP_TR_OUT(DST, FBASE) do { const unsigned la_ = xlds + (unsigned)(((8 * (lane >> 4) + ((lane & 15) >> 2)) * XLD + 4 * (lane & 3)) * 2);                     \
                _Pragma("unroll") for (int f = 0; f < 4; ++f) { const int fi = wid * 4 + f, cb = fi >> 1, ks = fi & 1; const unsigned a_ = la_ + (unsigned)((32 * ks * XLD + 16 * cb) * 2); \
                    s16x4 lo_, hi_;                                                                                                                       \
                    asm volatile("ds_read_b64_tr_b16 %0, %1" : "=&v"(lo_) : "v"(a_) : "memory");                                                           \
                    asm volatile("ds_read_b64_tr_b16 %0, %1 offset:%2" : "=&v"(hi_) : "v"(a_), "i"(4 * XLD * 2) : "memory");                                 \
                    asm volatile("s_waitcnt lgkmcnt(0)" ::: "memory");                                                                                     \
                    const uint2 l2_ = __builtin_bit_cast(uint2, lo_), h2_ = __builtin_bit_cast(uint2, hi_);                                                 \
                    if (PV != 9) *(u32x4*)((DST) + ((size_t)(((FBASE) + cb * 2 + ks) * 64 + lane)) * 8) = (u32x4){l2_.x, l2_.y, h2_.x, h2_.y}; } } while (0)
            if (PV != 5) PREP_TR_OUT(p.khT + uh * 16384, 0);
            __syncthreads();
        }
    }
}

#undef PREP_TR_OUT
constexpr int REC_LD = 36;
struct RecOps { bf16x8 aq[4], ak[2][2], ap[2]; f32x4 dv[2]; };
constexpr int REC_VOFF = 8 * 64 * REC_LD * 4, REC_VS = 96, REC_VBUF = 64 * REC_VS;
__device__ __forceinline__ void rec_load_a(RecOps& R, const Params& p, size_t uh, int w, int lane) {
    const bf16_t* qt = p.qt + uh * 16384 + lane * 8; const bf16_t* Pm = p.Pm + uh * 4096 + lane * 8;
#pragma unroll
    for (int mt = 0; mt < 4; ++mt) R.aq[mt] = *(const bf16x8*)(qt + (w * 4 + mt) * 512);
    const int mp = w >> 1;
    R.ap[0] = *(const bf16x8*)(Pm + (mp * 2) * 512); R.ap[1] = *(const bf16x8*)(Pm + (mp * 2 + 1) * 512);
}
__device__ __forceinline__ void rec_load_b(RecOps& R, const Params& p, size_t uh, int d0, int w, int lane) {
    const bf16_t* khT = p.khT + uh * 16384 + lane * 8; const float* dec = p.dec + uh * 256;
#pragma unroll
    for (int i = 0; i < 2; ++i) { R.ak[i][0] = *(const bf16x8*)(khT + ((2 * w + i) * 2) * 512); R.ak[i][1] = *(const bf16x8*)(khT + ((2 * w + i) * 2 + 1) * 512);
        R.dv[i] = *(const f32x4*)(dec + 16 * (2 * w + i) + 4 * (lane >> 4)); }
}
__device__ __forceinline__ void rec_load(RecOps& R, const Params& p, size_t uh, int d0, int w, int lane) { rec_load_a(R, p, uh, w, lane); rec_load_b(R, p, uh, d0, w, lane); }
template <int VAR>
__device__ __forceinline__ void phase_gla_rec(int wv, const Params& p, unsigned char* lds) {
    const int tid = ltid(wv), w = wv, lane = tid & 63, fr = lane & 15, fq = lane >> 4;
    const int bid_ = lbid(), ngrid_ = lgrid();
    float* red = (float*)lds;
    for (int u = bid_; u < 256; u += ngrid_) {
        const int g_ = (u & 7) * 2 + ((u >> 3) >> 4), b = g_ >> 2, hd = g_ & 3, d0 = ((u >> 3) & 15) * 32;
        f32x4 S[2][2];
#pragma unroll
        for (int i = 0; i < 2; ++i)
#pragma unroll
            for (int n = 0; n < 2; ++n) S[i][n] = (f32x4){0.f, 0.f, 0.f, 0.f};
        RecOps RA = {}, RB = {};
        const bf16_t* vsrc = p.proj + (size_t)(b * SEQ + (tid >> 3)) * GLA_NM + 2048 + hd * 512 + d0 + 4 * (tid & 7);
        unsigned char* vwr = lds + REC_VOFF + (tid >> 3) * REC_VS + 8 * (tid & 7);
        const unsigned vrd = (unsigned)(uintptr_t)(LAS unsigned char*)(lds + REC_VOFF) + (unsigned)((8 * (lane >> 4) + ((lane & 15) >> 2)) * REC_VS + 8 * (lane & 3));
        uint2 vreg = *(const uint2*)vsrc;
        __builtin_amdgcn_sched_barrier(0); __builtin_amdgcn_s_waitcnt(0); __builtin_amdgcn_sched_barrier(0);
        if (VAR != 2) { rec_load(RA, p, ((size_t)(b * 64)) * 4 + hd, d0, w, lane); __builtin_amdgcn_sched_barrier(0);
                        rec_load(RB, p, ((size_t)(b * 64 + 1)) * 4 + hd, d0, w, lane); __builtin_amdgcn_sched_barrier(0); }
        *(uint2*)vwr = vreg; vreg = *(const uint2*)(vsrc + (size_t)64 * GLA_NM);
        __syncthreads();
#define REC_STEP(CUR, NXT, c) do {                                                                                                             \
            __builtin_amdgcn_sched_barrier(0);     \
            bf16x8 bv[2][2];                                                                                                                     \
            _Pragma("unroll") for (int n = 0; n < 2; ++n) _Pragma("unroll") for (int ks = 0; ks < 2; ++ks) { s16x4 lo_, hi_; const unsigned a_ = vrd + (unsigned)(((c) & 1) * REC_VBUF + 32 * ks * REC_VS + 32 * n); \
                asm volatile("ds_read_b64_tr_b16 %0, %1" : "=&v"(lo_) : "v"(a_) : "memory");                                                       \
                asm volatile("ds_read_b64_tr_b16 %0, %1 offset:%2" : "=&v"(hi_) : "v"(a_), "i"(4 * REC_VS) : "memory");                               \
                asm volatile("s_waitcnt lgkmcnt(0)" ::: "memory");                                                                                 \
                const uint2 l2_ = __builtin_bit_cast(uint2, lo_), h2_ = __builtin_bit_cast(uint2, hi_);                                             \
                bv[n][ks] = __builtin_bit_cast(bf16x8, ((u32x4){l2_.x, l2_.y, h2_.x, h2_.y})); }                                                     \
            f32x4 acc[4][2];                                                                                                                     \
            { bf16x8 bs[2];                                                                                                                      \
              _Pragma("unroll") for (int n = 0; n < 2; ++n) { u32x4 sw; sw.x = cvtpk(S[0][n][0], S[0][n][1]); sw.y = cvtpk(S[0][n][2], S[0][n][3]);     \
                  sw.z = cvtpk(S[1][n][0], S[1][n][1]); sw.w = cvtpk(S[1][n][2], S[1][n][3]); bs[n] = __builtin_bit_cast(bf16x8, sw); }              \
              _Pragma("unroll") for (int mt = 0; mt < 4; ++mt) _Pragma("unroll") for (int n = 0; n < 2; ++n) acc[mt][n] = MFMA16(CUR.aq[mt], bs[n], ((f32x4){0.f, 0.f, 0.f, 0.f})); } \
            const int mp = w >> 1, np = w & 1;                                                                                                   \
            f32x4 accp = MFMA16(CUR.ap[0], (np ? bv[1][0] : bv[0][0]), ((f32x4){0.f, 0.f, 0.f, 0.f}));                                     \
            accp = MFMA16(CUR.ap[1], (np ? bv[1][1] : bv[0][1]), accp);                                                                   \
            __builtin_amdgcn_sched_barrier(0);                                                                                                   \
            if (VAR != 2) rec_load_a(CUR, p, ((size_t)(b * 64 + ((c) + 2 < 64 ? (c) + 2 : 63))) * 4 + hd, w, lane);     \
            __builtin_amdgcn_sched_barrier(0);                                                                                                   \
            if (VAR != 2) { *(uint2*)(vwr + (((c) + 1) & 1) * REC_VBUF) = vreg;     \
                vreg = *(const uint2*)(vsrc + (size_t)((c) + 2 < 64 ? (c) + 2 : 63) * 64 * GLA_NM); }                                                \
            __builtin_amdgcn_sched_barrier(0);                                                                                                   \
            _Pragma("unroll") for (int mt = 0; mt < 4; ++mt) _Pragma("unroll") for (int n = 0; n < 2; ++n) {                                      \
                const f32x4 v_ = (mt == mp && n == np) ? acc[mt][n] + accp : acc[mt][n];                                                          \
                _Pragma("unroll") for (int r_ = 0; r_ < 4; ++r_) red[(w * 64 + 16 * mt + 4 * fq + r_) * REC_LD + 16 * n + fr] = v_[r_]; }            \
            if (VAR != 1) __syncthreads();                                                                                                       \
            { const int t_ = tid >> 3, c4_ = (tid & 7) * 4; f32x4 s_ = *(const f32x4*)(red + t_ * REC_LD + c4_);                                  \
              _Pragma("unroll") for (int ww = 1; ww < 8; ++ww) s_ += *(const f32x4*)(red + (ww * 64 + t_) * REC_LD + c4_);                          \
              *(uint2*)(p.o + (size_t)(b * SEQ + (c) * 64 + t_) * DM + hd * 512 + d0 + c4_) = make_uint2(cvtpk(s_[0], s_[1]), cvtpk(s_[2], s_[3])); }     \
            _Pragma("unroll") for (int i = 0; i < 2; ++i) _Pragma("unroll") for (int n = 0; n < 2; ++n) {                                          \
                S[i][n] = S[i][n] * CUR.dv[i]; S[i][n] = MFMA16(CUR.ak[i][0], bv[n][0], S[i][n]); S[i][n] = MFMA16(CUR.ak[i][1], bv[n][1], S[i][n]); } \
            __builtin_amdgcn_sched_barrier(0);                                                                                                   \
            if (VAR != 2) { const int cn_ = (c) + 2 < 64 ? (c) + 2 : 63; rec_load_b(CUR, p, ((size_t)(b * 64 + cn_)) * 4 + hd, d0, w, lane); }     \
            if (VAR != 1) __syncthreads(); } while (0)
        for (int c = 0; c < 64; c += 2) { REC_STEP(RA, RB, c); REC_STEP(RB, RA, c + 1); }
#undef REC_STEP
    }
}

__device__ __forceinline__ void phase_gla_onorm(int wv, const Params& p, int l) {
    const int tid = ltid(wv), wid = wv, lane = tid & 63;
    const int bid_ = lbid(), ngrid_ = lgrid();
    const float* gn = p.gla_norm + l * 512 + 8 * lane;
    const f32x4 ga = *(const f32x4*)gn, gb = *(const f32x4*)(gn + 4);
    for (int row = bid_ * NWAVE + wid; row < TT; row += ngrid_ * NWAVE) {
        u32x4 ow[4], gw[4];
#pragma unroll
        for (int i = 0; i < 4; ++i) { const int c = 512 * i + 8 * lane; ow[i] = *(const u32x4*)(p.o + (size_t)row * DM + c); gw[i] = *(const u32x4*)(p.proj + (size_t)row * GLA_NM + 4096 + c); }
#pragma unroll
        for (int i = 0; i < 4; ++i) { const int c = 512 * i + 8 * lane;
            float o8[8], g8[8]; unpack8(ow[i], o8); unpack8(gw[i], g8);
            float ss = 0.f;
#pragma unroll
            for (int e = 0; e < 8; ++e) ss = fmaf(o8[e], o8[e], ss);
            ss = wave_sum_dpp(ss);
            const float rs = rsqrtf(ss * (1.f / 512.f) + RMS_EPS);
            float y[8];
#pragma unroll
            for (int e = 0; e < 4; ++e) { y[e] = o8[e] * rs * ga[e] * (g8[e] * __builtin_amdgcn_rcpf(1.f + __expf(-g8[e]))); y[4 + e] = o8[4 + e] * rs * gb[e] * (g8[4 + e] * __builtin_amdgcn_rcpf(1.f + __expf(-g8[4 + e]))); }
            *(u32x4*)(p.og + (size_t)row * DM + c) = pack8f(y); }
    }
}

constexpr int TK_SC = 0;
template <int N> __device__ __forceinline__ void top_insert(float (&L)[N], float v) {
#pragma unroll
    for (int j = N - 1; j >= 1; --j) L[j] = __builtin_amdgcn_fmed3f(L[j - 1], L[j], v);
    L[0] = fmaxf(L[0], v);
}
__device__ __forceinline__ void phase_peer_topk(int wv, const Params& p, int l, unsigned char* lds) {
    const int tid = ltid(wv), wid = wv, lane = tid & 63, fr = lane & 15, fq = lane >> 4;
    const int bid_ = lbid(), ngrid_ = lgrid();
    float* sc = (float*)(lds + TK_SC); unsigned* scu = (unsigned*)(lds + TK_SC);
    const int hd = bid_ & 7, nm = (ngrid_ - hd + 7) >> 3, pp = wid >> 2, mq = wid & 3;
    bf16x8 bfr[8][4];
    { const bf16_t* bp = p.subk + ((size_t)((l * 8 + hd) * 2 + pp) * 128 + fr) * 128 + 8 * fq;
#pragma unroll
      for (int nt = 0; nt < 8; ++nt)
#pragma unroll
          for (int ks = 0; ks < 4; ++ks) bfr[nt][ks] = *(const bf16x8*)(bp + (size_t)nt * 16 * 128 + 32 * ks); }
    for (int tile = bid_ >> 3; tile < TT / 128; tile += nm) {
        const int tok0 = tile * 128;
        { const bf16_t* ap = p.pq + (size_t)(tok0 + 32 * mq + fr) * DM + hd * 256 + pp * 128 + 8 * fq;
          bf16x8 a[2][4];
#pragma unroll
          for (int m = 0; m < 2; ++m)
#pragma unroll
              for (int ks = 0; ks < 4; ++ks) a[m][ks] = *(const bf16x8*)(ap + (size_t)m * 16 * DM + 32 * ks);
#pragma unroll
          for (int m = 0; m < 2; ++m)
#pragma unroll
              for (int nt = 0; nt < 8; ++nt) { f32x4 acc = (f32x4){0.f, 0.f, 0.f, 0.f};
#pragma unroll
                  for (int ks = 0; ks < 4; ++ks) acc = MFMA16(a[m][ks], bfr[nt][ks], acc);
#pragma unroll
                  for (int i = 0; i < 4; ++i) sc[(pp * 128 + 32 * mq + 16 * m + 4 * fq + i) * 129 + 16 * nt + fr] = acc[i]; } }
        __syncthreads();
        { const int q = tid >> 1, half = tid & 1; const float* sp = sc + q * 129 + 64 * half;
          float L[16];
#pragma unroll
          for (int j = 0; j < 16; ++j) L[j] = -3.0e38f;
#pragma unroll
          for (int n = 0; n < 16; ++n) { const float v = __uint_as_float((__float_as_uint(sp[n]) & ~127u) | (unsigned)(64 * half + n));
#pragma unroll
              for (int j = 15; j >= 1; --j) if (j <= n) L[j] = __builtin_amdgcn_fmed3f(L[j - 1], L[j], v);
              L[0] = fmaxf(L[0], v); }
#pragma unroll 8
          for (int n = 16; n < 64; ++n) { const float v = __uint_as_float((__float_as_uint(sp[n]) & ~127u) | (unsigned)(64 * half + n)); top_insert<16>(L, v); }
#pragma unroll
          for (int j = 0; j < 16; ++j) scu[q * 129 + 64 * half + j] = __float_as_uint(L[j]); }
        __syncthreads();
        if (tid < 256) { const int q = tid; float M[16];
#pragma unroll
            for (int j = 0; j < 16; ++j) M[j] = fmaxf(sc[q * 129 + j], sc[q * 129 + 64 + 15 - j]);
#pragma unroll
            for (int d = 8; d >= 1; d >>= 1)
#pragma unroll
                for (int i = 0; i < 16; ++i) if ((i & d) == 0) { const float hi = fmaxf(M[i], M[i + d]), lo = fminf(M[i], M[i + d]); M[i] = hi; M[i + d] = lo; }
#pragma unroll
            for (int j = 0; j < 16; ++j) sc[q * 129 + j] = M[j]; }
        __syncthreads();
        if (tid < 128) { const int t = tid; const unsigned* ta = scu + t * 129; const unsigned* tb = scu + (128 + t) * 129;
            float a[16], b[16], M[16];
#pragma unroll
            for (int j = 0; j < 16; ++j) { a[j] = __uint_as_float(ta[j]); b[j] = __uint_as_float(tb[j]); M[j] = -3.0e38f; }
            int cnt = 0;
#pragma unroll
            for (int i = 0; i < 16; ++i)
#pragma unroll
                for (int j = 0; j < 16; ++j) if ((i + 1) * (j + 1) <= 16) { const float s = a[i] + b[j]; const float v = __uint_as_float((__float_as_uint(s) & ~255u) | (unsigned)(i * 16 + j));
#pragma unroll
                    for (int q = 15; q >= 1; --q) if (q <= cnt) M[q] = __builtin_amdgcn_fmed3f(M[q - 1], M[q], v);
                    M[0] = fmaxf(M[0], v); ++cnt; }
            float e[16], sum = 0.f;
#pragma unroll
            for (int r = 0; r < 16; ++r) { e[r] = __expf(M[r] - M[0]); sum += e[r]; }
            const float inv = 1.f / sum;
            unsigned idp[8];
#pragma unroll
            for (int r = 0; r < 16; ++r) { const unsigned code = __float_as_uint(M[r]) & 255u; const unsigned ia = ta[code >> 4] & 127u, ib = tb[code & 15u] & 127u, id = ia * 128u + ib;
                if (r & 1) idp[r >> 1] |= id << 16; else idp[r >> 1] = id; e[r] *= inv; }
            { unsigned short* ip = (unsigned short*)p.ids + (size_t)(tok0 + t) * 128 + hd * 16; float* wp = p.wts + (size_t)(tok0 + t) * 128 + hd * 16;
              *(u32x4*)ip = (u32x4){idp[0], idp[1], idp[2], idp[3]}; *(u32x4*)(ip + 8) = (u32x4){idp[4], idp[5], idp[6], idp[7]};
#pragma unroll
              for (int q = 0; q < 4; ++q) *(f32x4*)(wp + 4 * q) = (f32x4){e[4 * q], e[4 * q + 1], e[4 * q + 2], e[4 * q + 3]}; } }
        __syncthreads();
    }
}

__device__ __forceinline__ float ub0(unsigned w) { return (float)(w & 0xffu); }
__device__ __forceinline__ float ub1(unsigned w) { return (float)((w >> 8) & 0xffu); }
__device__ __forceinline__ float ub2(unsigned w) { return (float)((w >> 16) & 0xffu); }
__device__ __forceinline__ float ub3(unsigned w) { return (float)(w >> 24); }
__device__ __forceinline__ float row16_sum(float v) { v += dpp_f<0xB1>(v); v += dpp_f<0x4E>(v); v += dpp_f<0x141>(v); v += dpp_f<0x128>(v); return v; }
#define G_IDS(idr) u32x4 idw = (u32x4){0u, 0u, 0u, 0u}; if (c < 4) idw = *(const u32x4*)((idr) + 8 * c)
#define G_LOADB(R, T, bb) do { const unsigned ix_ = (unsigned)dpp_i<0x150 + (bb)>((int)idw.x), iy_ = (unsigned)dpp_i<0x150 + (bb)>((int)idw.y), iz_ = (unsigned)dpp_i<0x150 + (bb)>((int)idw.z), iw_ = (unsigned)dpp_i<0x150 + (bb)>((int)idw.w); \
            R[0] = *(const u32x4*)((T) + ((ix_ & 0xffffu) * (unsigned)DM + lo)); R[1] = *(const u32x4*)((T) + ((ix_ >> 16) * (unsigned)DM + lo)); R[2] = *(const u32x4*)((T) + ((iy_ & 0xffffu) * (unsigned)DM + lo)); R[3] = *(const u32x4*)((T) + ((iy_ >> 16) * (unsigned)DM + lo)); \
            R[4] = *(const u32x4*)((T) + ((iz_ & 0xffffu) * (unsigned)DM + lo)); R[5] = *(const u32x4*)((T) + ((iz_ >> 16) * (unsigned)DM + lo)); R[6] = *(const u32x4*)((T) + ((iw_ & 0xffffu) * (unsigned)DM + lo)); R[7] = *(const u32x4*)((T) + ((iw_ >> 16) * (unsigned)DM + lo)); } while (0)
__device__ __forceinline__ void phase_peer_gather1(int wv, const Params& p, int l) {
    const int tid = ltid(wv), lane = tid & 63, j = lane >> 4, c = lane & 15;
    const int bid_ = lbid(), ngrid_ = lgrid();
    const int r = bid_ & 7, m = bid_ >> 3, nm = (ngrid_ - r + 7) >> 3;
    const unsigned char* Ub = p.U8 + (size_t)l * 16384 * DM + 256 * r; const unsigned lo = 16u * (unsigned)c;
    bf16_t* ap = (bf16_t*)p.apart + (size_t)r * TT * 128;
    for (int tok = m * NWAVE + wv; tok < TT; tok += nm * NWAVE) {
        float hf[16];
        { const bf16_t* hp = p.h2 + (size_t)tok * DM + 256 * r + 16 * c; float t8[8];
          unpack8(*(const u32x4*)hp, t8);
#pragma unroll
          for (int e = 0; e < 8; ++e) hf[e] = t8[e];
          unpack8(*(const u32x4*)(hp + 8), t8);
#pragma unroll
          for (int e = 0; e < 8; ++e) hf[8 + e] = t8[e]; }
        float am = 0.f;
#pragma unroll
        for (int e = 0; e < 16; ++e) am = fmaxf(am, fabsf(hf[e]));
        am = fmaxf(am, dpp_f<0xB1>(am)); am = fmaxf(am, dpp_f<0x4E>(am)); am = fmaxf(am, dpp_f<0x141>(am)); am = fmaxf(am, dpp_f<0x128>(am));
        const float sh = fmaxf(am, 1e-30f) * (1.f / 127.f), ish = 1.f / sh;
        int hq[4];
#pragma unroll
        for (int q = 0; q < 4; ++q) hq[q] = ((int)rintf(hf[4 * q] * ish) & 0xff) | (((int)rintf(hf[4 * q + 1] * ish) & 0xff) << 8) | (((int)rintf(hf[4 * q + 2] * ish) & 0xff) << 16) | ((int)rintf(hf[4 * q + 3] * ish) << 24);
        G_IDS((const unsigned short*)p.ids + (size_t)tok * 128 + 32 * j);
        int keep0 = 0, keep1 = 0;
        u32x4 RA[8], RB[8];
#define G_COMP1(R, bb) do { _Pragma("unroll") for (int i = 0; i < 8; ++i) { int d_ = __builtin_amdgcn_sdot4((int)R[i][0], hq[0], 0, false);              \
                d_ = __builtin_amdgcn_sdot4((int)R[i][1], hq[1], d_, false); d_ = __builtin_amdgcn_sdot4((int)R[i][2], hq[2], d_, false); d_ = __builtin_amdgcn_sdot4((int)R[i][3], hq[3], d_, false); \
                d_ += dpp_i<0xB1>(d_); d_ += dpp_i<0x4E>(d_); d_ += dpp_i<0x141>(d_); d_ += dpp_i<0x128>(d_);                                        \
                const int q_ = 8 * (bb) + i;                                                                                                      \
                if ((q_ & 1) == 0) keep0 = (c == (q_ >> 1)) ? d_ : keep0; else keep1 = (c == (q_ >> 1)) ? d_ : keep1; } } while (0)
        G_LOADB(RA, Ub, 0); G_LOADB(RB, Ub, 1); G_COMP1(RA, 0); G_LOADB(RA, Ub, 2); G_COMP1(RB, 1); G_LOADB(RB, Ub, 3); G_COMP1(RA, 2); G_COMP1(RB, 3);
#undef G_COMP1
        *(unsigned*)(ap + (size_t)tok * 128 + 32 * j + 2 * c) = cvtpk((float)keep0 * sh, (float)keep1 * sh);
    }
}
__device__ __forceinline__ void phase_peer_coef(int wv, const Params& p, int l) {
    const int tid = ltid(wv), lane = tid & 63;
    const int bid_ = lbid(), ngrid_ = lgrid();
    const float* su = p.su + (size_t)l * 16384; const float* sv = p.sv + (size_t)l * 16384;
    for (int t0 = (bid_ * NWAVE + wv) * 4; t0 < TT; t0 += ngrid_ * NWAVE * 4) {
        unsigned idw[4]; float w0[4], w1[4], a0[4], a1[4];
#pragma unroll
        for (int i = 0; i < 4; ++i) { const size_t tk = (size_t)(t0 + i) * 128 + 2 * lane; idw[i] = *(const unsigned*)((const unsigned short*)p.ids + tk); const float2 ww = *(const float2*)(p.wts + tk); w0[i] = ww.x; w1[i] = ww.y; a0[i] = 0.f; a1[i] = 0.f; }
#pragma unroll
        for (int rr = 0; rr < 8; ++rr)
#pragma unroll
            for (int i = 0; i < 4; ++i) { const unsigned qq = *(const unsigned*)((const bf16_t*)p.apart + ((size_t)rr * TT + t0 + i) * 128 + 2 * lane); a0[i] += __uint_as_float(qq << 16); a1[i] += __uint_as_float(qq & 0xffff0000u); }
        float u0[4], u1[4], v0[4], v1[4];
#pragma unroll
        for (int i = 0; i < 4; ++i) { const unsigned e0 = idw[i] & 0xffffu, e1 = idw[i] >> 16; u0[i] = su[e0]; u1[i] = su[e1]; v0[i] = sv[e0]; v1[i] = sv[e1]; }
#pragma unroll
        for (int i = 0; i < 4; ++i) { const int tok = t0 + i;
            const float c0 = w0[i] * gelu_tanh(a0[i] * u0[i]) * v0[i], c1 = w1[i] * gelu_tanh(a1[i] * u1[i]) * v1[i];
            float cm = fmaxf(fabsf(c0), fabsf(c1));
            cm = fmaxf(cm, dpp_f<0xB1>(cm)); cm = fmaxf(cm, dpp_f<0x4E>(cm)); cm = fmaxf(cm, dpp_f<0x141>(cm)); cm = fmaxf(cm, dpp_f<0x128>(cm));
            cm = fmaxf(fmaxf(rdlane(cm, 0), rdlane(cm, 16)), fmaxf(rdlane(cm, 32), rdlane(cm, 48)));
            const float sc = fmaxf(cm, 1e-30f) * (1.f / 127.f), isc = 1.f / sc;
            *(unsigned short*)(p.cqbuf + (size_t)tok * 128 + 2 * lane) = (unsigned short)(((int)rintf(c0 * isc) & 0xff) | (((int)rintf(c1 * isc) & 0xff) << 8));
            if (lane == 0) p.scbuf[tok] = sc; }
    }
}
__device__ __forceinline__ void phase_peer_gather2(int wv, const Params& p, int l, const float* gate  ) {
    const int tid = ltid(wv), lane = tid & 63, j = lane >> 4, c = lane & 15;
    const int bid_ = lbid(), ngrid_ = lgrid();
    const int r = bid_ & 7, m = bid_ >> 3, nm = (ngrid_ - r + 7) >> 3;
    const unsigned char* Vb = p.V8 + (size_t)l * 16384 * DM + 256 * r; const unsigned lo = 16u * (unsigned)c;
    for (int tok = m * NWAVE + wv; tok < TT; tok += nm * NWAVE) {
        const float sc = p.scbuf[tok];
        bf16_t* xp = p.xbuf + (size_t)tok * DM + 256 * r + 16 * c; const float* gp = gate + (size_t)(tok >> 12) * 12288 + 256 * r + 16 * c;
        f32x4 ga[4] = {}; u32x4 xw0 = (u32x4){0u, 0u, 0u, 0u}, xw1 = (u32x4){0u, 0u, 0u, 0u};
        if (j == 0) { xw0 = *(const u32x4*)xp; xw1 = *(const u32x4*)(xp + 8);
#pragma unroll
            for (int q = 0; q < 4; ++q) ga[q] = *(const f32x4*)(gp + 4 * q); }
        G_IDS((const unsigned short*)p.ids + (size_t)tok * 128 + 32 * j);
        int4 cqv = make_int4(0, 0, 0, 0); if (c < 2) cqv = *(const int4*)(p.cqbuf + (size_t)tok * 128 + 32 * j + 16 * c);
        const int cqw[8] = {dpp_i<0x150>(cqv.x), dpp_i<0x150>(cqv.y), dpp_i<0x150>(cqv.z), dpp_i<0x150>(cqv.w), dpp_i<0x151>(cqv.x), dpp_i<0x151>(cqv.y), dpp_i<0x151>(cqv.z), dpp_i<0x151>(cqv.w)};
        int yi[16];
#pragma unroll
        for (int e = 0; e < 16; ++e) yi[e] = 0;
        u32x4 RA[8], RB[8];
#define G_COMP2(R, bb) do { _Pragma("unroll") for (int g = 0; g < 2; ++g) { const int cq_ = cqw[2 * (bb) + g];                                            \
                _Pragma("unroll") for (int d = 0; d < 4; ++d) { const unsigned W0 = R[4 * g][d], W1 = R[4 * g + 1][d], W2 = R[4 * g + 2][d], W3 = R[4 * g + 3][d];       \
                    const unsigned A_ = __builtin_amdgcn_perm(W1, W0, 0x05010400u), B_ = __builtin_amdgcn_perm(W1, W0, 0x07030602u);                  \
                    const unsigned C_ = __builtin_amdgcn_perm(W3, W2, 0x05010400u), D_ = __builtin_amdgcn_perm(W3, W2, 0x07030602u);                  \
                    yi[4 * d + 0] = __builtin_amdgcn_sdot4((int)__builtin_amdgcn_perm(C_, A_, 0x05040100u), cq_, yi[4 * d + 0], false);                 \
                    yi[4 * d + 1] = __builtin_amdgcn_sdot4((int)__builtin_amdgcn_perm(C_, A_, 0x07060302u), cq_, yi[4 * d + 1], false);                 \
                    yi[4 * d + 2] = __builtin_amdgcn_sdot4((int)__builtin_amdgcn_perm(D_, B_, 0x05040100u), cq_, yi[4 * d + 2], false);                 \
                    yi[4 * d + 3] = __builtin_amdgcn_sdot4((int)__builtin_amdgcn_perm(D_, B_, 0x07060302u), cq_, yi[4 * d + 3], false); } } } while (0)
        G_LOADB(RA, Vb, 0); G_LOADB(RB, Vb, 1); G_COMP2(RA, 0); G_LOADB(RA, Vb, 2); G_COMP2(RB, 1); G_LOADB(RB, Vb, 3); G_COMP2(RA, 2); G_COMP2(RB, 3);
#undef G_COMP2
        float y[16];
#pragma unroll
        for (int e = 0; e < 16; ++e) { int v = yi[e]; v += __builtin_amdgcn_ds_bpermute((lane ^ 16) << 2, v); v += __builtin_amdgcn_ds_bpermute((lane ^ 32) << 2, v); y[e] = (float)v * sc; }
        if (j == 0) { float x0[8], x1[8]; unpack8(xw0, x0); unpack8(xw1, x1);
#pragma unroll
            for (int e = 0; e < 8; ++e) { x0[e] += ga[e >> 2][e & 3] * y[e]; x1[e] += ga[2 + (e >> 2)][e & 3] * y[8 + e]; }
            *(u32x4*)xp = pack8f(x0); *(u32x4*)(xp + 8) = pack8f(x1); }
    }
}
#undef G_LOADB
#undef G_IDS

__device__ __forceinline__ void phase_fl(int wv, const Params& p, unsigned char* lds) {
    const int tid = ltid(wv); float* gls = (float*)lds;
    const int bid_ = lbid(), ngrid_ = lgrid();
    for (int u = bid_; u < 256; u += ngrid_) {
        mini16(wv, p.hk + (size_t)u * 64 * DM, p.W16_kv, gls);
        __syncthreads();
#pragma unroll
        for (int i = 0; i < 2; ++i) { const int o = tid + NTHR * i; p.fl[(size_t)u * 1024 + o] = gls[o] + gls[1024 + o]; }
        __syncthreads();
    }
}
__device__ __forceinline__ void phase_fscan(int wv, const Params& p, unsigned char* lds) {
    const int tid = ltid(wv), lane = tid & 63;
    const int bid_ = lbid(), ngrid_ = lgrid();
    float* red = (float*)lds;
    for (int u = bid_; u < 64; u += ngrid_) {
        const int b = u >> 4, hd = u & 15; const float bf = p.fox_b_f[hd];
        const float* fp = p.fl + ((size_t)b * SEQ + 8 * tid) * 16 + hd;
        float x[8], v[8], tot = 0.f;
#pragma unroll
        for (int i = 0; i < 8; ++i) x[i] = fp[(size_t)i * 16];
#pragma unroll
        for (int i = 0; i < 8; ++i) { v[i] = log_sigmoidf(x[i] + bf); tot += v[i]; }
        float incl = tot;
#pragma unroll
        for (int d = 1; d < 64; d <<= 1) { const float n = shfl_idx(incl, (lane - d) & 63); if (lane >= d) incl += n; }
        __syncthreads();
        if (lane == 63) red[wv] = incl;
        __syncthreads();
        float run = incl - tot;
#pragma unroll
        for (int w = 0; w < NWAVE - 1; ++w) run += (w < wv) ? red[w] : 0.f;
        float o[8];
#pragma unroll
        for (int i = 0; i < 8; ++i) { run += v[i]; o[i] = run * (-11.313708498984761f); }
        float* op = p.Fa + (size_t)u * SEQ + 8 * tid;
        *(f32x4*)op = (f32x4){o[0], o[1], o[2], o[3]}; *(f32x4*)(op + 4) = (f32x4){o[4], o[5], o[6], o[7]};
    }
}
__device__ __forceinline__ float slab_max_norm2(int wv, const bf16_t* slab, float* red) {
    const int tid = ltid(wv), lane = tid & 63;
    const bf16_t* rp = slab + (size_t)(tid >> 4) * DM + (tid & 15) * 8;
    u32x4 w[8];
#pragma unroll
    for (int i = 0; i < 8; ++i) w[i] = *(const u32x4*)(rp + (size_t)i * 32 * DM);
    float m = 0.f;
#pragma unroll
    for (int i = 0; i < 8; ++i) { float v8[8]; unpack8(w[i], v8); float ss = 0.f;
#pragma unroll
        for (int e = 0; e < 8; ++e) ss = fmaf(v8[e], v8[e], ss);
        m = fmaxf(m, row16_sum(ss)); }
    m = fmaxf(fmaxf(rdlane(m, 0), rdlane(m, 16)), fmaxf(rdlane(m, 32), rdlane(m, 48)));
    __syncthreads();
    if (lane == 0) red[wv] = m;
    __syncthreads();
    float r = red[0];
#pragma unroll
    for (int w_ = 1; w_ < 8; ++w_) r = fmaxf(r, red[w_]);
    return r;
}
__device__ __forceinline__ void phase_knorm(int wv, const Params& p, unsigned char* lds) {
    const int tid = ltid(wv); const int bid_ = lbid(), ngrid_ = lgrid();
    for (int u = bid_; u < 1024; u += ngrid_) { const int bh = u >> 4, qb = u & 15;
        const float r = slab_max_norm2(wv, p.Kb + ((size_t)(bh >> 4) * SEQ + (size_t)qb * 256) * DM + (bh & 15) * 128, (float*)lds);
        if (tid == 0) p.kn2[u] = r; }
}
__device__ __forceinline__ void phase_qn(int wv, const Params& p, unsigned char* lds) {
    const int tid = ltid(wv), lane = tid & 63; const int bid_ = lbid(), ngrid_ = lgrid();
    for (int u = bid_; u < 1024; u += ngrid_) { const int bh = u >> 4, qb = u & 15, P0 = qb * 256;
        const float qn2 = slab_max_norm2(wv, p.qb + ((size_t)(bh >> 4) * SEQ + (size_t)P0) * DM + (bh & 15) * 128, (float*)lds);
        if (wv == 0) {
            float k2 = (lane <= qb) ? p.kn2[bh * 16 + lane] : 0.f;
            k2 = fmaxf(k2, dpp_f<0xB1>(k2)); k2 = fmaxf(k2, dpp_f<0x4E>(k2)); k2 = fmaxf(k2, dpp_f<0x141>(k2)); k2 = fmaxf(k2, dpp_f<0x128>(k2));
            k2 = rdlane(k2, 0);
            const float D = 2.02f * sqrtf(qn2 * k2) + 30.f * 11.313708498984761f;
            const float* Fb = p.Fa + (size_t)bh * SEQ; const float ref = Fb[P0] - D;
            const int e = 64 * lane + 63; const bool skip = (e < P0) && (Fb[e] < ref);
            const unsigned long long bal = __ballot(skip);
            const int j = (int)__builtin_ctzll(~bal);
            if (lane == 0) p.jlo[u] = j; }
    }
}
__device__ __forceinline__ void phase_fox_gate(int wv, const Params& p) {
    const int tid = ltid(wv); const int bid_ = lbid(), ngrid_ = lgrid();
    const size_t stride = (size_t)ngrid_ * NTHR * 8;
    for (size_t e0 = ((size_t)bid_ * NTHR + tid) * 8; e0 < (size_t)TT * DM; e0 += 4 * stride) {
        u32x4 ow[4], gw[4];
#pragma unroll
        for (int i = 0; i < 4; ++i) { const size_t e = e0 + i * stride; ow[i] = *(const u32x4*)(p.ob + e); gw[i] = *(const u32x4*)(p.gb + e); }
#pragma unroll
        for (int i = 0; i < 4; ++i) { float o8[8], g8[8], y[8]; unpack8(ow[i], o8); unpack8(gw[i], g8);
#pragma unroll
            for (int j = 0; j < 8; ++j) y[j] = o8[j] * sigmoidf_(g8[j]);
            *(u32x4*)(p.og + e0 + i * stride) = pack8f(y); }
    }
}

namespace fa {
constexpr int D = 128, RS = 2048;
constexpr float SCALE = 0.08838834764831845f, THR = 16.f;
constexpr int NW = 8, QBLK = 32, KVBLK = 64, QB = NW * QBLK;
constexpr int SHM_V = KVBLK * D * 2, SHM_K = KVBLK * D * 2, SHM_A = KVBLK * 4;
constexpr int OFF_K = 2 * SHM_V, OFF_WS = 2 * SHM_V + 2 * SHM_K, OFF_A = OFF_WS + NW * 64 * 4, LDS_BYTES = OFF_A + 2 * SHM_A;
#define KSWZ(row, colB) ((row) * 256 + ((colB) ^ (((row) & 7) << 4)))
#define SBAR() __builtin_amdgcn_sched_barrier(0)
__device__ __forceinline__ int v_st(int k, int c) { const int kk = (k & ~0xC) | ((k & 4) << 1) | ((k & 8) >> 1); return ((kk >> 3) * 4 + (c >> 5)) * 512 + ((kk & 7) * 32 + (c & 31)) * 2; }
__device__ __forceinline__ int v_rd_base(int lane) { return ((lane & 3) << 3) | (((lane >> 2) & 3) << 6) | (((lane >> 4) & 1) << 5) | (((lane >> 5) & 1) << 8); }
constexpr int v_rd_off(int d0, int ks, int half) { return d0 * 512 + ks * 4096 + half * 2048; }
__device__ __forceinline__ int crow(int r, int hi) { return (r & 3) + 8 * (r >> 2) + 4 * hi; }
__device__ __forceinline__ unsigned cvtpkv(float lo, float hi) { unsigned r; asm volatile("v_cvt_pk_bf16_f32 %0, %1, %2" : "=v"(r) : "v"(lo), "v"(hi)); return r; }
__device__ __forceinline__ bf16x8 load8(const bf16_t* p) { return *reinterpret_cast<const bf16x8*>(p); }
__device__ __forceinline__ void mask_tile(f32x16& p0, f32x16& p1, int dq) {
    const float NEG = -__builtin_inff();
#pragma unroll
    for (int r = 0; r < 16; ++r) { const int c = (r & 3) + 8 * (r >> 2); if (dq - c < 0) p0[r] = NEG; if (dq - c - 32 < 0) p1[r] = NEG; }
}
__device__ __forceinline__ void partialSM(f32x16& p0, f32x16& p1, float& m_reg, float& mn, float& alpha) {
    float pmax = p0[0]; for (int r = 1; r < 16; ++r) pmax = fmaxf(pmax, p0[r]); for (int r = 0; r < 16; ++r) pmax = fmaxf(pmax, p1[r]);
    { auto rr = __builtin_amdgcn_permlane32_swap(__float_as_uint(pmax), __float_as_uint(pmax), false, false);
      pmax = fmaxf(__uint_as_float(rr[0]), __uint_as_float(rr[1])); }
    constexpr float C2 = 1.4426950408889634f * SCALE;
    if (__builtin_expect(__all((pmax - m_reg) * SCALE <= THR), 1)) { mn = m_reg; alpha = 1.f; }
    else { mn = fmaxf(m_reg, pmax); alpha = __builtin_amdgcn_exp2f((m_reg - mn) * C2); m_reg = mn; }
    const float mnL = -mn * C2;
    for (int r = 0; r < 16; ++r) p0[r] = fmaf(p0[r], C2, mnL); for (int r = 0; r < 16; ++r) p1[r] = fmaf(p1[r], C2, mnL);
    for (int r = 0; r < 16; ++r) p0[r] = __builtin_amdgcn_exp2f(p0[r]);
}
__device__ __forceinline__ void finishSM(f32x16& p0, f32x16& p1, float alpha, float& l_reg, bf16x8& pa0, bf16x8& pa1, bf16x8& pa2, bf16x8& pa3) {
    for (int r = 0; r < 16; ++r) p1[r] = __builtin_amdgcn_exp2f(p1[r]);
    float ps = 0; for (int r = 0; r < 16; ++r) ps += p0[r]; for (int r = 0; r < 16; ++r) ps += p1[r];
    { auto rr = __builtin_amdgcn_permlane32_swap(__float_as_uint(ps), __float_as_uint(ps), false, false);
      ps = __uint_as_float(rr[0]) + __uint_as_float(rr[1]); }
    l_reg = l_reg * alpha + ps;
#define PK4(P, B_, OUT) do { unsigned a0 = cvtpkv(P[B_+0], P[B_+1]), a1 = cvtpkv(P[B_+2], P[B_+3]);                          \
        unsigned b0 = cvtpkv(P[B_+4], P[B_+5]), b1 = cvtpkv(P[B_+6], P[B_+7]);                                             \
        auto r0 = __builtin_amdgcn_permlane32_swap(a0, b0, false, false); auto r1 = __builtin_amdgcn_permlane32_swap(a1, b1, false, false); \
        u32x4 w = {r0[0], r1[0], r0[1], r1[1]}; OUT = *reinterpret_cast<bf16x8*>(&w); } while (0)
    PK4(p0, 0, pa0); PK4(p0, 8, pa1); PK4(p1, 0, pa2); PK4(p1, 8, pa3);
#undef PK4
}
template <int KB>
__device__ __forceinline__ void qkt(f32x16& p0, f32x16& p1, const char* K_lds, int r32, int hi, const bf16x8* qr) {
    p0 = f32x16{}; p1 = f32x16{};
    const char* kb[4];
#pragma unroll
    for (int dd = 0; dd < 4; ++dd) kb[dd] = K_lds + KB * SHM_K + KSWZ(r32, (dd * 16 + hi * 8) * 2);
#pragma unroll
    for (int d0 = 0; d0 < 8; ++d0) { const char* a = kb[d0 & 3] + (d0 >> 2) * 128;
        bf16x8 b0 = *reinterpret_cast<const bf16x8*>(a);
        bf16x8 b1 = *reinterpret_cast<const bf16x8*>(a + 32 * 256);
        p0 = __builtin_amdgcn_mfma_f32_32x32x16_bf16(b0, qr[d0], p0, 0, 0, 0);
        p1 = __builtin_amdgcn_mfma_f32_32x32x16_bf16(b1, qr[d0], p1, 0, 0, 0); }
}
template <int VB>
__device__ __forceinline__ void pv_tile(f32x16* o, int vb0, bf16x8 pa0, bf16x8 pa1, bf16x8 pa2, bf16x8 pa3) {
#define TRRD(dst, off) asm volatile("ds_read_b64_tr_b16 %0, %1 offset:%2" : "=&v"(dst) : "v"(vb0), "i"(off) : "memory")
#define PV_D0(d0) do { constexpr int b_ = VB * SHM_V + v_rd_off(d0, 0, 0); \
        { s16x4 l0, l1, h0, h1; TRRD(l0, b_); TRRD(h0, b_ + 2048); TRRD(l1, b_ + 4096); TRRD(h1, b_ + 6144); \
          asm volatile("s_waitcnt lgkmcnt(0)" ::: "memory"); SBAR();   \
          o[d0] = __builtin_amdgcn_mfma_f32_32x32x16_bf16(pa0, (bf16x8){l0[0], l0[1], l0[2], l0[3], h0[0], h0[1], h0[2], h0[3]}, o[d0], 0, 0, 0);   \
          o[d0] = __builtin_amdgcn_mfma_f32_32x32x16_bf16(pa1, (bf16x8){l1[0], l1[1], l1[2], l1[3], h1[0], h1[1], h1[2], h1[3]}, o[d0], 0, 0, 0); } \
        { s16x4 l2, l3, h2, h3; TRRD(l2, b_ + 8192); TRRD(h2, b_ + 10240); TRRD(l3, b_ + 12288); TRRD(h3, b_ + 14336); \
          asm volatile("s_waitcnt lgkmcnt(0)" ::: "memory"); SBAR();   \
          o[d0] = __builtin_amdgcn_mfma_f32_32x32x16_bf16(pa2, (bf16x8){l2[0], l2[1], l2[2], l2[3], h2[0], h2[1], h2[2], h2[3]}, o[d0], 0, 0, 0);   \
          o[d0] = __builtin_amdgcn_mfma_f32_32x32x16_bf16(pa3, (bf16x8){l3[0], l3[1], l3[2], l3[3], h3[0], h3[1], h3[2], h3[3]}, o[d0], 0, 0, 0); } } while (0)
    PV_D0(0); PV_D0(1); PV_D0(2); PV_D0(3);
#undef PV_D0
#undef TRRD
}
struct Ptrs { const bf16_t* qb; const bf16_t* Kb; const bf16_t* Vb; const float* Fa; bf16_t* ob; const bf16_t* gb; };
struct BlockRef { unsigned qo, ko, fo; int P0; };
struct Seam { bf16x8 qr[8]; bf16x8 st_v0, st_v1, st_k0, st_k1; };
#define VMW() asm volatile("s_waitcnt vmcnt(0)" ::: "memory")
#define VMWN(n) asm volatile("s_waitcnt vmcnt(%0)" :: "i"(n) : "memory")
#define SLOAD_H(Kp, Vp, k0) do { const bf16_t* kt_ = (Kp) + (size_t)(k0) * RS; const bf16_t* vt_ = (Vp) + (size_t)(k0) * RS;                       \
        S.st_v0 = load8(vt_ + svo); S.st_v1 = load8(vt_ + 32 * RS + svo); S.st_k0 = load8(kt_ + svo); S.st_k1 = load8(kt_ + 32 * RS + svo); } while (0)
#define ALOAD(Fp, k0, bf) do { if (wid == 0) __builtin_amdgcn_global_load_lds((const unsigned*)((Fp) + (size_t)((k0) + lane)), (LAS unsigned*)(ldsl + OFF_A + (bf) * SHM_A), 4, 0, 0); } while (0)
#define SWRITE_HK(bf) do { *(bf16x8*)(K_lds + (bf) * SHM_K + kws) = S.st_k0; *(bf16x8*)(K_lds + (bf) * SHM_K + kws + 32 * 256) = S.st_k1; } while (0)
#define SWRITE_HV(bf) do { *(bf16x8*)(V_lds + (bf) * SHM_V + vst0) = S.st_v0; *(bf16x8*)(V_lds + (bf) * SHM_V + vst1) = S.st_v1; } while (0)
#define SWRITE_H(bf) do { SWRITE_HV(bf); SWRITE_HK(bf); } while (0)
__device__ __forceinline__ void attn_prime(int wv, const Ptrs& P, const BlockRef& cur, char* lds, LAS unsigned char* ldsl, Seam& S) {
    const int tid = ltid(wv), wid = wv, lane = tid & 63, r32 = lane & 31, hi = lane >> 5;
    const int bid_ = lbid(), ngrid_ = lgrid();
    const int sr = tid >> 4, sc = (tid & 15) * 8, kws = KSWZ(sr, sc * 2); char* K_lds = lds + OFF_K;
    const unsigned svo = (unsigned)(sr * RS + sc), qvo = (unsigned)(r32 * RS + hi * 8);
    { const bf16_t* qw = P.qb + cur.qo + (size_t)(wid * QBLK) * RS;
      for (int d0 = 0; d0 < 8; ++d0) S.qr[d0] = load8(qw + qvo + d0 * 16); }
    SLOAD_H(P.Kb + cur.ko, P.Vb + cur.ko, 0); ALOAD(P.Fa + cur.fo, 0, 0); VMW(); SWRITE_HK(0);
    __syncthreads();
}
__device__ __forceinline__ void attn_block(int wv, const Ptrs& P, const BlockRef& cur, const BlockRef& nxt, char* lds, LAS unsigned char* ldsl, Seam& S) {
    const int tid = ltid(wv), wid = wv, lane = tid & 63, r32 = lane & 31, hi = lane >> 5;
    const int bid_ = lbid(), ngrid_ = lgrid();
    const int NT = (cur.P0 + QB - 1) / KVBLK + 1;
    const int qlo = cur.P0 + wid * QBLK, qm = qlo + r32 - 4 * hi;
    char* V_lds = lds; char* K_lds = lds + OFF_K; const char* A_lds = lds + OFF_A;
    float* ws = (float*)(lds + OFF_WS) + wid * 64; float* li_l = ws, * al_l = ws + 32;
    float m_reg = -1e30f, l_reg = 0; f32x16 o[4] = {};
    const int sr = tid >> 4, sc = (tid & 15) * 8, vst0 = v_st(sr, sc), vst1 = v_st(32 + sr, sc), kws = KSWZ(sr, sc * 2);
    const unsigned svo = (unsigned)(sr * RS + sc), qvo = (unsigned)(r32 * RS + hi * 8);
    const int vb0 = (int)(uintptr_t)V_lds + v_rd_base(lane);
    const bf16_t* Kh = P.Kb + cur.ko; const bf16_t* Vh = P.Vb + cur.ko; const float* Fh = P.Fa + cur.fo;
#define RESC(a) do { if (__any((a) < 1.f)) { if (hi == 0) al_l[r32] = (a); asm volatile("s_waitcnt lgkmcnt(0)" ::: "memory");              \
                     for (int d_ = 0; d_ < 4; ++d_) for (int r = 0; r < 16; ++r) o[d_][r] *= al_l[crow(r, hi)]; } } while (0)
#define KBASE(t) ((t) * KVBLK)
#define ADDB(P0_, P1_, KB) do { const float* bp_ = (const float*)(A_lds + (KB) * SHM_A) + 4 * hi;                                      \
        _Pragma("unroll") for (int q_ = 0; q_ < 4; ++q_) { const f32x4 b0_ = *(const f32x4*)(bp_ + 8 * q_), b1_ = *(const f32x4*)(bp_ + 32 + 8 * q_); \
            _Pragma("unroll") for (int e_ = 0; e_ < 4; ++e_) { P0_[4 * q_ + e_] += b0_[e_]; P1_[4 * q_ + e_] += b1_[e_]; } } } while (0)
#define MASKT(P0_, P1_, t) do { const int kb_ = KBASE(t); if (kb_ + KVBLK - 1 > qlo) mask_tile(P0_, P1_, qm - kb_); } while (0)
    constexpr int NQL = 8;
#define SEAM_K0() do { VMWN(NQL); SWRITE_HK(0); SBAR(); } while (0)
    f32x16 pA0, pA1, pB0, pB1; float mnA, mnB, alA, alB; bf16x8 pa0, pa1, pa2, pa3;
    SWRITE_HV(0); SBAR();
    SLOAD_H(Kh, Vh, KBASE(1)); ALOAD(Fh, KBASE(1), 1);
    SBAR(); qkt<0>(pA0, pA1, K_lds, r32, hi, S.qr);
    ADDB(pA0, pA1, 0); MASKT(pA0, pA1, 0); partialSM(pA0, pA1, m_reg, mnA, alA);
    VMW(); SWRITE_H(1);
    __syncthreads();
#define HALF_STEP(PX0, PX1, mnX, alX, PY0, PY1, alY, t, KB, VB, SB) do {                                                      \
        SBAR(); qkt<KB>(PX0, PX1, K_lds, r32, hi, S.qr);                                                         \
        finishSM(PY0, PY1, alY, l_reg, pa0, pa1, pa2, pa3); SBAR();                                                           \
        if ((t) + 1 < NT) { SLOAD_H(Kh, Vh, KBASE((t) + 1)); ALOAD(Fh, KBASE((t) + 1), SB); SBAR(); }                         \
        pv_tile<VB>(o, vb0, pa0, pa1, pa2, pa3); ADDB(PX0, PX1, KB); MASKT(PX0, PX1, (t)); partialSM(PX0, PX1, m_reg, mnX, alX);                  \
        __syncthreads();                                                                                                      \
        if ((t) + 1 < NT) { VMW(); SWRITE_H(SB); }                                                                            \
        RESC(alX); __syncthreads(); } while (0)
    for (int t = 1; t + 1 < NT; t += 2) {
        HALF_STEP(pB0, pB1, mnB, alB, pA0, pA1, alA, t, 1, 0, 0);
        HALF_STEP(pA0, pA1, mnA, alA, pB0, pB1, alB, t + 1, 0, 1, 1);
    }
    const bool even = (NT & 1) == 0;
    if (even) { SBAR(); qkt<1>(pB0, pB1, K_lds, r32, hi, S.qr); SBAR(); }
    SLOAD_H(P.Kb + nxt.ko, P.Vb + nxt.ko, 0); ALOAD(P.Fa + nxt.fo, 0, 0); SBAR();
    { const bf16_t* qw = P.qb + nxt.qo + (size_t)(wid * QBLK) * RS;
#pragma unroll
      for (int d0 = 0; d0 < 8; ++d0) S.qr[d0] = load8(qw + qvo + d0 * 16); }
    SBAR();
    finishSM(pA0, pA1, alA, l_reg, pa0, pa1, pa2, pa3); SBAR();
    pv_tile<0>(o, vb0, pa0, pa1, pa2, pa3);
    if (even) { ADDB(pB0, pB1, 1); MASKT(pB0, pB1, NT - 1); partialSM(pB0, pB1, m_reg, mnB, alB); __syncthreads(); RESC(alB);
        finishSM(pB0, pB1, alB, l_reg, pa0, pa1, pa2, pa3); SBAR(); pv_tile<1>(o, vb0, pa0, pa1, pa2, pa3); }
    SBAR(); SEAM_K0();
    if (hi == 0) li_l[r32] = l_reg; asm volatile("s_waitcnt lgkmcnt(0)" ::: "memory");
    float rli[16];
#pragma unroll
    for (int r = 0; r < 16; ++r) rli[r] = __builtin_amdgcn_rcpf(li_l[crow(r, hi)]);
    bf16_t* Ow = P.ob + cur.qo + (size_t)(wid * QBLK) * RS;
    const bf16_t* Gw = P.gb + cur.qo + (size_t)(wid * QBLK) * RS;
    const unsigned ovo = (unsigned)(4 * hi * RS + r32);
    unsigned short gq[16][4];
#pragma unroll
    for (int r = 0; r < 16; ++r) { const bf16_t* growp = Gw + (size_t)((r & 3) + 8 * (r >> 2)) * RS;
#pragma unroll
        for (int d0 = 0; d0 < 4; ++d0) gq[r][d0] = growp[ovo + d0 * 32]; }
#pragma unroll
    for (int r = 0; r < 16; ++r) { bf16_t* rowp = Ow + (size_t)((r & 3) + 8 * (r >> 2)) * RS;
#pragma unroll
        for (int d0 = 0; d0 < 4; ++d0) { const float gl_ = __uint_as_float((unsigned)gq[r][d0] << 16);
            const float v = o[d0][r] * rli[r] * __builtin_amdgcn_rcpf(1.f + __expf(-gl_)); const float vn = shfl_idx(v, lane ^ 1);
            if ((r32 & 1) == 0) *(unsigned*)(rowp + ovo + d0 * 32) = cvtpkv(v, vn); } }
    __syncthreads();
#undef RESC
#undef ADDB
#undef KBASE
#undef MASKT
#undef SEAM_K0
#undef HALF_STEP
}
#undef VMW
#undef VMWN
#undef SLOAD_H
#undef ALOAD
#undef SWRITE_HK
#undef SWRITE_HV
#undef SWRITE_H
__device__ __forceinline__ BlockRef make_ref(const int* jlo, int bh, int qb) {
    const int b = bh >> 4, hd = bh & 15; BlockRef r; const int j0 = jlo[bh * 16 + qb] * KVBLK;
    r.qo = (unsigned)((b * SEQ + qb * QB) * RS + hd * D); r.ko = (unsigned)((b * SEQ + j0) * RS + hd * D); r.fo = (unsigned)(bh * SEQ + j0); r.P0 = qb * QB - j0; return r;
}
__device__ __forceinline__ void attn_phase(int wv, LAS unsigned char* ldsl, const bf16_t* qb_, const bf16_t* Kb_, const bf16_t* Vb_, const float* Fa_, bf16_t* ob_, const bf16_t* gb_, const int* jlo, unsigned* qctr) {
    char* lds = (char*)ldsl; const Ptrs p{qb_, Kb_, Vb_, Fa_, ob_, gb_};
    volatile int* s_next = (volatile int*)(lds + LDS_BYTES);
    const int tid = ltid(wv);
    if (tid == 0) *s_next = (int)__hip_atomic_fetch_add(qctr, 1u, __ATOMIC_RELAXED, __HIP_MEMORY_SCOPE_AGENT);
    __syncthreads();
    int L = __builtin_amdgcn_readfirstlane(*s_next);
    if (L >= 1024) return;
    BlockRef cur = make_ref(jlo, L & 63, 15 - (L >> 6));
    Seam S;
    attn_prime(wv, p, cur, lds, ldsl, S);
    for (;;) {
        if (tid == 0) *s_next = (int)__hip_atomic_fetch_add(qctr, 1u, __ATOMIC_RELAXED, __HIP_MEMORY_SCOPE_AGENT);
        __syncthreads();
        const int Ln = __builtin_amdgcn_readfirstlane(*s_next); const bool last = Ln >= 1024;
        const BlockRef nxt = last ? cur : make_ref(jlo, Ln & 63, 15 - (Ln >> 6));
        attn_block(wv, p, cur, nxt, lds, ldsl, S);
        if (last) break;
        cur = nxt;
    }
}
}

constexpr int NSTEPS = 49;
__device__ __forceinline__ void gemm_bf16_nl(int wv, LAS unsigned char* smem, const bf16_t* A, const bf16_t* Bt, int N, bf16_t* O, int ldc, int split_cols, size_t split_stride) {
    pg8::Gemm g{A, Bt, TT, N, DM}; pg8::StaticOrder S; S.init(TT, N, lgrid(), lbid());
    pg8::EpiBf16<0> E{O, ldc, nullptr, split_cols, split_stride};
    pg8::gemm_phase<pg8::EpiBf16<0>, pg8::StaticOrder, false>(wv, smem, g, S, E, nullptr);
}
__device__ __forceinline__ void gemm_resid_nl(int wv, LAS unsigned char* smem, const bf16_t* A, const bf16_t* Bt, const void* xold, int xold_f32, bf16_t* xnew, const float* gate) {
    pg8::Gemm g{A, Bt, TT, DM, DM}; pg8::StaticOrder S; S.init(TT, DM, lgrid(), lbid());
    pg8::EpiResid E{xold, xold_f32, xnew, gate, 12288};
    pg8::gemm_phase<pg8::EpiResid, pg8::StaticOrder, false>(wv, smem, g, S, E, nullptr);
}
template <unsigned PHASE_MASK>
__global__ void __launch_bounds__(NTHR, 2) trunk_kernel(Params p_unused, int lo, int hi) {
    extern __shared__ __attribute__((aligned(16))) unsigned char smem[];
    LAS unsigned char* sl = (LAS unsigned char*)smem;
    const int wv0 = __builtin_amdgcn_readfirstlane((int)threadIdx.x >> 6);
    typedef const __attribute__((address_space(4))) Params* KP;
    KP kp0 = (KP)__builtin_amdgcn_kernarg_segment_ptr();
    XcdBarrier bar; bar.bar = kp0->bar; bar.x = 0; bar.st = nullptr; bar.wv = wv0;
    if (hi - lo > 1) {
        LAS unsigned* stw = (LAS unsigned*)(smem + LDS_BYTES - 16);
        if (xb_thread0(wv0)) { stw[0] = 0u; stw[1] = 0u; stw[2] = 0u; stw[3] = 0u; }
        __syncthreads();
        bar = xcd_barrier_post(kp0->bar, (volatile LAS unsigned*)stw, wv0);
    }
    int step = 0;
#define EN(k) (((PHASE_MASK) >> (k)) & 1u)
#ifndef DUP_MASK
#define DUP_MASK 0u
#endif
#define DUP(k) (((DUP_MASK) >> (k)) & 1u)
#define RUN(kind, ...) do { KP kq = kp0; asm volatile("" : "+s"(kq)); const int lo_ = ((const __attribute__((address_space(4))) int*)kq)[sizeof(Params) / 4], hi_ = ((const __attribute__((address_space(4))) int*)kq)[sizeof(Params) / 4 + 1]; \
        if (step >= lo_ && step < hi_) { if constexpr (EN(kind)) { const Params& p = *(const Params*)kq; int wv = wv0; asm volatile("" : "+s"(wv)); __VA_ARGS__; if constexpr (DUP(kind)) { xcd_barrier(bar); __VA_ARGS__; } } if (step + 1 < hi_) xcd_barrier(bar); } ++step; } while (0)
    RUN(0, phase_prologue(wv, p, smem, p.bar + 3712));
    RUN(1, (phase_norm<false, false, true>(wv, p.x, p.norm_mix, p.mod + 0, p.mod + 2048, 12288, p.h, nullptr, nullptr, nullptr, 0, nullptr, nullptr)));
    for (int l = 0; l < 2; ++l) {
        RUN(2, gemm_bf16_nl(wv, sl, p.h, p.Wt_in + (size_t)l * GLA_NM * DM, GLA_NM, p.proj, GLA_NM, 0, 0));
        RUN(3, {
#ifdef PREP_PROBE
            phase_gla_prep<PREP_PROBE>(wv, p, l, smem); xcd_barrier(bar);
#endif
            phase_gla_prep<0>(wv, p, l, smem); });
        RUN(4, {
#ifdef REC_PROBE
            phase_gla_rec<REC_PROBE>(wv, p, smem); xcd_barrier(bar);
#endif
            phase_gla_rec<0>(wv, p, smem); });
        RUN(5, phase_gla_onorm(wv, p, l));
        RUN(6, gemm_resid_nl(wv, sl, p.og, p.Wt_out + (size_t)l * DM * DM, l == 0 ? (const void*)p.x : (const void*)p.xbuf, l == 0 ? 1 : 0, p.xbuf, (p.mod + (size_t)l * NBATCH * 12288) + 4096));
        RUN(1, (phase_norm<false, false>(wv, p.xbuf, p.norm_ffn + l * DM, (p.mod + (size_t)l * NBATCH * 12288) + 6144, (p.mod + (size_t)l * NBATCH * 12288) + 8192, 12288, p.h2, nullptr, nullptr, nullptr, 0, nullptr, nullptr)));
        RUN(2, gemm_bf16_nl(wv, sl, p.h2, p.Wt_pq + (size_t)l * DM * DM, DM, p.pq, DM, 0, 0));
        RUN(7, phase_peer_topk(wv, p, l, smem));
        RUN(8, phase_peer_gather1(wv, p, l));
        RUN(13, phase_peer_coef(wv, p, l));
        RUN(14, phase_peer_gather2(wv, p, l, (p.mod + (size_t)l * NBATCH * 12288) + 10240));
        if (l == 0) RUN(1, (phase_norm<false, false>(wv, p.xbuf, p.norm_mix + DM, (p.mod + (size_t)l * NBATCH * 12288) + NBATCH * 12288, (p.mod + (size_t)l * NBATCH * 12288) + NBATCH * 12288 + 2048, 12288, p.h, nullptr, nullptr, nullptr, 0, nullptr, nullptr)));
        else RUN(1, (phase_norm<true, false>(wv, p.xbuf, p.kv_norm, p.kvmod, p.kvmod + 2048, 4096, p.hk, p.norm_mix + 2 * DM, (p.mod + (size_t)l * NBATCH * 12288) + NBATCH * 12288, (p.mod + (size_t)l * NBATCH * 12288) + NBATCH * 12288 + 2048, 12288, p.h, nullptr)));
    }
    RUN(2, { gemm_bf16_nl(wv, sl, p.hk, p.Wt_kv, KV_NM, p.Kb, DM, DM, (size_t)TT * DM); __syncthreads(); if constexpr (EN(9)) phase_fl(wv, p, smem); });
    for (int l = 2; l < 4; ++l) {
        RUN(2, { gemm_bf16_nl(wv, sl, p.h, p.Wt_q + (size_t)(l - 2) * 4096 * DM, 4096, p.qb, DM, DM, (size_t)TT * DM); if constexpr (EN(10)) { if (l == 2) { phase_fscan(wv, p, smem); phase_knorm(wv, p, smem); } } });
        RUN(15, phase_qn(wv, p, smem));
        RUN(11, fa::attn_phase(wv, sl, p.qb, p.Kb, p.Vb, p.Fa, p.og, p.gb, p.jlo, p.bar + 3584 + 64 * (l - 2)));
        RUN(6, gemm_resid_nl(wv, sl, p.og, p.Wt_fo + (size_t)(l - 2) * DM * DM, (const void*)p.xbuf, 0, p.xbuf, (p.mod + (size_t)l * NBATCH * 12288) + 4096));
        RUN(1, (phase_norm<false, false>(wv, p.xbuf, p.norm_ffn + l * DM, (p.mod + (size_t)l * NBATCH * 12288) + 6144, (p.mod + (size_t)l * NBATCH * 12288) + 8192, 12288, p.h2, nullptr, nullptr, nullptr, 0, nullptr, nullptr)));
        RUN(2, gemm_bf16_nl(wv, sl, p.h2, p.Wt_pq + (size_t)l * DM * DM, DM, p.pq, DM, 0, 0));
        RUN(7, phase_peer_topk(wv, p, l, smem));
        RUN(8, phase_peer_gather1(wv, p, l));
        RUN(13, phase_peer_coef(wv, p, l));
        RUN(14, phase_peer_gather2(wv, p, l, (p.mod + (size_t)l * NBATCH * 12288) + 10240));
        if (l == 2) RUN(1, (phase_norm<false, false>(wv, p.xbuf, p.norm_mix + 3 * DM, (p.mod + (size_t)l * NBATCH * 12288) + NBATCH * 12288, (p.mod + (size_t)l * NBATCH * 12288) + NBATCH * 12288 + 2048, 12288, p.h, nullptr, nullptr, nullptr, 0, nullptr, nullptr)));
        else RUN(1, (phase_norm<false, true>(wv, p.xbuf, p.final_norm, nullptr, nullptr, 0, nullptr, nullptr, nullptr, nullptr, 0, nullptr, p.out)));
    }
#undef RUN
}

extern "C" void kernel_launch(void* const* d_in, const int* in_sizes, int n_in, void* d_out, int out_size, void* d_ws, size_t ws_size, hipStream_t stream) {
    static int grid = 0;
    if (grid == 0) {
        int dev = 0, cus = 0;
        if (hipGetDevice(&dev) != hipSuccess || hipDeviceGetAttribute(&cus, hipDeviceAttributeMultiprocessorCount, dev) != hipSuccess || cus <= 0) cus = 256;
        const bool ok = hipFuncSetAttribute((const void*)trunk_kernel<0xffffffffu>, hipFuncAttributeMaxDynamicSharedMemorySize, LDS_BYTES) == hipSuccess;
        if (!ok) { fprintf(stderr, "kernel_launch: hipFuncSetAttribute failed\n"); grid = -1; return; }
        (void)hipGetLastError();
        grid = cus;
    }
    if (grid < 0 || n_in != 23) return;
    Params p{};
    const float* const* in = (const float* const*)d_in;
    p.x = in[0]; p.c = in[1]; p.ada_w = in[2]; p.ada_b = in[3]; p.norm_mix = in[4]; p.norm_ffn = in[5]; p.gla_w_in = in[6]; p.gla_wg2 = in[7]; p.gla_bg2 = in[8]; p.gla_norm = in[9];
    p.gla_w_out = in[10]; p.kv_norm = in[11]; p.kv_ada_w = in[12]; p.kv_ada_b = in[13]; p.fox_w_kv = in[14]; p.fox_b_f = in[15]; p.fox_w_q = in[16]; p.fox_w_out = in[17];
    p.peer_w_q = in[18]; p.peer_subk = in[19]; p.peer_u = in[20]; p.peer_v = in[21]; p.final_norm = in[22];
    p.out = (float*)d_out;
    unsigned char* ws = (unsigned char*)d_ws; size_t off = 0;
    auto take = [&](size_t bytes) { unsigned char* r = ws + off; off += (bytes + 255) & ~(size_t)255; return r; };
    p.bar = (unsigned*)take(16384);
    p.mod = (float*)take((size_t)4 * NBATCH * 12288 * 4); p.kvmod = (float*)take((size_t)NBATCH * 4096 * 4);
    p.Wt_in = (bf16_t*)take((size_t)2 * GLA_NM * DM * 2); p.W16_in = (bf16_t*)take((size_t)2 * 16 * DM * 2);
    p.Wt_out = (bf16_t*)take((size_t)2 * DM * DM * 2); p.Wt_kv = (bf16_t*)take((size_t)KV_NM * DM * 2); p.W16_kv = (bf16_t*)take((size_t)16 * DM * 2);
    p.Wt_q = (bf16_t*)take((size_t)2 * 4096 * DM * 2); p.Wt_fo = (bf16_t*)take((size_t)2 * DM * DM * 2); p.Wt_pq = (bf16_t*)take((size_t)4 * DM * DM * 2);
    p.subk = (bf16_t*)take((size_t)4 * 8 * 2 * 128 * 128 * 2);
    p.U8 = (unsigned char*)take((size_t)4 * 16384 * DM); p.V8 = (unsigned char*)take((size_t)4 * 16384 * DM); p.su = (float*)take((size_t)4 * 16384 * 4); p.sv = (float*)take((size_t)4 * 16384 * 4);
    p.xbuf = (bf16_t*)take((size_t)TT * DM * 2);
    p.h = (bf16_t*)take((size_t)TT * DM * 2); p.hk = (bf16_t*)take((size_t)TT * DM * 2); p.h2 = (bf16_t*)take((size_t)TT * DM * 2);
    p.og = (bf16_t*)take((size_t)TT * DM * 2); p.pq = (bf16_t*)take((size_t)TT * DM * 2);
    p.ids = (int*)take((size_t)TT * 128 * 4); p.wts = (float*)take((size_t)TT * 128 * 4); p.fl = (float*)take((size_t)TT * 16 * 4); p.apart = (float*)take((size_t)8 * TT * 128 * 4); p.cqbuf = (signed char*)take((size_t)TT * 128); p.scbuf = (float*)take((size_t)TT * 4); p.kn2 = (float*)take(1024 * 4); p.jlo = (int*)take(1024 * 4);
    const size_t region = off;
    p.proj = (bf16_t*)take((size_t)TT * GLA_NM * 2); p.qt = (bf16_t*)take((size_t)TT * 1024 * 2); p.khT = (bf16_t*)take((size_t)TT * 1024 * 2);
    p.vT = (bf16_t*)take((size_t)TT * DM * 2); p.Pm = (bf16_t*)take((size_t)TT * 4 * 64 * 2); p.dec = (float*)take((size_t)1024 * 256 * 4); p.o = (bf16_t*)take((size_t)TT * DM * 2);
    const size_t end_gla = off; off = region;
    p.qb = (bf16_t*)take((size_t)TT * DM * 2); p.gb = (bf16_t*)take((size_t)TT * DM * 2); p.Kb = (bf16_t*)take((size_t)TT * DM * 2); p.Vb = (bf16_t*)take((size_t)TT * DM * 2);
    p.ob = (bf16_t*)take((size_t)TT * DM * 2); p.Fa = (float*)take((size_t)64 * SEQ * 4);
    const size_t end_all = off > end_gla ? off : end_gla;
    if (end_all > ws_size) { fprintf(stderr, "kernel_launch: workspace too small: need %zu have %zu\n", end_all, ws_size); return; }
    { int first = 0, m = 0;
      auto add = [&](const float* src, bf16_t* dst, bf16_t* dst16, int N, int Nmain) { TMat& t = p.tm[m++]; t.src = src; t.dst = dst; t.dst16 = dst16; t.N = N; t.Nmain = Nmain; t.ntn = (N + 255) / 256; t.first = first; first += 32 * t.ntn; };
      for (int l = 0; l < 2; ++l) add(p.gla_w_in + (size_t)l * DM * GLA_N, p.Wt_in + (size_t)l * GLA_NM * DM, p.W16_in + (size_t)l * 16 * DM, GLA_N, GLA_NM);
      for (int l = 0; l < 2; ++l) add(p.gla_w_out + (size_t)l * DM * DM, p.Wt_out + (size_t)l * DM * DM, nullptr, DM, DM);
      add(p.fox_w_kv, p.Wt_kv, p.W16_kv, KV_N, KV_NM);
      for (int l = 0; l < 2; ++l) add(p.fox_w_q + (size_t)l * DM * 4096, p.Wt_q + (size_t)l * 4096 * DM, nullptr, 4096, 4096);
      for (int l = 0; l < 2; ++l) add(p.fox_w_out + (size_t)l * DM * DM, p.Wt_fo + (size_t)l * DM * DM, nullptr, DM, DM);
      for (int l = 0; l < 4; ++l) add(p.peer_w_q + (size_t)l * DM * DM, p.Wt_pq + (size_t)l * DM * DM, nullptr, DM, DM);
      p.ntr_jobs = first; p.pad0 = 0; }
    (void)hipMemsetAsync(p.bar, 0, 16384, stream);
    hipLaunchKernelGGL(trunk_kernel<0xffffffffu>, dim3(grid), dim3(NTHR), LDS_BYTES, stream, p, 0, NSTEPS);
    const hipError_t le = hipPeekAtLastError();
    if (le != hipSuccess) fprintf(stderr, "kernel_launch: launch failed: %s\n", hipGetErrorName(le));
}
```

```cpp
#include <hip/hip_runtime.h>
#include <stdint.h>
#include <stdio.h>

#define LAS __attribute__((address_space(3)))
typedef unsigned short bf16_t;
typedef float f32x16 __attribute__((ext_vector_type(16)));
typedef float fl2 __attribute__((ext_vector_type(2)));
typedef short s16x4 __attribute__((ext_vector_type(4)));
typedef __bf16 bf16x2 __attribute__((ext_vector_type(2)));

__device__ __forceinline__ int ltid(int wv) { unsigned m = ~0u; asm volatile("" : "+s"(m)); return (wv << 6) | (int)__builtin_amdgcn_mbcnt_hi(m, __builtin_amdgcn_mbcnt_lo(m, 0u)); }

__device__ __forceinline__ int lbid() { int b = (int)blockIdx.x; asm volatile("" : "+s"(b)); return b; }
__device__ __forceinline__ int lgrid() { int g = (int)gridDim.x; asm volatile("" : "+s"(g)); return g; }

namespace pg8 {
#define PG8_LAS __attribute__((address_space(3)))
typedef unsigned short bf16_t;
typedef short bf16x8 __attribute__((ext_vector_type(8)));
typedef float f32x4 __attribute__((ext_vector_type(4)));
typedef unsigned u32x4 __attribute__((ext_vector_type(4)));
constexpr int BM = 256, BK = 64, HALF = 128, HTB = HALF * BK * 2  , STAGE_BYTES = 8 * HTB, NXCD = 8, WGM = 8;

__host__ __device__ __forceinline__ int lds_byte(int r, int c) { const int st = (r >> 4) * 2 + (c >> 5), rr = r & 15, cc = c & 31, ob = rr * 64 + cc * 2; return st * 1024 + (ob ^ (((ob >> 9) & 1) << 5)); }
__host__ __device__ __forceinline__ void stage_rc(int b, int& R, int& C) { const int st = b / 1024, sb = b % 1024, swz = sb ^ (((sb >> 9) & 1) << 5); R = (st >> 1) * 16 + swz / 64; C = (st & 1) * 32 + (swz % 64) / 2; }
__host__ __device__ __forceinline__ int perm32(int rho) { const int n = rho >> 4, i = rho & 15; return 8 * (i >> 2) + 4 * n + (i & 3); }

struct Unit { int pm, pn; };
struct Gemm { const bf16_t* A; const bf16_t* Bt; int M, N, K; };

struct StaticOrder {
    int nM, nN, nwg, G, c;
    __host__ __device__ void init(int M, int N, int G_, int c_) { nM = M / BM; nN = N / BM; nwg = nM * nN; G = G_; c = c_; }
    __host__ __device__ bool next(int i, Unit& u) const {
        const long L = (long)i * G + c; if (L >= nwg) return false;
        int wgid = (int)L; { const int q = nwg / NXCD, r = nwg % NXCD, xcd = wgid % NXCD, off = wgid / NXCD; wgid = (xcd < r ? xcd * (q + 1) : r * (q + 1) + (xcd - r) * q) + off; }
        const int nig = WGM * nN, gid = wgid / nig, fm = gid * WGM, gsz = (nM - fm) < WGM ? (nM - fm) : WGM;
        u.pm = fm + ((wgid % nig) % gsz); u.pn = (wgid % nig) / gsz; return true;
    }
    __device__ __forceinline__ void a_ready(const Unit&) const {}
    __device__ __forceinline__ void done(const Unit&) const {}
};
struct CountedOrder : StaticOrder {
    const unsigned* ready; unsigned need; unsigned* tmo;
    __device__ __forceinline__ void a_ready(const Unit& u) const {
        if (threadIdx.x < 64) {
            const unsigned long long t0 = __builtin_amdgcn_s_memrealtime(); unsigned polls = 0;
            while ((unsigned)__builtin_amdgcn_readfirstlane(__hip_atomic_load(ready + 64 * u.pm, __ATOMIC_RELAXED, __HIP_MEMORY_SCOPE_AGENT)) < need) {
                if ((++polls & 255u) == 0u && __builtin_amdgcn_readfirstlane(__hip_atomic_load(tmo, __ATOMIC_RELAXED, __HIP_MEMORY_SCOPE_AGENT)) != 0u) break;
                if (__builtin_amdgcn_s_memrealtime() - t0 > 2000000ull) {
                    if (threadIdx.x == 0) { unsigned expect = 0u; __hip_atomic_compare_exchange_strong(tmo + 1, &expect, 0x600u | (unsigned)(u.pm & 0xff), __ATOMIC_RELAXED, __ATOMIC_RELAXED, __HIP_MEMORY_SCOPE_AGENT); __hip_atomic_store(tmo, 1u, __ATOMIC_RELAXED, __HIP_MEMORY_SCOPE_AGENT); }
                    break; }
                __builtin_amdgcn_s_sleep(2); }
            __builtin_amdgcn_fence(__ATOMIC_ACQUIRE, "agent");
            asm volatile("s_waitcnt vmcnt(0)" ::: "memory");
        }
#if !defined(BROKEN_HOOK_NO_BARRIER)
        asm volatile("" ::: "memory"); __builtin_amdgcn_s_barrier(); asm volatile("" ::: "memory");
#endif
    }
};

__device__ __forceinline__ unsigned cvt_pk_bf16(float lo, float hi) { unsigned r; asm volatile("v_cvt_pk_bf16_f32 %0, %1, %2" : "=v"(r) : "v"(lo), "v"(hi)); return r; }
typedef float f32x2 __attribute__((ext_vector_type(2)));
__device__ __forceinline__ f32x2 gelu_pk(f32x2 v) {
    const f32x2 av = __builtin_elementwise_abs(v), d = av * 0.2316418882f + 1.0f;
    f32x2 t; t.x = __builtin_amdgcn_rcpf(d.x); t.y = __builtin_amdgcn_rcpf(d.y);
    f32x2 q = t * 0.5307027145f + (-0.7265760135f); q = q * t + 0.7107068705f; q = q * t + (-0.142248368f); q = q * t + 0.127414796f; q = q * t;
    const f32x2 s = (v * v) * (-0.72134752044f);
    f32x2 e; e.x = __builtin_amdgcn_exp2f(s.x); e.y = __builtin_amdgcn_exp2f(s.y);
    const f32x2 m = v * (q * e), r = v - m;
    f32x2 o; o.x = v.x < 0.f ? m.x : r.x; o.y = v.y < 0.f ? m.y : r.y; return o;
}

struct EpiF32 {
    static constexpr bool PERM = false, AFTER_DRAIN = false;
    float* C; int ldc; const float* bias;
    __device__ __forceinline__ void operator()(const f32x4 (&acc)[2][2][4][2], const Unit& u, int wr, int wc, int fr, int fq) const {
        const int row0 = u.pm * BM + wr * 64 + fr, col0 = u.pn * BM + wc * 32 + 4 * fq;
        f32x4 bv[2][2];
#pragma unroll
        for (int bj = 0; bj < 2; ++bj)
#pragma unroll
            for (int n = 0; n < 2; ++n) bv[bj][n] = bias ? *(const f32x4*)(bias + col0 + bj * HALF + n * 16) : (f32x4){0.f, 0.f, 0.f, 0.f};
#pragma unroll
        for (int ai = 0; ai < 2; ++ai)
#pragma unroll
            for (int m = 0; m < 4; ++m) { float* rowp = C + (size_t)(row0 + ai * HALF + m * 16) * ldc + col0;
#pragma unroll
                for (int bj = 0; bj < 2; ++bj)
#pragma unroll
                    for (int n = 0; n < 2; ++n) *(f32x4*)(rowp + bj * HALF + n * 16) = acc[ai][bj][m][n] + bv[bj][n]; }
    }
};
template <int ACT  > struct EpiBf16 {
    static constexpr bool PERM = true, AFTER_DRAIN = false;
    bf16_t* O; int ldc; const float* bias; int split_cols; size_t split_stride;
    __device__ __forceinline__ void operator()(const f32x4 (&acc)[2][2][4][2], const Unit& u, int wr, int wc, int fr, int fq) const {
        const int row0 = u.pm * BM + wr * 64 + fr; int colt = u.pn * BM; bf16_t* base = O;
        if (split_cols) { const int t = colt / split_cols; base += (size_t)t * split_stride; colt -= t * split_cols; }
        const int col0 = colt + wc * 32 + 8 * fq, bcol0 = u.pn * BM + wc * 32 + 8 * fq;
        f32x4 bv[2][2];
#pragma unroll
        for (int bj = 0; bj < 2; ++bj)
#pragma unroll
            for (int n = 0; n < 2; ++n) bv[bj][n] = bias ? *(const f32x4*)(bias + bcol0 + bj * HALF + 4 * n) : (f32x4){0.f, 0.f, 0.f, 0.f};
#pragma unroll
        for (int ai = 0; ai < 2; ++ai)
#pragma unroll
            for (int m = 0; m < 4; ++m) { bf16_t* rowp = base + (size_t)(row0 + ai * HALF + m * 16) * ldc + col0;
#pragma unroll
                for (int bj = 0; bj < 2; ++bj) { f32x4 v0 = acc[ai][bj][m][0] + bv[bj][0], v1 = acc[ai][bj][m][1] + bv[bj][1];
                    if (ACT == 1) { f32x2 a = gelu_pk((f32x2){v0[0], v0[1]}), b = gelu_pk((f32x2){v0[2], v0[3]}), c = gelu_pk((f32x2){v1[0], v1[1]}), d = gelu_pk((f32x2){v1[2], v1[3]});
                        v0 = (f32x4){a.x, a.y, b.x, b.y}; v1 = (f32x4){c.x, c.y, d.x, d.y}; }
                    if (ACT == 2) {
#pragma unroll
                        for (int j = 0; j < 4; ++j) { v0[j] = 0.5f * v0[j] * (1.0f + erff(v0[j] * 0.70710678f)); v1[j] = 0.5f * v1[j] * (1.0f + erff(v1[j] * 0.70710678f)); } }
                    u32x4 w; w.x = cvt_pk_bf16(v0[0], v0[1]); w.y = cvt_pk_bf16(v0[2], v0[3]); w.z = cvt_pk_bf16(v1[0], v1[1]); w.w = cvt_pk_bf16(v1[2], v1[3]);
                    *(u32x4*)(rowp + bj * HALF) = w; } }
    }
};
struct EpiResid {
    static constexpr bool PERM = false, AFTER_DRAIN = false;
    const void* xold; int xold_f32; bf16_t* xnew; const float* gate; int gstride;
    __device__ __forceinline__ void operator()(const f32x4 (&acc)[2][2][4][2], const Unit& u, int wr, int wc, int fr, int fq) const {
        const int row0 = u.pm * BM + wr * 64 + fr, col0 = u.pn * BM + wc * 32 + 4 * fq;
        const float* gp = gate + (size_t)((u.pm * BM) >> 12) * gstride + col0;
        f32x4 gv[2][2];
#pragma unroll
        for (int bj = 0; bj < 2; ++bj)
#pragma unroll
            for (int n = 0; n < 2; ++n) gv[bj][n] = *(const f32x4*)(gp + bj * HALF + n * 16);
#pragma unroll
        for (int ai = 0; ai < 2; ++ai) {
            f32x4 xo[4][2][2];
            if (xold_f32) {
#pragma unroll
                for (int m = 0; m < 4; ++m) { const size_t off = (size_t)(row0 + ai * HALF + m * 16) * 2048 + col0;
#pragma unroll
                    for (int bj = 0; bj < 2; ++bj)
#pragma unroll
                        for (int n = 0; n < 2; ++n) xo[m][bj][n] = *(const f32x4*)((const float*)xold + off + bj * HALF + n * 16); }
            } else {
#pragma unroll
                for (int m = 0; m < 4; ++m) { const size_t off = (size_t)(row0 + ai * HALF + m * 16) * 2048 + col0;
#pragma unroll
                    for (int bj = 0; bj < 2; ++bj)
#pragma unroll
                        for (int n = 0; n < 2; ++n) { const uint2 w = *(const uint2*)((const bf16_t*)xold + off + bj * HALF + n * 16);
                            xo[m][bj][n] = (f32x4){__uint_as_float(w.x << 16), __uint_as_float(w.x & 0xffff0000u), __uint_as_float(w.y << 16), __uint_as_float(w.y & 0xffff0000u)}; } }
            }
#pragma unroll
            for (int m = 0; m < 4; ++m) { const size_t off = (size_t)(row0 + ai * HALF + m * 16) * 2048 + col0;
#pragma unroll
                for (int bj = 0; bj < 2; ++bj)
#pragma unroll
                    for (int n = 0; n < 2; ++n) { const f32x4 y = xo[m][bj][n] + gv[bj][n] * acc[ai][bj][m][n];
                        *(uint2*)(xnew + off + bj * HALF + n * 16) = make_uint2(cvt_pk_bf16(y[0], y[1]), cvt_pk_bf16(y[2], y[3])); } } }
    }
};

template <class Epi, class Sched, bool STAMP = false>
__device__ __forceinline__ void gemm_phase(int wv, PG8_LAS unsigned char* lds, const Gemm g, const Sched& S, const Epi& E, unsigned long long* stamps) {
    const int tid = ltid(wv), wid = wv, lane = tid & 63, wr = wid >> 2, wc = wid & 3, fr = lane & 15, fq = lane >> 4;
    const int K = g.K, nt = K / BK;
    int ts_lo = 0, ts_hi = 0, nts = 0; const unsigned long long rt_entry = STAMP ? (unsigned long long)wall_clock64() : 0ull;
#define PG8_STAMP() do { if (STAMP && wid == 0 && nts < 64) { const unsigned long long _c = (unsigned long long)clock64(); \
        ts_lo = (lane == nts) ? (int)(unsigned)_c : ts_lo; ts_hi = (lane == nts) ? (int)(unsigned)(_c >> 32) : ts_hi; ++nts; } } while (0)
    PG8_STAMP();
    unsigned voffA[2], voffB[2];
#pragma unroll
    for (int i = 0; i < 2; ++i) { int R, C; stage_rc(tid * 16 + i * 8192, R, C); const int Rb = Epi::PERM ? ((R & ~31) + perm32(R & 31)) : R;
        voffA[i] = (unsigned)(R * K + C) * 2u; voffB[i] = (unsigned)(Rb * K + C) * 2u; }
    const size_t kstep = (size_t)(BK * 2);
    const size_t hstep = (size_t)HALF * K * 2;
    const size_t tstep = 2 * hstep;
    const unsigned ldsw = (unsigned)wid * 1024u;
    const int aoff = lds_byte(wr * 64 + fr, fq * 8), boff = lds_byte(wc * 32 + fr, fq * 8);
#define PG8_SA(b, h) (((b) * 2 + (h)) * HTB)
#define PG8_SB(b, h) ((4 + (b) * 2 + (h)) * HTB)
#define PG8_STAGE(bufoff, gbase, voff) do { _Pragma("unroll") for (int _i = 0; _i < 2; ++_i) \
        __builtin_amdgcn_global_load_lds((const unsigned*)((const char*)(gbase) + (voff)[_i]), (PG8_LAS unsigned*)(lds + (bufoff) + ldsw + _i * 8192), 16, 0, 0); } while (0)
#define PG8_LDA(dst, b, h) do { _Pragma("unroll") for (int m = 0; m < 4; ++m) _Pragma("unroll") for (int k = 0; k < 2; ++k) dst[m][k] = *(const PG8_LAS bf16x8*)(lds + PG8_SA(b, h) + aoff + m * 2048 + k * 1024); } while (0)
#define PG8_LDB(dst, b, h) do { _Pragma("unroll") for (int n = 0; n < 2; ++n) _Pragma("unroll") for (int k = 0; k < 2; ++k) dst[n][k] = *(const PG8_LAS bf16x8*)(lds + PG8_SB(b, h) + boff + n * 2048 + k * 1024); } while (0)
#define PG8_MMA(ai, bj, At, Bt) do { __builtin_amdgcn_s_setprio(1); _Pragma("unroll") for (int m = 0; m < 4; ++m) _Pragma("unroll") for (int n = 0; n < 2; ++n) _Pragma("unroll") for (int k = 0; k < 2; ++k) \
        acc[ai][bj][m][n] = __builtin_amdgcn_mfma_f32_16x16x32_bf16(Bt[n][k], At[m][k], acc[ai][bj][m][n], 0, 0, 0); __builtin_amdgcn_s_setprio(0); } while (0)
#define PG8_WAIT_V(n) asm volatile("s_waitcnt vmcnt(" #n ")" ::: "memory")
#define PG8_WAIT_L(n) asm volatile("s_waitcnt lgkmcnt(" #n ")" ::: "memory")
#define PG8_BAR __builtin_amdgcn_s_barrier()
#define PG8_SCHED __builtin_amdgcn_sched_barrier(0)
    Unit cur, nxt; int ui = 0;
    if (!S.next(0, cur)) return;
    f32x4 acc[2][2][4][2];
#pragma unroll
    for (int a = 0; a < 2; ++a)
#pragma unroll
        for (int b = 0; b < 2; ++b)
#pragma unroll
            for (int m = 0; m < 4; ++m)
#pragma unroll
                for (int n = 0; n < 2; ++n) acc[a][b][m][n] = (f32x4){0.f, 0.f, 0.f, 0.f};
    bf16x8 At[4][2], B0[2][2], B1[2][2];
    const char* cA = (const char*)g.A + (size_t)cur.pm * tstep; const char* cB = (const char*)g.Bt + (size_t)cur.pn * tstep;
    S.a_ready(cur);
    PG8_STAGE(PG8_SB(0, 0), cB, voffB); PG8_STAGE(PG8_SA(0, 0), cA, voffA); PG8_STAGE(PG8_SB(0, 1), cB + hstep, voffB); PG8_STAGE(PG8_SA(0, 1), cA + hstep, voffA);
    if (wr == 1) PG8_BAR;
    PG8_WAIT_V(4); PG8_BAR;
    PG8_STAGE(PG8_SB(1, 0), cB + kstep, voffB); PG8_STAGE(PG8_SA(1, 0), cA + kstep, voffA); PG8_STAGE(PG8_SB(1, 1), cB + hstep + kstep, voffB);
    PG8_WAIT_V(6); PG8_BAR;
    PG8_STAMP();
    for (;;) {
        const bool has_next = S.next(ui + 1, nxt);
        const char* nA = has_next ? (const char*)g.A + (size_t)nxt.pm * tstep : cA; const char* nB = has_next ? (const char*)g.Bt + (size_t)nxt.pn * tstep : cB;
        for (int t = 0; t < nt; t += 2) {
            const bool last = (t == nt - 2);
            const char* a1 = cA + (size_t)(t + 1) * kstep;
            const char* a2 = last ? nA : cA + (size_t)(t + 2) * kstep; const char* b2 = last ? nB : cB + (size_t)(t + 2) * kstep;
            const char* a3 = a2 + kstep; const char* b3 = b2 + kstep;
            if (last && has_next) S.a_ready(nxt);
            PG8_LDB(B0, 0, 0); PG8_SCHED; PG8_LDA(At, 0, 0); PG8_STAGE(PG8_SA(1, 1), a1 + hstep, voffA);
            PG8_WAIT_L(8); PG8_BAR; PG8_WAIT_L(0); PG8_MMA(0, 0, At, B0); PG8_BAR; PG8_SCHED;
            PG8_LDB(B1, 0, 1); PG8_STAGE(PG8_SB(0, 0), b2, voffB);
            PG8_BAR; PG8_WAIT_L(0); PG8_MMA(0, 1, At, B1); PG8_BAR;
            PG8_LDA(At, 0, 1); PG8_STAGE(PG8_SA(0, 0), a2, voffA);
            PG8_BAR; PG8_WAIT_L(0); PG8_MMA(1, 0, At, B0); PG8_BAR; PG8_SCHED;
            PG8_STAGE(PG8_SB(0, 1), b2 + hstep, voffB);
            PG8_WAIT_V(6); PG8_BAR; PG8_MMA(1, 1, At, B1); PG8_BAR;
            PG8_LDB(B0, 1, 0); PG8_SCHED; PG8_LDA(At, 1, 0); PG8_STAGE(PG8_SA(0, 1), a2 + hstep, voffA);
            PG8_WAIT_L(8); PG8_BAR; PG8_WAIT_L(0); PG8_MMA(0, 0, At, B0); PG8_BAR; PG8_SCHED;
            PG8_LDB(B1, 1, 1); PG8_STAGE(PG8_SB(1, 0), b3, voffB);
            PG8_BAR; PG8_WAIT_L(0); PG8_MMA(0, 1, At, B1); PG8_BAR;
            PG8_LDA(At, 1, 1); PG8_STAGE(PG8_SA(1, 0), a3, voffA);
            PG8_BAR; PG8_WAIT_L(0); PG8_MMA(1, 0, At, B0); PG8_BAR; PG8_SCHED;
            PG8_STAGE(PG8_SB(1, 1), b3 + hstep, voffB);
            PG8_WAIT_V(6); PG8_BAR; PG8_MMA(1, 1, At, B1); PG8_BAR;
        }
        PG8_STAMP();
        if constexpr (!Epi::AFTER_DRAIN) { E(acc, cur, wr, wc, fr, fq); S.done(cur); }
        PG8_STAMP();
        if (!has_next) break;
#pragma unroll
        for (int a = 0; a < 2; ++a)
#pragma unroll
            for (int b = 0; b < 2; ++b)
#pragma unroll
                for (int m = 0; m < 4; ++m)
#pragma unroll
                    for (int n = 0; n < 2; ++n) acc[a][b][m][n] = (f32x4){0.f, 0.f, 0.f, 0.f};
        cur = nxt; cA = nA; cB = nB; ++ui;
    }
    PG8_WAIT_V(0);
    if (wr == 0) PG8_BAR;
    PG8_BAR;
    if constexpr (Epi::AFTER_DRAIN) { E.fused(acc, cur, wr, wc, fr, fq, lds, wid, lane); S.done(cur); }
    PG8_STAMP();
    if (STAMP && wid == 0) { stamps[lane] = lane < nts ? (((unsigned long long)(unsigned)ts_hi << 32) | (unsigned)ts_lo) : 0ull;
        if (lane == 62) stamps[62] = rt_entry; if (lane == 63) stamps[63] = (unsigned long long)wall_clock64(); }
#undef PG8_STAMP
#undef PG8_SA
#undef PG8_SB
#undef PG8_STAGE
#undef PG8_LDA
#undef PG8_LDB
#undef PG8_MMA
#undef PG8_WAIT_V
#undef PG8_WAIT_L
#undef PG8_BAR
#undef PG8_SCHED
}
}
#define XB_TMO      128
#define XB_XCNT(j)  (256  + 64 * (j))
#define XB_XSUB(j)  (1280 + 64 * (j))
#define XB_XGEN(j)  (2304 + 64 * (j))
#define XB_TOP      3328
#define XB_TOPGEN   3392
#define XCD_BAR_WORDS 3456
#define XB_SPIN_CAP (1u << 18)
#define LAS __attribute__((address_space(3)))

__device__ __forceinline__ unsigned xb_ld(unsigned* p)              { return __hip_atomic_load(p, __ATOMIC_RELAXED, __HIP_MEMORY_SCOPE_AGENT); }
__device__ __forceinline__ unsigned xb_add(unsigned* p, unsigned v) { return __hip_atomic_fetch_add(p, v, __ATOMIC_RELAXED, __HIP_MEMORY_SCOPE_AGENT); }
__device__ __forceinline__ unsigned xb_xcc_id() { return (unsigned)__builtin_amdgcn_s_getreg((3 << 11) | 20) & 0xFu; }
#define XB_SPIN(cond, bar) do { unsigned _sp = 0; while (cond) { __builtin_amdgcn_s_sleep(1); \
    if ((++_sp & 255u) == 0u) { if (xb_ld(&(bar)[XB_TMO])) break; if (_sp > XB_SPIN_CAP) { atomicAdd(&(bar)[XB_TMO], 1u); break; } } } } while (0)

struct XcdBarrier {
    unsigned* bar; unsigned x; int wv;
    volatile LAS unsigned* st;
};

__device__ __forceinline__ bool xb_thread0(int wv) { unsigned m = ~0u; asm volatile("" : "+s"(m)); return wv == 0 && __builtin_amdgcn_mbcnt_hi(m, __builtin_amdgcn_mbcnt_lo(m, 0u)) == 0u; }
__device__ __forceinline__ XcdBarrier xcd_barrier_post(unsigned* bar, volatile LAS unsigned* st, int wv) {
    XcdBarrier b; b.bar = bar; b.x = xb_xcc_id(); b.st = st; b.wv = wv;
    if (xb_thread0(wv)) (void)xb_add(&bar[XB_XCNT(b.x)], 1u);
    return b;
}
__device__ __forceinline__ void xcd_barrier_complete(unsigned* bar, unsigned x, unsigned& nloc, unsigned& nx) {
    const unsigned G = gridDim.x * gridDim.y * gridDim.z;
    unsigned sum, cnt, mine, sp = 0u;
    for (;;) {
        sum = 0u; cnt = 0u; mine = 0u;
#pragma unroll
        for (unsigned j = 0; j < 16; ++j) { const unsigned c = xb_ld(&bar[XB_XCNT(j)]); sum += c; cnt += (c > 0u) ? 1u : 0u; mine = (j == x) ? c : mine; }
        if (sum == G) break;
        __builtin_amdgcn_s_sleep(1);
        if ((++sp & 255u) == 0u) { if (xb_ld(&bar[XB_TMO])) break; if (sp > XB_SPIN_CAP) { atomicAdd(&bar[XB_TMO], 1u); break; } }
    }
    nloc = mine > 0u ? mine : 1u; nx = cnt > 0u ? cnt : 1u;
}

__device__ __forceinline__ void xcd_barrier(const XcdBarrier& b) {
    asm volatile("s_waitcnt vmcnt(0)" ::: "memory");
    __syncthreads();
    if (xb_thread0(b.wv)) {
        unsigned* bar = b.bar; asm volatile("" : "+s"(bar)); unsigned bx = b.x; asm volatile("" : "+s"(bx));
        __builtin_amdgcn_s_waitcnt(0);
        unsigned nloc = b.st[0], nx = b.st[1];
        if (nloc == 0u) { xcd_barrier_complete(bar, bx, nloc, nx); b.st[0] = nloc; b.st[1] = nx; }
        const unsigned old = xb_add(&bar[XB_XSUB(bx)], 1u);
        const unsigned gen = old / nloc;
        if (old + 1u == (gen + 1u) * nloc) {
            __builtin_amdgcn_fence(__ATOMIC_RELEASE, "agent");
            asm volatile("s_waitcnt vmcnt(0)" ::: "memory");
            const unsigned og = xb_add(&bar[XB_TOP], 1u);
            const unsigned tg = og / nx;
            if (og + 1u == (tg + 1u) * nx) xb_add(&bar[XB_TOPGEN], 1u);
            else XB_SPIN(xb_ld(&bar[XB_TOPGEN]) == tg, bar);
            __builtin_amdgcn_fence(__ATOMIC_ACQUIRE, "agent");
            xb_add(&bar[XB_XGEN(bx)], 1u);
            asm volatile("s_waitcnt vmcnt(0)" ::: "memory");
        } else {
            XB_SPIN(xb_ld(&bar[XB_XGEN(bx)]) == gen, bar);
            __builtin_amdgcn_fence(__ATOMIC_ACQUIRE, "agent");
            asm volatile("s_waitcnt vmcnt(0)" ::: "memory");
        }
    }
    __syncthreads();
    __builtin_amdgcn_s_waitcnt(0);
}

constexpr int NTHR = 512, NWAVE = 8;
constexpr int TT = 16384, DM = 2048, SEQ = 4096, NBATCH = 4;
constexpr int GLA_N = 6160, GLA_NM = 6144;
constexpr int KV_N = 4112, KV_NM = 4096;
constexpr float RMS_EPS = 1e-6f;
constexpr int LDS_BYTES = 155648;

typedef pg8::bf16x8 bf16x8;
typedef pg8::f32x4 f32x4;
typedef pg8::u32x4 u32x4;

struct TMat { const float* src; bf16_t* dst; bf16_t* dst16; int N, Nmain, ntn, first; };
constexpr int NTMAT = 13;
struct Params {
    const float *x, *c, *ada_w, *ada_b, *norm_mix, *norm_ffn, *gla_w_in, *gla_wg2, *gla_bg2, *gla_norm, *gla_w_out, *kv_norm, *kv_ada_w, *kv_ada_b,
                *fox_w_kv, *fox_b_f, *fox_w_q, *fox_w_out, *peer_w_q, *peer_subk, *peer_u, *peer_v, *final_norm;
    float* out;
    unsigned* bar; float* mod; float* kvmod;
    bf16_t *Wt_in, *W16_in, *Wt_out, *Wt_kv, *W16_kv, *Wt_q, *Wt_fo, *Wt_pq, *subk; unsigned char *U8, *V8; float *su, *sv;
    bf16_t* xbuf; bf16_t *h, *hk, *h2, *og, *pq; int* ids; float* wts; float* fl; float* apart; signed char* cqbuf; float* scbuf; float* kn2; int* jlo;
    bf16_t *proj, *qt, *khT, *vT, *Pm; float* dec; bf16_t* o;
    bf16_t *qb, *gb, *Kb, *Vb, *ob; float* Fa;
    TMat tm[NTMAT];
    int ntr_jobs, pad0;
};

__device__ __forceinline__ unsigned cvtpk(float lo, float hi) { unsigned r; asm("v_cvt_pk_bf16_f32 %0, %1, %2" : "=v"(r) : "v"(lo), "v"(hi)); return r; }
__device__ __forceinline__ float bflo(unsigned w) { return __uint_as_float(w << 16); }
__device__ __forceinline__ float bfhi(unsigned w) { return __uint_as_float(w & 0xffff0000u); }
__device__ __forceinline__ bf16_t f2bf(float f) { return (bf16_t)(cvtpk(f, f) & 0xffffu); }
__device__ __forceinline__ float shfl_idx(float v, int src_lane) { return __builtin_bit_cast(float, __builtin_amdgcn_ds_bpermute(src_lane << 2, __builtin_bit_cast(int, v))); }
__device__ __forceinline__ float wave_sum_shfl(float v, int lane) {
#pragma unroll
    for (int o = 32; o > 0; o >>= 1) v += shfl_idx(v, lane ^ o);
    return v;
}
template <int CTRL> __device__ __forceinline__ int dpp_i(int x) { return __builtin_amdgcn_mov_dpp(x, CTRL, 0xf, 0xf, true); }
template <int CTRL> __device__ __forceinline__ float dpp_f(float x) { return __builtin_bit_cast(float, __builtin_amdgcn_mov_dpp(__builtin_bit_cast(int, x), CTRL, 0xf, 0xf, true)); }
__device__ __forceinline__ float rdlane(float v, int l) { return __builtin_bit_cast(float, __builtin_amdgcn_readlane(__builtin_bit_cast(int, v), l)); }
__device__ __forceinline__ float wave_sum_dpp(float v) {
    v += dpp_f<0xB1>(v); v += dpp_f<0x4E>(v); v += dpp_f<0x141>(v); v += dpp_f<0x128>(v);
    return (rdlane(v, 0) + rdlane(v, 16)) + (rdlane(v, 32) + rdlane(v, 48));
}
__device__ __forceinline__ float dot2bf(unsigned a, unsigned b, float acc) { return __builtin_amdgcn_fdot2_f32_bf16(__builtin_bit_cast(bf16x2, a), __builtin_bit_cast(bf16x2, b), acc, false); }
__device__ __forceinline__ float log_sigmoidf(float z) { return fminf(z, 0.f) - log1pf(expf(-fabsf(z))); }
__device__ __forceinline__ float log_sigmoid_fast(float z) { return fminf(z, 0.f) - __logf(1.f + __expf(-fabsf(z))); }
__device__ __forceinline__ float siluf(float z) { return z / (1.f + expf(-z)); }
__device__ __forceinline__ float sigmoidf_(float z) { return 1.f / (1.f + expf(-z)); }
__device__ __forceinline__ float gelu_tanh(float x) { const float u = 0.7978845608028654f * (x + 0.044715f * x * x * x); return 0.5f * x * (1.f + tanhf(u)); }
__device__ __forceinline__ u32x4 pack8f(const float (&v)[8]) { u32x4 w; w.x = cvtpk(v[0], v[1]); w.y = cvtpk(v[2], v[3]); w.z = cvtpk(v[4], v[5]); w.w = cvtpk(v[6], v[7]); return w; }
__device__ __forceinline__ void unpack8(const u32x4 w, float (&v)[8]) { v[0] = bflo(w.x); v[1] = bfhi(w.x); v[2] = bflo(w.y); v[3] = bfhi(w.y); v[4] = bflo(w.z); v[5] = bfhi(w.z); v[6] = bflo(w.w); v[7] = bfhi(w.w); }
#define MFMA16(a, b, c) __builtin_amdgcn_mfma_f32_16x16x32_bf16((a), (b), (c), 0, 0, 0)

constexpr int NGEMV = 208, NCONV = 2048 + 2048 + 16;
__device__ __forceinline__ void phase_prologue(int wv, const Params& p, unsigned char* lds, unsigned* qctr) {
    const int tid = ltid(wv), wid = wv, lane = tid & 63;
    const int bid_ = lbid(), ngrid_ = lgrid();
    float* cact = (float*)lds;
    float* red = (float*)(lds + 32768);
    float* tile = (float*)(lds + 65536);
    for (int i = tid; i < NBATCH * DM; i += NTHR) cact[i] = siluf(p.c[i]);
    __syncthreads();
    const int njobs = NGEMV + p.ntr_jobs + NCONV;
    volatile int* s_job = (volatile int*)(lds + 140 * 1024);
    (void)bid_; (void)ngrid_;
    if (tid == 0) *s_job = (int)__hip_atomic_fetch_add(qctr, 1u, __ATOMIC_RELAXED, __HIP_MEMORY_SCOPE_AGENT);
    __syncthreads();
    int job = __builtin_amdgcn_readfirstlane(*s_job);
    __syncthreads();
    for (; job < njobs; ) {
        if (tid == 0) *s_job = (int)__hip_atomic_fetch_add(qctr, 1u, __ATOMIC_RELAXED, __HIP_MEMORY_SCOPE_AGENT);
        if (job < NGEMV) {
            const float* W; const float* bias; float* outp; int N, ostride, cb;
            if (job < 192) { const int l = job / 48; cb = job % 48; W = p.ada_w + (size_t)l * DM * 12288; bias = p.ada_b + l * 12288; outp = p.mod + (size_t)l * NBATCH * 12288; N = 12288; ostride = 12288; }
            else { cb = job - 192; W = p.kv_ada_w; bias = p.kv_ada_b; outp = p.kvmod; N = 4096; ostride = 4096; }
            const int col = cb * 256 + 4 * lane;
            f32x4 acc[4];
#pragma unroll
            for (int b = 0; b < 4; ++b) acc[b] = (f32x4){0.f, 0.f, 0.f, 0.f};
            const float* wp = W + (size_t)(wid * 256) * N + col;
#pragma unroll 8
            for (int k = 0; k < 256; ++k) {
                const f32x4 w4 = *(const f32x4*)(wp + (size_t)k * N);
#pragma unroll
                for (int b = 0; b < 4; ++b) acc[b] += cact[b * DM + wid * 256 + k] * w4;
            }
#pragma unroll
            for (int b = 0; b < 4; ++b) *(f32x4*)(red + (wid * 4 + b) * 256 + 4 * lane) = acc[b];
            __syncthreads();
#pragma unroll
            for (int i = 0; i < 2; ++i) { const int o = tid + NTHR * i, b = o >> 8, cl = o & 255; float s = bias[cb * 256 + cl];
#pragma unroll
                for (int ks = 0; ks < 8; ++ks) s += red[(ks * 4 + b) * 256 + cl];
                outp[(size_t)b * ostride + cb * 256 + cl] = s; }
            __syncthreads();
        } else if (job < NGEMV + p.ntr_jobs) {
            const int j = job - NGEMV; int m = 0;
#pragma unroll
            for (int q = 1; q < NTMAT; ++q) if (j >= p.tm[q].first) m = q;
            const TMat M = p.tm[m];
            const int r = j - M.first, kt = r / M.ntn, nt4 = r - kt * M.ntn;
#pragma unroll
            for (int i = 0; i < 8; ++i) { const int idx = tid + NTHR * i, rr = idx >> 6, c4 = idx & 63, n = nt4 * 256 + 4 * c4;
                f32x4 v = (f32x4){0.f, 0.f, 0.f, 0.f};
                if (n < M.N) v = *(const f32x4*)(M.src + (size_t)(kt * 64 + rr) * M.N + n);
                float* tp = tile + ((c4 >> 4) * 64 + rr) * 65 + 4 * (c4 & 15); tp[0] = v[0]; tp[1] = v[1]; tp[2] = v[2]; tp[3] = v[3]; }
            __syncthreads();
#pragma unroll
            for (int q = 0; q < 4; ++q) { const int nl = tid >> 3, ks = tid & 7, n = nt4 * 256 + q * 64 + nl; float v[8];
#pragma unroll
              for (int e = 0; e < 8; ++e) v[e] = tile[(q * 64 + 8 * ks + e) * 65 + nl];
              const u32x4 w = pack8f(v);
              if (n < M.Nmain) *(u32x4*)(M.dst + (size_t)n * DM + kt * 64 + 8 * ks) = w;
              else if (n < M.N) *(u32x4*)(M.dst16 + (size_t)(n - M.Nmain) * DM + kt * 64 + 8 * ks) = w; }
            __syncthreads();
        } else {
            const int j = job - NGEMV - p.ntr_jobs;
            if (j < 4096) {
                const float* src = j < 2048 ? p.peer_u : p.peer_v; unsigned char* dst = j < 2048 ? p.U8 : p.V8; float* sc = j < 2048 ? p.su : p.sv; const int jj = j & 2047;
#pragma unroll
                for (int i = 0; i < 4; ++i) { const size_t row = (size_t)jj * 32 + wid * 4 + i; const float* rp = src + row * DM + 16 * lane;
                    f32x4 v[8];
#pragma unroll
                    for (int q = 0; q < 4; ++q) { v[q] = *(const f32x4*)(rp + 4 * q); v[4 + q] = *(const f32x4*)(rp + 1024 + 4 * q); }
                    float am = 0.f;
#pragma unroll
                    for (int q = 0; q < 8; ++q) am = fmaxf(fmaxf(fmaxf(am, fabsf(v[q][0])), fmaxf(fabsf(v[q][1]), fabsf(v[q][2]))), fabsf(v[q][3]));
#pragma unroll
                    for (int o = 32; o > 0; o >>= 1) am = fmaxf(am, shfl_idx(am, lane ^ o));
                    const float s = fmaxf(am, 1e-30f) * (1.f / 127.f), inv = 1.f / s;
                    unsigned w[8];
#pragma unroll
                    for (int q = 0; q < 8; ++q) { unsigned ww = 0u;
#pragma unroll
                        for (int e = 0; e < 4; ++e) { const int qi = (int)rintf(v[q][e] * inv); ww |= (unsigned)(qi & 0xff) << (8 * e); }
                        w[q] = ww; }
                    *(u32x4*)(dst + row * DM + 16 * lane) = (u32x4){w[0], w[1], w[2], w[3]}; *(u32x4*)(dst + row * DM + 1024 + 16 * lane) = (u32x4){w[4], w[5], w[6], w[7]};
                    if (lane == 0) sc[row] = s; }
            } else {
                const size_t base = (size_t)(j - 4096) * 65536; const float* src = p.peer_subk; bf16_t* dst = p.subk;
#pragma unroll 4
                for (int i = 0; i < 16; ++i) { const size_t e = base + (size_t)(i * NTHR + tid) * 8;
                    const f32x4 a = *(const f32x4*)(src + e), b = *(const f32x4*)(src + e + 4);
                    u32x4 w; w.x = cvtpk(a[0], a[1]); w.y = cvtpk(a[2], a[3]); w.z = cvtpk(b[0], b[1]); w.w = cvtpk(b[2], b[3]);
                    *(u32x4*)(dst + e) = w; }
            }
        }
        __syncthreads();
        job = __builtin_amdgcn_readfirstlane(*s_job);
        __syncthreads();
    }
}

template <bool TWO, bool FINAL, bool XF32 = false>
__device__ __forceinline__ void phase_norm(int wv, const void* xv, const float* g1, const float* sh1, const float* sc1, int ms1, bf16_t* out1,
                                           const float* g2, const float* sh2, const float* sc2, int ms2, bf16_t* out2, float* outf) {
    const int tid = ltid(wv), lane = tid & 63;
    const int bid_ = lbid(), ngrid_ = lgrid();
    for (int r0 = (bid_ * NWAVE + wv) * 8; r0 < TT; r0 += ngrid_ * NWAVE * 8) {
        const int b = r0 >> 12;
        f32x4 a1[8], s1[8], a2[8], s2[8];
#pragma unroll
        for (int i = 0; i < 4; ++i)
#pragma unroll
            for (int hh = 0; hh < 2; ++hh) { const int c = 8 * (lane + 64 * i) + 4 * hh;
                if constexpr (FINAL) { a1[2 * i + hh] = *(const f32x4*)(g1 + c); }
                else { a1[2 * i + hh] = *(const f32x4*)(g1 + c) * (1.f + *(const f32x4*)(sc1 + (size_t)b * ms1 + c)); s1[2 * i + hh] = *(const f32x4*)(sh1 + (size_t)b * ms1 + c); }
                if constexpr (TWO) { a2[2 * i + hh] = *(const f32x4*)(g2 + c) * (1.f + *(const f32x4*)(sc2 + (size_t)b * ms2 + c)); s2[2 * i + hh] = *(const f32x4*)(sh2 + (size_t)b * ms2 + c); } }
        for (int rr = 0; rr < 8; ++rr) { const int row = r0 + rr;
            f32x4 v[8]; float ss = 0.f;
            if constexpr (XF32) { const float* xr = (const float*)xv + (size_t)row * DM;
#pragma unroll
                for (int i = 0; i < 4; ++i) { const int c = 8 * (lane + 64 * i); v[2 * i] = *(const f32x4*)(xr + c); v[2 * i + 1] = *(const f32x4*)(xr + c + 4); } }
            else { const bf16_t* xr = (const bf16_t*)xv + (size_t)row * DM;
#pragma unroll
                for (int i = 0; i < 4; ++i) { float t8[8]; unpack8(*(const u32x4*)(xr + 8 * (lane + 64 * i)), t8); v[2 * i] = (f32x4){t8[0], t8[1], t8[2], t8[3]}; v[2 * i + 1] = (f32x4){t8[4], t8[5], t8[6], t8[7]}; } }
#pragma unroll
            for (int i = 0; i < 8; ++i) ss += v[i][0] * v[i][0] + v[i][1] * v[i][1] + v[i][2] * v[i][2] + v[i][3] * v[i][3];
            ss = wave_sum_dpp(ss);
            const float rs = rsqrtf(ss * (1.f / DM) + RMS_EPS);
#pragma unroll
            for (int i = 0; i < 4; ++i) { const int c = 8 * (lane + 64 * i);
                if constexpr (FINAL) { *(f32x4*)(outf + (size_t)row * DM + c) = v[2 * i] * rs * a1[2 * i]; *(f32x4*)(outf + (size_t)row * DM + c + 4) = v[2 * i + 1] * rs * a1[2 * i + 1]; }
                else {
                    { const f32x4 ya = v[2 * i] * rs * a1[2 * i] + s1[2 * i], yb = v[2 * i + 1] * rs * a1[2 * i + 1] + s1[2 * i + 1];
                      u32x4 w; w.x = cvtpk(ya[0], ya[1]); w.y = cvtpk(ya[2], ya[3]); w.z = cvtpk(yb[0], yb[1]); w.w = cvtpk(yb[2], yb[3]);
                      *(u32x4*)(out1 + (size_t)row * DM + c) = w; }
                    if constexpr (TWO) { const f32x4 ya = v[2 * i] * rs * a2[2 * i] + s2[2 * i], yb = v[2 * i + 1] * rs * a2[2 * i + 1] + s2[2 * i + 1];
                      u32x4 w; w.x = cvtpk(ya[0], ya[1]); w.y = cvtpk(ya[2], ya[3]); w.z = cvtpk(yb[0], yb[1]); w.w = cvtpk(yb[2], yb[3]);
                      *(u32x4*)(out2 + (size_t)row * DM + c) = w; }
                }
            }
        }
    }
}

__device__ __forceinline__ void mini16(int wv, const bf16_t* A  , const bf16_t* W16, float* gls) {
    const int tid = ltid(wv), wid = wv, lane = tid & 63, fr = lane & 15, fq = lane >> 4, mt = wid & 3, kh = wid >> 2;
    f32x4 acc = (f32x4){0.f, 0.f, 0.f, 0.f};
    const bf16_t* ap = A + (size_t)(16 * mt + fr) * DM + kh * 1024 + 8 * fq;
    const bf16_t* bp = W16 + (size_t)fr * DM + kh * 1024 + 8 * fq;
    bf16x8 af[12], bfr[12];
#define MINI_BATCH(k0, n) do { __builtin_amdgcn_sched_barrier(0);                                                                                  \
        _Pragma("unroll") for (int j = 0; j < (n); ++j) { af[j] = *(const bf16x8*)(ap + 32 * ((k0) + j)); bfr[j] = *(const bf16x8*)(bp + 32 * ((k0) + j)); } \
        __builtin_amdgcn_sched_barrier(0);                                                                                                         \
        _Pragma("unroll") for (int j = 0; j < (n); ++j) acc = MFMA16(af[j], bfr[j], acc); } while (0)
    MINI_BATCH(0, 12); MINI_BATCH(12, 12); MINI_BATCH(24, 8);
#undef MINI_BATCH
    __builtin_amdgcn_sched_barrier(0);
#pragma unroll
    for (int i = 0; i < 4; ++i) gls[(kh * 64 + 16 * mt + 4 * fq + i) * 16 + fr] = acc[i];
}

constexpr int PREP_GLS = 0, PREP_TOT = 8192, PREP_BLOC = 10240, PREP_X = 75776, PREP_Y = 109568, PREP_PS = 143360;
constexpr int XLD = 264, TLD = 72;
template <int PV>
__device__ __forceinline__ void phase_gla_prep(int wv, const Params& p, int l, unsigned char* lds) {
    const int tid = ltid(wv), wid = wv, lane = tid & 63, fr = lane & 15, fq = lane >> 4;
    const int bid_ = lbid(), ngrid_ = lgrid();
    float* gls = (float*)(lds + PREP_GLS); float* tot0 = (float*)(lds + PREP_TOT); float* bloc = (float*)(lds + PREP_BLOC);
    const unsigned xlds = (unsigned)(uintptr_t)(LAS unsigned char*)(lds + PREP_X);
    bf16_t* X = (bf16_t*)(lds + PREP_X); bf16_t* Y = (bf16_t*)(lds + PREP_Y); bf16_t* Ps = (bf16_t*)(lds + PREP_PS);
    const float* wg2 = p.gla_wg2 + (size_t)l * 16 * 1024; const float* bg2 = p.gla_bg2 + l * 1024;
    const bf16_t* W16 = p.W16_in + (size_t)l * 16 * DM;
    for (int u = bid_; u < 256; u += ngrid_) {
        const int tok0 = (u >> 6) * SEQ + (u & 63) * 64;
        if (PV != 4) mini16(wv, p.h + (size_t)tok0 * DM, W16, gls);
        __syncthreads();
        { const float s0 = gls[tid] + gls[1024 + tid], s1 = gls[NTHR + tid] + gls[1024 + NTHR + tid]; gls[tid] = s0; gls[NTHR + tid] = s1; }
        __syncthreads();
        for (int hd = 0; hd < 4; ++hd) {
            const size_t uh = (size_t)u * 4 + hd;
            u32x4 qw[4], kw[4];
#pragma unroll
            for (int i = 0; i < 4; ++i) { const int idx = tid + NTHR * i, t = idx >> 5, k0 = 8 * (idx & 31);
                const bf16_t* pr = p.proj + (size_t)(tok0 + t) * GLA_NM + hd * 256 + k0; qw[i] = *(const u32x4*)pr; kw[i] = *(const u32x4*)(pr + 1024); }
            for (int rep_ = 0; rep_ < (PV == 6 ? 2 : 1); ++rep_) if (PV != 1) { if (rep_) __syncthreads(); const int k = tid & 255, half = tid >> 8; float wg[16];
#pragma unroll
              for (int r = 0; r < 16; ++r) wg[r] = wg2[r * 1024 + hd * 256 + k];
              const float bg = bg2[hd * 256 + k]; float run = 0.f;
              fl2 wp[8];
#pragma unroll
              for (int r = 0; r < 8; ++r) wp[r] = (fl2){wg[2 * r], wg[2 * r + 1]};
              for (int tt = 0; tt < 32; tt += 4) { const int t = 32 * half + tt; const f32x4* gp = (const f32x4*)(gls + t * 16);
                  f32x4 gq[16];
                  __builtin_amdgcn_sched_barrier(0);
#pragma unroll
                  for (int i = 0; i < 16; ++i) gq[i] = gp[i];
                  __builtin_amdgcn_sched_barrier(0);
                  fl2 z2[4];
#pragma unroll
                  for (int j = 0; j < 4; ++j) z2[j] = (fl2){bg, 0.f};
#pragma unroll
                  for (int q = 0; q < 4; ++q)
#pragma unroll
                      for (int j = 0; j < 4; ++j) { const f32x4 g = gq[4 * j + q]; z2[j] += (fl2){g[0], g[1]} * wp[2 * q]; z2[j] += (fl2){g[2], g[3]} * wp[2 * q + 1]; }
                  float ls[4];
#pragma unroll
                  for (int j = 0; j < 4; ++j) { const float z = z2[j][0] + z2[j][1];
                      ls[j] = fminf(z, 0.f) - 0.6931471805599453f * __builtin_amdgcn_logf(1.f + __builtin_amdgcn_exp2f(-1.4426950408889634f * fabsf(z))); }
#pragma unroll
                  for (int j = 0; j < 4; ++j) { run += ls[j] * (1.f / 16.f); bloc[(t + j) * 256 + k] = run; } }
              if (half == 0) tot0[k] = run; }
            __syncthreads();
            f32x4 Lacc[2];
#pragma unroll
            for (int pass = 0; pass < 2; ++pass) {
#pragma unroll
                for (int i = 0; i < 4; ++i) { const int idx = tid + NTHR * i, t = idx >> 5, g = idx & 31, k0 = 8 * g;
                    float q8[8], k8[8]; unpack8(qw[i], q8); unpack8(kw[i], k8);
                    float xo[8], yo[8];
#pragma unroll
                    for (int e = 0; e < 8; ++e) { const float ep = __expf(bloc[t * 256 + k0 + e] + (t >= 32 ? tot0[k0 + e] : 0.f)), em = __frcp_rn(ep);
                        xo[e] = q8[e] * 0.0625f * (pass == 0 ? ep : em); yo[e] = k8[e] * (pass == 0 ? em : ep); }
                    const u32x4 xw = pack8f(xo), yw = pack8f(yo);
                    *(u32x4*)(X + t * XLD + k0) = xw; *(u32x4*)(Y + t * XLD + k0) = yw;
                    if (pass == 0) { const int G = g >> 2, a = g & 3, p1 = ((a & 1) << 4) | ((a >> 1) << 2);
                        bf16_t* qo = p.qt + uh * 16384 + ((size_t)((G * 4 + (t >> 4)) * 64 + (p1 >> 3) * 16 + (t & 15))) * 8 + (p1 & 7);
                        if (PV != 9) { *(uint2*)qo = make_uint2(xw.x, xw.y); *(uint2*)(qo + 128) = make_uint2(xw.z, xw.w); } } }
                __syncthreads();
#pragma unroll
                for (int j = 0; j < (PV == 3 ? 0 : 2); ++j) { const int tt = 2 * wid + j, mt = tt >> 2, nt = tt & 3; f32x4 acc = (f32x4){0.f, 0.f, 0.f, 0.f};
#pragma unroll
                    for (int ks = 0; ks < 8; ++ks) { const bf16x8 a = *(const bf16x8*)(X + (16 * mt + fr) * XLD + 32 * ks + 8 * fq), b = *(const bf16x8*)(Y + (16 * nt + fr) * XLD + 32 * ks + 8 * fq);
                        acc = MFMA16(a, b, acc); }
                    if (pass == 0) Lacc[j] = acc;
                    else {
#pragma unroll
                        for (int i = 0; i < 4; ++i) { const int t = 16 * mt + 4 * fq + i, s = 16 * nt + fr; Ps[t * TLD + s] = f2bf(s <= t ? Lacc[j][i] : acc[i]); } } }
                __syncthreads();
            }
            { const int row = tid >> 3, seg = tid & 7;
              if (PV != 9) *(u32x4*)(p.Pm + uh * 4096 + ((size_t)(((row >> 4) * 2 + (seg >> 2)) * 64 + (seg & 3) * 16 + (row & 15))) * 8) = *(const u32x4*)(Ps + row * TLD + 8 * seg); }
            if (PV != 5) { float eb[8];
#pragma unroll
              for (int e = 0; e < 8; ++e) eb[e] = __expf(bloc[63 * 256 + 8 * (tid & 31) + e] + tot0[8 * (tid & 31) + e]);
#pragma unroll
              for (int i = 0; i < 4; ++i) { const int idx = tid + NTHR * i, t = idx >> 5, g = idx & 31, k0 = 8 * g;
                float k8[8], kh[8]; unpack8(kw[i], k8);
#pragma unroll
                for (int e = 0; e < 8; ++e) { kh[e] = k8[e] * eb[e] * __expf(-(bloc[t * 256 + k0 + e] + (t >= 32 ? tot0[k0 + e] : 0.f)));
                    if (PV != 9 && t == 0) p.dec[uh * 256 + k0 + e] = eb[e]; }
                *(u32x4*)(X + t * XLD + k0) = pack8f(kh); } }
            __syncthreads();
#define PREP_TR_OUT(DST, FBASE) do { const unsigned la_ = xlds + (unsigned)(((8 * (lane >> 4) + ((lane & 15) >> 2)) * XLD + 4 * (lane & 3)) * 2);                     \
                _Pragma("unroll") for (int f = 0; f < 4; ++f) { const int fi = wid * 4 + f, cb = fi >> 1, ks = fi & 1; const unsigned a_ = la_ + (unsigned)((32 * ks * XLD + 16 * cb) * 2); \
                    s16x4 lo_, hi_;                                                                                                                       \
                    asm volatile("ds_read_b64_tr_b16 %0, %1" : "=&v"(lo_) : "v"(a_) : "memory");                                                           \
                    asm volatile("ds_read_b64_tr_b16 %0, %1 offset:%2" : "=&v"(hi_) : "v"(a_), "i"(4 * XLD * 2) : "memory");                                 \
                    asm volatile("s_waitcnt lgkmcnt(0)" ::: "memory");                                                                                     \
                    const uint2 l2_ = __builtin_bit_cast(uint2, lo_), h2_ = __builtin_bit_cast(uint2, hi_);                                                 \
                    if (PV != 9) *(u32x4*)((DST) + ((size_t)(((FBASE) + cb * 2 + ks) * 64 + lane)) * 8) = (u32x4){l2_.x, l2_.y, h2_.x, h2_.y}; } } while (0)
            if (PV != 5) PREP_TR_OUT(p.khT + uh * 16384, 0);
            __syncthreads();
        }
    }
}

#undef PREP_TR_OUT
constexpr int REC_LD = 36;
struct RecOps { bf16x8 aq[4], ak[2][2], ap[2]; f32x4 dv[2]; };
constexpr int REC_VOFF = 8 * 64 * REC_LD * 4, REC_VS = 96, REC_VBUF = 64 * REC_VS;
__device__ __forceinline__ void rec_load_a(RecOps& R, const Params& p, size_t uh, int w, int lane) {
    const bf16_t* qt = p.qt + uh * 16384 + lane * 8; const bf16_t* Pm = p.Pm + uh * 4096 + lane * 8;
#pragma unroll
    for (int mt = 0; mt < 4; ++mt) R.aq[mt] = *(const bf16x8*)(qt + (w * 4 + mt) * 512);
    const int mp = w >> 1;
    R.ap[0] = *(const bf16x8*)(Pm + (mp * 2) * 512); R.ap[1] = *(const bf16x8*)(Pm + (mp * 2 + 1) * 512);
}
__device__ __forceinline__ void rec_load_b(RecOps& R, const Params& p, size_t uh, int d0, int w, int lane) {
    const bf16_t* khT = p.khT + uh * 16384 + lane * 8; const float* dec = p.dec + uh * 256;
#pragma unroll
    for (int i = 0; i < 2; ++i) { R.ak[i][0] = *(const bf16x8*)(khT + ((2 * w + i) * 2) * 512); R.ak[i][1] = *(const bf16x8*)(khT + ((2 * w + i) * 2 + 1) * 512);
        R.dv[i] = *(const f32x4*)(dec + 16 * (2 * w + i) + 4 * (lane >> 4)); }
}
__device__ __forceinline__ void rec_load(RecOps& R, const Params& p, size_t uh, int d0, int w, int lane) { rec_load_a(R, p, uh, w, lane); rec_load_b(R, p, uh, d0, w, lane); }
template <int VAR>
__device__ __forceinline__ void phase_gla_rec(int wv, const Params& p, unsigned char* lds) {
    const int tid = ltid(wv), w = wv, lane = tid & 63, fr = lane & 15, fq = lane >> 4;
    const int bid_ = lbid(), ngrid_ = lgrid();
    float* red = (float*)lds;
    for (int u = bid_; u < 256; u += ngrid_) {
        const int g_ = (u & 7) * 2 + ((u >> 3) >> 4), b = g_ >> 2, hd = g_ & 3, d0 = ((u >> 3) & 15) * 32;
        f32x4 S[2][2];
#pragma unroll
        for (int i = 0; i < 2; ++i)
#pragma unroll
            for (int n = 0; n < 2; ++n) S[i][n] = (f32x4){0.f, 0.f, 0.f, 0.f};
        RecOps RA = {}, RB = {};
        const bf16_t* vsrc = p.proj + (size_t)(b * SEQ + (tid >> 3)) * GLA_NM + 2048 + hd * 512 + d0 + 4 * (tid & 7);
        unsigned char* vwr = lds + REC_VOFF + (tid >> 3) * REC_VS + 8 * (tid & 7);
        const unsigned vrd = (unsigned)(uintptr_t)(LAS unsigned char*)(lds + REC_VOFF) + (unsigned)((8 * (lane >> 4) + ((lane & 15) >> 2)) * REC_VS + 8 * (lane & 3));
        uint2 vreg = *(const uint2*)vsrc;
        __builtin_amdgcn_sched_barrier(0); __builtin_amdgcn_s_waitcnt(0); __builtin_amdgcn_sched_barrier(0);
        if (VAR != 2) { rec_load(RA, p, ((size_t)(b * 64)) * 4 + hd, d0, w, lane); __builtin_amdgcn_sched_barrier(0);
                        rec_load(RB, p, ((size_t)(b * 64 + 1)) * 4 + hd, d0, w, lane); __builtin_amdgcn_sched_barrier(0); }
        *(uint2*)vwr = vreg; vreg = *(const uint2*)(vsrc + (size_t)64 * GLA_NM);
        __syncthreads();
#define REC_STEP(CUR, NXT, c) do {                                                                                                             \
            __builtin_amdgcn_sched_barrier(0);     \
            bf16x8 bv[2][2];                                                                                                                     \
            _Pragma("unroll") for (int n = 0; n < 2; ++n) _Pragma("unroll") for (int ks = 0; ks < 2; ++ks) { s16x4 lo_, hi_; const unsigned a_ = vrd + (unsigned)(((c) & 1) * REC_VBUF + 32 * ks * REC_VS + 32 * n); \
                asm volatile("ds_read_b64_tr_b16 %0, %1" : "=&v"(lo_) : "v"(a_) : "memory");                                                       \
                asm volatile("ds_read_b64_tr_b16 %0, %1 offset:%2" : "=&v"(hi_) : "v"(a_), "i"(4 * REC_VS) : "memory");                               \
                asm volatile("s_waitcnt lgkmcnt(0)" ::: "memory");                                                                                 \
                const uint2 l2_ = __builtin_bit_cast(uint2, lo_), h2_ = __builtin_bit_cast(uint2, hi_);                                             \
                bv[n][ks] = __builtin_bit_cast(bf16x8, ((u32x4){l2_.x, l2_.y, h2_.x, h2_.y})); }                                                     \
            f32x4 acc[4][2];                                                                                                                     \
            { bf16x8 bs[2];                                                                                                                      \
              _Pragma("unroll") for (int n = 0; n < 2; ++n) { u32x4 sw; sw.x = cvtpk(S[0][n][0], S[0][n][1]); sw.y = cvtpk(S[0][n][2], S[0][n][3]);     \
                  sw.z = cvtpk(S[1][n][0], S[1][n][1]); sw.w = cvtpk(S[1][n][2], S[1][n][3]); bs[n] = __builtin_bit_cast(bf16x8, sw); }              \
              _Pragma("unroll") for (int mt = 0; mt < 4; ++mt) _Pragma("unroll") for (int n = 0; n < 2; ++n) acc[mt][n] = MFMA16(CUR.aq[mt], bs[n], ((f32x4){0.f, 0.f, 0.f, 0.f})); } \
            const int mp = w >> 1, np = w & 1;                                                                                                   \
            f32x4 accp = MFMA16(CUR.ap[0], (np ? bv[1][0] : bv[0][0]), ((f32x4){0.f, 0.f, 0.f, 0.f}));                                     \
            accp = MFMA16(CUR.ap[1], (np ? bv[1][1] : bv[0][1]), accp);                                                                   \
            __builtin_amdgcn_sched_barrier(0);                                                                                                   \
            if (VAR != 2) rec_load_a(CUR, p, ((size_t)(b * 64 + ((c) + 2 < 64 ? (c) + 2 : 63))) * 4 + hd, w, lane);     \
            __builtin_amdgcn_sched_barrier(0);                                                                                                   \
            if (VAR != 2) { *(uint2*)(vwr + (((c) + 1) & 1) * REC_VBUF) = vreg;     \
                vreg = *(const uint2*)(vsrc + (size_t)((c) + 2 < 64 ? (c) + 2 : 63) * 64 * GLA_NM); }                                                \
            __builtin_amdgcn_sched_barrier(0);                                                                                                   \
            _Pragma("unroll") for (int mt = 0; mt < 4; ++mt) _Pragma("unroll") for (int n = 0; n < 2; ++n) {                                      \
                const f32x4 v_ = (mt == mp && n == np) ? acc[mt][n] + accp : acc[mt][n];                                                          \
                _Pragma("unroll") for (int r_ = 0; r_ < 4; ++r_) red[(w * 64 + 16 * mt + 4 * fq + r_) * REC_LD + 16 * n + fr] = v_[r_]; }            \
            if (VAR != 1) __syncthreads();                                                                                                       \
            { const int t_ = tid >> 3, c4_ = (tid & 7) * 4; f32x4 s_ = *(const f32x4*)(red + t_ * REC_LD + c4_);                                  \
              _Pragma("unroll") for (int ww = 1; ww < 8; ++ww) s_ += *(const f32x4*)(red + (ww * 64 + t_) * REC_LD + c4_);                          \
              *(uint2*)(p.o + (size_t)(b * SEQ + (c) * 64 + t_) * DM + hd * 512 + d0 + c4_) = make_uint2(cvtpk(s_[0], s_[1]), cvtpk(s_[2], s_[3])); }     \
            _Pragma("unroll") for (int i = 0; i < 2; ++i) _Pragma("unroll") for (int n = 0; n < 2; ++n) {                                          \
                S[i][n] = S[i][n] * CUR.dv[i]; S[i][n] = MFMA16(CUR.ak[i][0], bv[n][0], S[i][n]); S[i][n] = MFMA16(CUR.ak[i][1], bv[n][1], S[i][n]); } \
            __builtin_amdgcn_sched_barrier(0);                                                                                                   \
            if (VAR != 2) { const int cn_ = (c) + 2 < 64 ? (c) + 2 : 63; rec_load_b(CUR, p, ((size_t)(b * 64 + cn_)) * 4 + hd, d0, w, lane); }     \
            if (VAR != 1) __syncthreads(); } while (0)
        for (int c = 0; c < 64; c += 2) { REC_STEP(RA, RB, c); REC_STEP(RB, RA, c + 1); }
#undef REC_STEP
    }
}

__device__ __forceinline__ void phase_gla_onorm(int wv, const Params& p, int l) {
    const int tid = ltid(wv), wid = wv, lane = tid & 63;
    const int bid_ = lbid(), ngrid_ = lgrid();
    const float* gn = p.gla_norm + l * 512 + 8 * lane;
    const f32x4 ga = *(const f32x4*)gn, gb = *(const f32x4*)(gn + 4);
    for (int row = bid_ * NWAVE + wid; row < TT; row += ngrid_ * NWAVE) {
        u32x4 ow[4], gw[4];
#pragma unroll
        for (int i = 0; i < 4; ++i) { const int c = 512 * i + 8 * lane; ow[i] = *(const u32x4*)(p.o + (size_t)row * DM + c); gw[i] = *(const u32x4*)(p.proj + (size_t)row * GLA_NM + 4096 + c); }
#pragma unroll
        for (int i = 0; i < 4; ++i) { const int c = 512 * i + 8 * lane;
            float o8[8], g8[8]; unpack8(ow[i], o8); unpack8(gw[i], g8);
            float ss = 0.f;
#pragma unroll
            for (int e = 0; e < 8; ++e) ss = fmaf(o8[e], o8[e], ss);
            ss = wave_sum_shfl(ss, lane);
            const float rs = rsqrtf(ss * (1.f / 512.f) + RMS_EPS);
            float y[8];
#pragma unroll
            for (int e = 0; e < 4; ++e) { y[e] = o8[e] * rs * ga[e] * (g8[e] * __builtin_amdgcn_rcpf(1.f + __expf(-g8[e]))); y[4 + e] = o8[4 + e] * rs * gb[e] * (g8[4 + e] * __builtin_amdgcn_rcpf(1.f + __expf(-g8[4 + e]))); }
            *(u32x4*)(p.og + (size_t)row * DM + c) = pack8f(y); }
    }
}

constexpr int TK_SC = 0;
template <int N> __device__ __forceinline__ void top_insert(float (&L)[N], float v) {
#pragma unroll
    for (int j = N - 1; j >= 1; --j) L[j] = __builtin_amdgcn_fmed3f(L[j - 1], L[j], v);
    L[0] = fmaxf(L[0], v);
}
__device__ __forceinline__ void phase_peer_topk(int wv, const Params& p, int l, unsigned char* lds) {
    const int tid = ltid(wv), wid = wv, lane = tid & 63, fr = lane & 15, fq = lane >> 4;
    const int bid_ = lbid(), ngrid_ = lgrid();
    float* sc = (float*)(lds + TK_SC); unsigned* scu = (unsigned*)(lds + TK_SC);
    const int hd = bid_ & 7, nm = (ngrid_ - hd + 7) >> 3, pp = wid >> 2, mq = wid & 3;
    bf16x8 bfr[8][4];
    { const bf16_t* bp = p.subk + ((size_t)((l * 8 + hd) * 2 + pp) * 128 + fr) * 128 + 8 * fq;
#pragma unroll
      for (int nt = 0; nt < 8; ++nt)
#pragma unroll
          for (int ks = 0; ks < 4; ++ks) bfr[nt][ks] = *(const bf16x8*)(bp + (size_t)nt * 16 * 128 + 32 * ks); }
    for (int tile = bid_ >> 3; tile < TT / 128; tile += nm) {
        const int tok0 = tile * 128;
        { const bf16_t* ap = p.pq + (size_t)(tok0 + 32 * mq + fr) * DM + hd * 256 + pp * 128 + 8 * fq;
          bf16x8 a[2][4];
#pragma unroll
          for (int m = 0; m < 2; ++m)
#pragma unroll
              for (int ks = 0; ks < 4; ++ks) a[m][ks] = *(const bf16x8*)(ap + (size_t)m * 16 * DM + 32 * ks);
#pragma unroll
          for (int m = 0; m < 2; ++m)
#pragma unroll
              for (int nt = 0; nt < 8; ++nt) { f32x4 acc = (f32x4){0.f, 0.f, 0.f, 0.f};
#pragma unroll
                  for (int ks = 0; ks < 4; ++ks) acc = MFMA16(a[m][ks], bfr[nt][ks], acc);
#pragma unroll
                  for (int i = 0; i < 4; ++i) sc[(pp * 128 + 32 * mq + 16 * m + 4 * fq + i) * 129 + 16 * nt + fr] = acc[i]; } }
        __syncthreads();
        { const int q = tid >> 1, half = tid & 1; const float* sp = sc + q * 129 + 64 * half;
          float L[16];
#pragma unroll
          for (int j = 0; j < 16; ++j) L[j] = -3.0e38f;
#pragma unroll
          for (int n = 0; n < 16; ++n) { const float v = __uint_as_float((__float_as_uint(sp[n]) & ~127u) | (unsigned)(64 * half + n));
#pragma unroll
              for (int j = 15; j >= 1; --j) if (j <= n) L[j] = __builtin_amdgcn_fmed3f(L[j - 1], L[j], v);
              L[0] = fmaxf(L[0], v); }
#pragma unroll 8
          for (int n = 16; n < 64; ++n) { const float v = __uint_as_float((__float_as_uint(sp[n]) & ~127u) | (unsigned)(64 * half + n)); top_insert<16>(L, v); }
#pragma unroll
          for (int j = 0; j < 16; ++j) scu[q * 129 + 64 * half + j] = __float_as_uint(L[j]); }
        __syncthreads();
        if (tid < 256) { const int q = tid; float M[16];
#pragma unroll
            for (int j = 0; j < 16; ++j) M[j] = fmaxf(sc[q * 129 + j], sc[q * 129 + 64 + 15 - j]);
#pragma unroll
            for (int d = 8; d >= 1; d >>= 1)
#pragma unroll
                for (int i = 0; i < 16; ++i) if ((i & d) == 0) { const float hi = fmaxf(M[i], M[i + d]), lo = fminf(M[i], M[i + d]); M[i] = hi; M[i + d] = lo; }
#pragma unroll
            for (int j = 0; j < 16; ++j) sc[q * 129 + j] = M[j]; }
        __syncthreads();
        if (tid < 128) { const int t = tid; const unsigned* ta = scu + t * 129; const unsigned* tb = scu + (128 + t) * 129;
            float a[16], b[16], M[16];
#pragma unroll
            for (int j = 0; j < 16; ++j) { a[j] = __uint_as_float(ta[j]); b[j] = __uint_as_float(tb[j]); M[j] = -3.0e38f; }
            int cnt = 0;
#pragma unroll
            for (int i = 0; i < 16; ++i)
#pragma unroll
                for (int j = 0; j < 16; ++j) if ((i + 1) * (j + 1) <= 16) { const float s = a[i] + b[j]; const float v = __uint_as_float((__float_as_uint(s) & ~255u) | (unsigned)(i * 16 + j));
#pragma unroll
                    for (int q = 15; q >= 1; --q) if (q <= cnt) M[q] = __builtin_amdgcn_fmed3f(M[q - 1], M[q], v);
                    M[0] = fmaxf(M[0], v); ++cnt; }
            float e[16], sum = 0.f;
#pragma unroll
            for (int r = 0; r < 16; ++r) { e[r] = __expf(M[r] - M[0]); sum += e[r]; }
            const float inv = 1.f / sum;
            unsigned idp[8];
#pragma unroll
            for (int r = 0; r < 16; ++r) { const unsigned code = __float_as_uint(M[r]) & 255u; const unsigned ia = ta[code >> 4] & 127u, ib = tb[code & 15u] & 127u, id = ia * 128u + ib;
                if (r & 1) idp[r >> 1] |= id << 16; else idp[r >> 1] = id; e[r] *= inv; }
            { unsigned short* ip = (unsigned short*)p.ids + (size_t)(tok0 + t) * 128 + hd * 16; float* wp = p.wts + (size_t)(tok0 + t) * 128 + hd * 16;
              *(u32x4*)ip = (u32x4){idp[0], idp[1], idp[2], idp[3]}; *(u32x4*)(ip + 8) = (u32x4){idp[4], idp[5], idp[6], idp[7]};
#pragma unroll
              for (int q = 0; q < 4; ++q) *(f32x4*)(wp + 4 * q) = (f32x4){e[4 * q], e[4 * q + 1], e[4 * q + 2], e[4 * q + 3]}; } }
        __syncthreads();
    }
}

__device__ __forceinline__ float ub0(unsigned w) { return (float)(w & 0xffu); }
__device__ __forceinline__ float ub1(unsigned w) { return (float)((w >> 8) & 0xffu); }
__device__ __forceinline__ float ub2(unsigned w) { return (float)((w >> 16) & 0xffu); }
__device__ __forceinline__ float ub3(unsigned w) { return (float)(w >> 24); }
__device__ __forceinline__ float row16_sum(float v) { v += dpp_f<0xB1>(v); v += dpp_f<0x4E>(v); v += dpp_f<0x141>(v); v += dpp_f<0x128>(v); return v; }
#define G_IDS(idr) u32x4 idw = (u32x4){0u, 0u, 0u, 0u}; if (c < 4) idw = *(const u32x4*)((idr) + 8 * c)
#define G_LOADB(R, T, bb) do { const unsigned ix_ = (unsigned)dpp_i<0x150 + (bb)>((int)idw.x), iy_ = (unsigned)dpp_i<0x150 + (bb)>((int)idw.y), iz_ = (unsigned)dpp_i<0x150 + (bb)>((int)idw.z), iw_ = (unsigned)dpp_i<0x150 + (bb)>((int)idw.w); \
            R[0] = *(const u32x4*)((T) + ((ix_ & 0xffffu) * (unsigned)DM + lo)); R[1] = *(const u32x4*)((T) + ((ix_ >> 16) * (unsigned)DM + lo)); R[2] = *(const u32x4*)((T) + ((iy_ & 0xffffu) * (unsigned)DM + lo)); R[3] = *(const u32x4*)((T) + ((iy_ >> 16) * (unsigned)DM + lo)); \
            R[4] = *(const u32x4*)((T) + ((iz_ & 0xffffu) * (unsigned)DM + lo)); R[5] = *(const u32x4*)((T) + ((iz_ >> 16) * (unsigned)DM + lo)); R[6] = *(const u32x4*)((T) + ((iw_ & 0xffffu) * (unsigned)DM + lo)); R[7] = *(const u32x4*)((T) + ((iw_ >> 16) * (unsigned)DM + lo)); } while (0)
__device__ __forceinline__ void phase_peer_gather1(int wv, const Params& p, int l) {
    const int tid = ltid(wv), lane = tid & 63, j = lane >> 4, c = lane & 15;
    const int bid_ = lbid(), ngrid_ = lgrid();
    const int r = bid_ & 7, m = bid_ >> 3, nm = (ngrid_ - r + 7) >> 3;
    const unsigned char* Ub = p.U8 + (size_t)l * 16384 * DM + 256 * r; const unsigned lo = 16u * (unsigned)c;
    bf16_t* ap = (bf16_t*)p.apart + (size_t)r * TT * 128;
    for (int tok = m * NWAVE + wv; tok < TT; tok += nm * NWAVE) {
        float hf[16];
        { const bf16_t* hp = p.h2 + (size_t)tok * DM + 256 * r + 16 * c; float t8[8];
          unpack8(*(const u32x4*)hp, t8);
#pragma unroll
          for (int e = 0; e < 8; ++e) hf[e] = t8[e];
          unpack8(*(const u32x4*)(hp + 8), t8);
#pragma unroll
          for (int e = 0; e < 8; ++e) hf[8 + e] = t8[e]; }
        float am = 0.f;
#pragma unroll
        for (int e = 0; e < 16; ++e) am = fmaxf(am, fabsf(hf[e]));
        am = fmaxf(am, dpp_f<0xB1>(am)); am = fmaxf(am, dpp_f<0x4E>(am)); am = fmaxf(am, dpp_f<0x141>(am)); am = fmaxf(am, dpp_f<0x128>(am));
        const float sh = fmaxf(am, 1e-30f) * (1.f / 127.f), ish = 1.f / sh;
        int hq[4];
#pragma unroll
        for (int q = 0; q < 4; ++q) hq[q] = ((int)rintf(hf[4 * q] * ish) & 0xff) | (((int)rintf(hf[4 * q + 1] * ish) & 0xff) << 8) | (((int)rintf(hf[4 * q + 2] * ish) & 0xff) << 16) | ((int)rintf(hf[4 * q + 3] * ish) << 24);
        G_IDS((const unsigned short*)p.ids + (size_t)tok * 128 + 32 * j);
        int keep0 = 0, keep1 = 0;
        u32x4 RA[8], RB[8];
#define G_COMP1(R, bb) do { _Pragma("unroll") for (int i = 0; i < 8; ++i) { int d_ = __builtin_amdgcn_sdot4((int)R[i][0], hq[0], 0, false);              \
                d_ = __builtin_amdgcn_sdot4((int)R[i][1], hq[1], d_, false); d_ = __builtin_amdgcn_sdot4((int)R[i][2], hq[2], d_, false); d_ = __builtin_amdgcn_sdot4((int)R[i][3], hq[3], d_, false); \
                d_ += dpp_i<0xB1>(d_); d_ += dpp_i<0x4E>(d_); d_ += dpp_i<0x141>(d_); d_ += dpp_i<0x128>(d_);                                        \
                const int q_ = 8 * (bb) + i;                                                                                                      \
                if ((q_ & 1) == 0) keep0 = (c == (q_ >> 1)) ? d_ : keep0; else keep1 = (c == (q_ >> 1)) ? d_ : keep1; } } while (0)
        G_LOADB(RA, Ub, 0); G_LOADB(RB, Ub, 1); G_COMP1(RA, 0); G_LOADB(RA, Ub, 2); G_COMP1(RB, 1); G_LOADB(RB, Ub, 3); G_COMP1(RA, 2); G_COMP1(RB, 3);
#undef G_COMP1
        *(unsigned*)(ap + (size_t)tok * 128 + 32 * j + 2 * c) = cvtpk((float)keep0 * sh, (float)keep1 * sh);
    }
}
__device__ __forceinline__ void phase_peer_coef(int wv, const Params& p, int l) {
    const int tid = ltid(wv), lane = tid & 63;
    const int bid_ = lbid(), ngrid_ = lgrid();
    const float* su = p.su + (size_t)l * 16384; const float* sv = p.sv + (size_t)l * 16384;
    for (int t0 = (bid_ * NWAVE + wv) * 4; t0 < TT; t0 += ngrid_ * NWAVE * 4) {
        unsigned idw[4]; float w0[4], w1[4], a0[4], a1[4];
#pragma unroll
        for (int i = 0; i < 4; ++i) { const size_t tk = (size_t)(t0 + i) * 128 + 2 * lane; idw[i] = *(const unsigned*)((const unsigned short*)p.ids + tk); const float2 ww = *(const float2*)(p.wts + tk); w0[i] = ww.x; w1[i] = ww.y; a0[i] = 0.f; a1[i] = 0.f; }
#pragma unroll
        for (int rr = 0; rr < 8; ++rr)
#pragma unroll
            for (int i = 0; i < 4; ++i) { const unsigned qq = *(const unsigned*)((const bf16_t*)p.apart + ((size_t)rr * TT + t0 + i) * 128 + 2 * lane); a0[i] += __uint_as_float(qq << 16); a1[i] += __uint_as_float(qq & 0xffff0000u); }
        float u0[4], u1[4], v0[4], v1[4];
#pragma unroll
        for (int i = 0; i < 4; ++i) { const unsigned e0 = idw[i] & 0xffffu, e1 = idw[i] >> 16; u0[i] = su[e0]; u1[i] = su[e1]; v0[i] = sv[e0]; v1[i] = sv[e1]; }
#pragma unroll
        for (int i = 0; i < 4; ++i) { const int tok = t0 + i;
            const float c0 = w0[i] * gelu_tanh(a0[i] * u0[i]) * v0[i], c1 = w1[i] * gelu_tanh(a1[i] * u1[i]) * v1[i];
            float cm = fmaxf(fabsf(c0), fabsf(c1));
            cm = fmaxf(cm, dpp_f<0xB1>(cm)); cm = fmaxf(cm, dpp_f<0x4E>(cm)); cm = fmaxf(cm, dpp_f<0x141>(cm)); cm = fmaxf(cm, dpp_f<0x128>(cm));
            cm = fmaxf(fmaxf(rdlane(cm, 0), rdlane(cm, 16)), fmaxf(rdlane(cm, 32), rdlane(cm, 48)));
            const float sc = fmaxf(cm, 1e-30f) * (1.f / 127.f), isc = 1.f / sc;
            *(unsigned short*)(p.cqbuf + (size_t)tok * 128 + 2 * lane) = (unsigned short)(((int)rintf(c0 * isc) & 0xff) | (((int)rintf(c1 * isc) & 0xff) << 8));
            if (lane == 0) p.scbuf[tok] = sc; }
    }
}
__device__ __forceinline__ void phase_peer_gather2(int wv, const Params& p, int l, const float* gate  ) {
    const int tid = ltid(wv), lane = tid & 63, j = lane >> 4, c = lane & 15;
    const int bid_ = lbid(), ngrid_ = lgrid();
    const int r = bid_ & 7, m = bid_ >> 3, nm = (ngrid_ - r + 7) >> 3;
    const unsigned char* Vb = p.V8 + (size_t)l * 16384 * DM + 256 * r; const unsigned lo = 16u * (unsigned)c;
    for (int tok = m * NWAVE + wv; tok < TT; tok += nm * NWAVE) {
        const float sc = p.scbuf[tok];
        bf16_t* xp = p.xbuf + (size_t)tok * DM + 256 * r + 16 * c; const float* gp = gate + (size_t)(tok >> 12) * 12288 + 256 * r + 16 * c;
        f32x4 ga[4] = {}; u32x4 xw0 = (u32x4){0u, 0u, 0u, 0u}, xw1 = (u32x4){0u, 0u, 0u, 0u};
        if (j == 0) { xw0 = *(const u32x4*)xp; xw1 = *(const u32x4*)(xp + 8);
#pragma unroll
            for (int q = 0; q < 4; ++q) ga[q] = *(const f32x4*)(gp + 4 * q); }
        G_IDS((const unsigned short*)p.ids + (size_t)tok * 128 + 32 * j);
        int4 cqv = make_int4(0, 0, 0, 0); if (c < 2) cqv = *(const int4*)(p.cqbuf + (size_t)tok * 128 + 32 * j + 16 * c);
        const int cqw[8] = {dpp_i<0x150>(cqv.x), dpp_i<0x150>(cqv.y), dpp_i<0x150>(cqv.z), dpp_i<0x150>(cqv.w), dpp_i<0x151>(cqv.x), dpp_i<0x151>(cqv.y), dpp_i<0x151>(cqv.z), dpp_i<0x151>(cqv.w)};
        int yi[16];
#pragma unroll
        for (int e = 0; e < 16; ++e) yi[e] = 0;
        u32x4 RA[8], RB[8];
#define G_COMP2(R, bb) do { _Pragma("unroll") for (int g = 0; g < 2; ++g) { const int cq_ = cqw[2 * (bb) + g];                                            \
                _Pragma("unroll") for (int d = 0; d < 4; ++d) { const unsigned W0 = R[4 * g][d], W1 = R[4 * g + 1][d], W2 = R[4 * g + 2][d], W3 = R[4 * g + 3][d];       \
                    const unsigned A_ = __builtin_amdgcn_perm(W1, W0, 0x05010400u), B_ = __builtin_amdgcn_perm(W1, W0, 0x07030602u);                  \
                    const unsigned C_ = __builtin_amdgcn_perm(W3, W2, 0x05010400u), D_ = __builtin_amdgcn_perm(W3, W2, 0x07030602u);                  \
                    yi[4 * d + 0] = __builtin_amdgcn_sdot4((int)__builtin_amdgcn_perm(C_, A_, 0x05040100u), cq_, yi[4 * d + 0], false);                 \
                    yi[4 * d + 1] = __builtin_amdgcn_sdot4((int)__builtin_amdgcn_perm(C_, A_, 0x07060302u), cq_, yi[4 * d + 1], false);                 \
                    yi[4 * d + 2] = __builtin_amdgcn_sdot4((int)__builtin_amdgcn_perm(D_, B_, 0x05040100u), cq_, yi[4 * d + 2], false);                 \
                    yi[4 * d + 3] = __builtin_amdgcn_sdot4((int)__builtin_amdgcn_perm(D_, B_, 0x07060302u), cq_, yi[4 * d + 3], false); } } } while (0)
        G_LOADB(RA, Vb, 0); G_LOADB(RB, Vb, 1); G_COMP2(RA, 0); G_LOADB(RA, Vb, 2); G_COMP2(RB, 1); G_LOADB(RB, Vb, 3); G_COMP2(RA, 2); G_COMP2(RB, 3);
#undef G_COMP2
        float y[16];
#pragma unroll
        for (int e = 0; e < 16; ++e) { int v = yi[e]; v += __builtin_amdgcn_ds_bpermute((lane ^ 16) << 2, v); v += __builtin_amdgcn_ds_bpermute((lane ^ 32) << 2, v); y[e] = (float)v * sc; }
        if (j == 0) { float x0[8], x1[8]; unpack8(xw0, x0); unpack8(xw1, x1);
#pragma unroll
            for (int e = 0; e < 8; ++e) { x0[e] += ga[e >> 2][e & 3] * y[e]; x1[e] += ga[2 + (e >> 2)][e & 3] * y[8 + e]; }
            *(u32x4*)xp = pack8f(x0); *(u32x4*)(xp + 8) = pack8f(x1); }
    }
}
#undef G_LOADB
#undef G_IDS

__device__ __forceinline__ void phase_fl(int wv, const Params& p, unsigned char* lds) {
    const int tid = ltid(wv); float* gls = (float*)lds;
    const int bid_ = lbid(), ngrid_ = lgrid();
    for (int u = bid_; u < 256; u += ngrid_) {
        mini16(wv, p.hk + (size_t)u * 64 * DM, p.W16_kv, gls);
        __syncthreads();
#pragma unroll
        for (int i = 0; i < 2; ++i) { const int o = tid + NTHR * i; p.fl[(size_t)u * 1024 + o] = gls[o] + gls[1024 + o]; }
        __syncthreads();
    }
}
__device__ __forceinline__ void phase_fscan(int wv, const Params& p, unsigned char* lds) {
    const int tid = ltid(wv), lane = tid & 63;
    const int bid_ = lbid(), ngrid_ = lgrid();
    float* red = (float*)lds;
    for (int u = bid_; u < 64; u += ngrid_) {
        const int b = u >> 4, hd = u & 15; const float bf = p.fox_b_f[hd];
        const float* fp = p.fl + ((size_t)b * SEQ + 8 * tid) * 16 + hd;
        float x[8], v[8], tot = 0.f;
#pragma unroll
        for (int i = 0; i < 8; ++i) x[i] = fp[(size_t)i * 16];
#pragma unroll
        for (int i = 0; i < 8; ++i) { v[i] = log_sigmoidf(x[i] + bf); tot += v[i]; }
        float incl = tot;
#pragma unroll
        for (int d = 1; d < 64; d <<= 1) { const float n = shfl_idx(incl, (lane - d) & 63); if (lane >= d) incl += n; }
        __syncthreads();
        if (lane == 63) red[wv] = incl;
        __syncthreads();
        float run = incl - tot;
#pragma unroll
        for (int w = 0; w < NWAVE - 1; ++w) run += (w < wv) ? red[w] : 0.f;
        float o[8];
#pragma unroll
        for (int i = 0; i < 8; ++i) { run += v[i]; o[i] = run * (-11.313708498984761f); }
        float* op = p.Fa + (size_t)u * SEQ + 8 * tid;
        *(f32x4*)op = (f32x4){o[0], o[1], o[2], o[3]}; *(f32x4*)(op + 4) = (f32x4){o[4], o[5], o[6], o[7]};
    }
}
__device__ __forceinline__ float slab_max_norm2(int wv, const bf16_t* slab, float* red) {
    const int tid = ltid(wv), lane = tid & 63;
    const bf16_t* rp = slab + (size_t)(tid >> 4) * DM + (tid & 15) * 8;
    u32x4 w[8];
#pragma unroll
    for (int i = 0; i < 8; ++i) w[i] = *(const u32x4*)(rp + (size_t)i * 32 * DM);
    float m = 0.f;
#pragma unroll
    for (int i = 0; i < 8; ++i) { float v8[8]; unpack8(w[i], v8); float ss = 0.f;
#pragma unroll
        for (int e = 0; e < 8; ++e) ss = fmaf(v8[e], v8[e], ss);
        m = fmaxf(m, row16_sum(ss)); }
    m = fmaxf(fmaxf(rdlane(m, 0), rdlane(m, 16)), fmaxf(rdlane(m, 32), rdlane(m, 48)));
    __syncthreads();
    if (lane == 0) red[wv] = m;
    __syncthreads();
    float r = red[0];
#pragma unroll
    for (int w_ = 1; w_ < 8; ++w_) r = fmaxf(r, red[w_]);
    return r;
}
__device__ __forceinline__ void phase_knorm(int wv, const Params& p, unsigned char* lds) {
    const int tid = ltid(wv); const int bid_ = lbid(), ngrid_ = lgrid();
    for (int u = bid_; u < 1024; u += ngrid_) { const int bh = u >> 4, qb = u & 15;
        const float r = slab_max_norm2(wv, p.Kb + ((size_t)(bh >> 4) * SEQ + (size_t)qb * 256) * DM + (bh & 15) * 128, (float*)lds);
        if (tid == 0) p.kn2[u] = r; }
}
__device__ __forceinline__ void phase_qn(int wv, const Params& p, unsigned char* lds) {
    const int tid = ltid(wv), lane = tid & 63; const int bid_ = lbid(), ngrid_ = lgrid();
    for (int u = bid_; u < 1024; u += ngrid_) { const int bh = u >> 4, qb = u & 15, P0 = qb * 256;
        const float qn2 = slab_max_norm2(wv, p.qb + ((size_t)(bh >> 4) * SEQ + (size_t)P0) * DM + (bh & 15) * 128, (float*)lds);
        if (wv == 0) {
            float k2 = (lane <= qb) ? p.kn2[bh * 16 + lane] : 0.f;
            k2 = fmaxf(k2, dpp_f<0xB1>(k2)); k2 = fmaxf(k2, dpp_f<0x4E>(k2)); k2 = fmaxf(k2, dpp_f<0x141>(k2)); k2 = fmaxf(k2, dpp_f<0x128>(k2));
            k2 = rdlane(k2, 0);
            const float D = 2.02f * sqrtf(qn2 * k2) + 30.f * 11.313708498984761f;
            const float* Fb = p.Fa + (size_t)bh * SEQ; const float ref = Fb[P0] - D;
            const int e = 64 * lane + 63; const bool skip = (e < P0) && (Fb[e] < ref);
            const unsigned long long bal = __ballot(skip);
            const int j = (int)__builtin_ctzll(~bal);
            if (lane == 0) p.jlo[u] = j; }
    }
}
__device__ __forceinline__ void phase_fox_gate(int wv, const Params& p) {
    const int tid = ltid(wv); const int bid_ = lbid(), ngrid_ = lgrid();
    const size_t stride = (size_t)ngrid_ * NTHR * 8;
    for (size_t e0 = ((size_t)bid_ * NTHR + tid) * 8; e0 < (size_t)TT * DM; e0 += 4 * stride) {
        u32x4 ow[4], gw[4];
#pragma unroll
        for (int i = 0; i < 4; ++i) { const size_t e = e0 + i * stride; ow[i] = *(const u32x4*)(p.ob + e); gw[i] = *(const u32x4*)(p.gb + e); }
#pragma unroll
        for (int i = 0; i < 4; ++i) { float o8[8], g8[8], y[8]; unpack8(ow[i], o8); unpack8(gw[i], g8);
#pragma unroll
            for (int j = 0; j < 8; ++j) y[j] = o8[j] * sigmoidf_(g8[j]);
            *(u32x4*)(p.og + e0 + i * stride) = pack8f(y); }
    }
}

namespace fa {
constexpr int D = 128, RS = 2048;
constexpr float SCALE = 0.08838834764831845f, THR = 16.f;
constexpr int NW = 8, QBLK = 32, KVBLK = 64, QB = NW * QBLK;
constexpr int SHM_V = KVBLK * D * 2, SHM_K = KVBLK * D * 2, SHM_A = KVBLK * 4;
constexpr int OFF_K = 2 * SHM_V, OFF_WS = 2 * SHM_V + 2 * SHM_K, OFF_A = OFF_WS + NW * 64 * 4, LDS_BYTES = OFF_A + 2 * SHM_A;
#define KSWZ(row, colB) ((row) * 256 + ((colB) ^ (((row) & 7) << 4)))
#define SBAR() __builtin_amdgcn_sched_barrier(0)
__device__ __forceinline__ int v_st(int k, int c) { const int kk = (k & ~0xC) | ((k & 4) << 1) | ((k & 8) >> 1); return ((kk >> 3) * 4 + (c >> 5)) * 512 + ((kk & 7) * 32 + (c & 31)) * 2; }
__device__ __forceinline__ int v_rd_base(int lane) { return ((lane & 3) << 3) | (((lane >> 2) & 3) << 6) | (((lane >> 4) & 1) << 5) | (((lane >> 5) & 1) << 8); }
constexpr int v_rd_off(int d0, int ks, int half) { return d0 * 512 + ks * 4096 + half * 2048; }
__device__ __forceinline__ int crow(int r, int hi) { return (r & 3) + 8 * (r >> 2) + 4 * hi; }
__device__ __forceinline__ unsigned cvtpkv(float lo, float hi) { unsigned r; asm volatile("v_cvt_pk_bf16_f32 %0, %1, %2" : "=v"(r) : "v"(lo), "v"(hi)); return r; }
__device__ __forceinline__ bf16x8 load8(const bf16_t* p) { return *reinterpret_cast<const bf16x8*>(p); }
__device__ __forceinline__ void mask_tile(f32x16& p0, f32x16& p1, int dq) {
    const float NEG = -__builtin_inff();
#pragma unroll
    for (int r = 0; r < 16; ++r) { const int c = (r & 3) + 8 * (r >> 2); if (dq - c < 0) p0[r] = NEG; if (dq - c - 32 < 0) p1[r] = NEG; }
}
__device__ __forceinline__ void partialSM(f32x16& p0, f32x16& p1, float& m_reg, float& mn, float& alpha) {
    float pmax = p0[0]; for (int r = 1; r < 16; ++r) pmax = fmaxf(pmax, p0[r]); for (int r = 0; r < 16; ++r) pmax = fmaxf(pmax, p1[r]);
    { auto rr = __builtin_amdgcn_permlane32_swap(__float_as_uint(pmax), __float_as_uint(pmax), false, false);
      pmax = fmaxf(__uint_as_float(rr[0]), __uint_as_float(rr[1])); }
    constexpr float C2 = 1.4426950408889634f * SCALE;
    if (__builtin_expect(__all((pmax - m_reg) * SCALE <= THR), 1)) { mn = m_reg; alpha = 1.f; }
    else { mn = fmaxf(m_reg, pmax); alpha = __builtin_amdgcn_exp2f((m_reg - mn) * C2); m_reg = mn; }
    const float mnL = -mn * C2;
    for (int r = 0; r < 16; ++r) p0[r] = fmaf(p0[r], C2, mnL); for (int r = 0; r < 16; ++r) p1[r] = fmaf(p1[r], C2, mnL);
    for (int r = 0; r < 16; ++r) p0[r] = __builtin_amdgcn_exp2f(p0[r]);
}
__device__ __forceinline__ void finishSM(f32x16& p0, f32x16& p1, float alpha, float& l_reg, bf16x8& pa0, bf16x8& pa1, bf16x8& pa2, bf16x8& pa3) {
    for (int r = 0; r < 16; ++r) p1[r] = __builtin_amdgcn_exp2f(p1[r]);
    float ps = 0; for (int r = 0; r < 16; ++r) ps += p0[r]; for (int r = 0; r < 16; ++r) ps += p1[r];
    { auto rr = __builtin_amdgcn_permlane32_swap(__float_as_uint(ps), __float_as_uint(ps), false, false);
      ps = __uint_as_float(rr[0]) + __uint_as_float(rr[1]); }
    l_reg = l_reg * alpha + ps;
#define PK4(P, B_, OUT) do { unsigned a0 = cvtpkv(P[B_+0], P[B_+1]), a1 = cvtpkv(P[B_+2], P[B_+3]);                          \
        unsigned b0 = cvtpkv(P[B_+4], P[B_+5]), b1 = cvtpkv(P[B_+6], P[B_+7]);                                             \
        auto r0 = __builtin_amdgcn_permlane32_swap(a0, b0, false, false); auto r1 = __builtin_amdgcn_permlane32_swap(a1, b1, false, false); \
        u32x4 w = {r0[0], r1[0], r0[1], r1[1]}; OUT = *reinterpret_cast<bf16x8*>(&w); } while (0)
    PK4(p0, 0, pa0); PK4(p0, 8, pa1); PK4(p1, 0, pa2); PK4(p1, 8, pa3);
#undef PK4
}
template <int KB>
__device__ __forceinline__ void qkt(f32x16& p0, f32x16& p1, const char* K_lds, int r32, int hi, const bf16x8* qr) {
    p0 = f32x16{}; p1 = f32x16{};
    const char* kb[4];
#pragma unroll
    for (int dd = 0; dd < 4; ++dd) kb[dd] = K_lds + KB * SHM_K + KSWZ(r32, (dd * 16 + hi * 8) * 2);
#pragma unroll
    for (int d0 = 0; d0 < 8; ++d0) { const char* a = kb[d0 & 3] + (d0 >> 2) * 128;
        bf16x8 b0 = *reinterpret_cast<const bf16x8*>(a);
        bf16x8 b1 = *reinterpret_cast<const bf16x8*>(a + 32 * 256);
        p0 = __builtin_amdgcn_mfma_f32_32x32x16_bf16(b0, qr[d0], p0, 0, 0, 0);
        p1 = __builtin_amdgcn_mfma_f32_32x32x16_bf16(b1, qr[d0], p1, 0, 0, 0); }
}
template <int VB>
__device__ __forceinline__ void pv_tile(f32x16* o, int vb0, bf16x8 pa0, bf16x8 pa1, bf16x8 pa2, bf16x8 pa3) {
#define TRRD(dst, off) asm volatile("ds_read_b64_tr_b16 %0, %1 offset:%2" : "=&v"(dst) : "v"(vb0), "i"(off) : "memory")
#define PV_D0(d0) do { constexpr int b_ = VB * SHM_V + v_rd_off(d0, 0, 0); \
        { s16x4 l0, l1, h0, h1; TRRD(l0, b_); TRRD(h0, b_ + 2048); TRRD(l1, b_ + 4096); TRRD(h1, b_ + 6144); \
          asm volatile("s_waitcnt lgkmcnt(0)" ::: "memory"); SBAR();   \
          o[d0] = __builtin_amdgcn_mfma_f32_32x32x16_bf16(pa0, (bf16x8){l0[0], l0[1], l0[2], l0[3], h0[0], h0[1], h0[2], h0[3]}, o[d0], 0, 0, 0);   \
          o[d0] = __builtin_amdgcn_mfma_f32_32x32x16_bf16(pa1, (bf16x8){l1[0], l1[1], l1[2], l1[3], h1[0], h1[1], h1[2], h1[3]}, o[d0], 0, 0, 0); } \
        { s16x4 l2, l3, h2, h3; TRRD(l2, b_ + 8192); TRRD(h2, b_ + 10240); TRRD(l3, b_ + 12288); TRRD(h3, b_ + 14336); \
          asm volatile("s_waitcnt lgkmcnt(0)" ::: "memory"); SBAR();   \
          o[d0] = __builtin_amdgcn_mfma_f32_32x32x16_bf16(pa2, (bf16x8){l2[0], l2[1], l2[2], l2[3], h2[0], h2[1], h2[2], h2[3]}, o[d0], 0, 0, 0);   \
          o[d0] = __builtin_amdgcn_mfma_f32_32x32x16_bf16(pa3, (bf16x8){l3[0], l3[1], l3[2], l3[3], h3[0], h3[1], h3[2], h3[3]}, o[d0], 0, 0, 0); } } while (0)
    PV_D0(0); PV_D0(1); PV_D0(2); PV_D0(3);
#undef PV_D0
#undef TRRD
}
struct Ptrs { const bf16_t* qb; const bf16_t* Kb; const bf16_t* Vb; const float* Fa; bf16_t* ob; const bf16_t* gb; };
struct BlockRef { unsigned qo, ko, fo; int P0; };
struct Seam { bf16x8 qr[8]; bf16x8 st_v0, st_v1, st_k0, st_k1; };
#define VMW() asm volatile("s_waitcnt vmcnt(0)" ::: "memory")
#define VMWN(n) asm volatile("s_waitcnt vmcnt(%0)" :: "i"(n) : "memory")
#define SLOAD_H(Kp, Vp, k0) do { const bf16_t* kt_ = (Kp) + (size_t)(k0) * RS; const bf16_t* vt_ = (Vp) + (size_t)(k0) * RS;                       \
        S.st_v0 = load8(vt_ + svo); S.st_v1 = load8(vt_ + 32 * RS + svo); S.st_k0 = load8(kt_ + svo); S.st_k1 = load8(kt_ + 32 * RS + svo); } while (0)
#define ALOAD(Fp, k0, bf) do { if (wid == 0) __builtin_amdgcn_global_load_lds((const unsigned*)((Fp) + (size_t)((k0) + lane)), (LAS unsigned*)(ldsl + OFF_A + (bf) * SHM_A), 4, 0, 0); } while (0)
#define SWRITE_HK(bf) do { *(bf16x8*)(K_lds + (bf) * SHM_K + kws) = S.st_k0; *(bf16x8*)(K_lds + (bf) * SHM_K + kws + 32 * 256) = S.st_k1; } while (0)
#define SWRITE_HV(bf) do { *(bf16x8*)(V_lds + (bf) * SHM_V + vst0) = S.st_v0; *(bf16x8*)(V_lds + (bf) * SHM_V + vst1) = S.st_v1; } while (0)
#define SWRITE_H(bf) do { SWRITE_HV(bf); SWRITE_HK(bf); } while (0)
__device__ __forceinline__ void attn_prime(int wv, const Ptrs& P, const BlockRef& cur, char* lds, LAS unsigned char* ldsl, Seam& S) {
    const int tid = ltid(wv), wid = wv, lane = tid & 63, r32 = lane & 31, hi = lane >> 5;
    const int bid_ = lbid(), ngrid_ = lgrid();
    const int sr = tid >> 4, sc = (tid & 15) * 8, kws = KSWZ(sr, sc * 2); char* K_lds = lds + OFF_K;
    const unsigned svo = (unsigned)(sr * RS + sc), qvo = (unsigned)(r32 * RS + hi * 8);
    { const bf16_t* qw = P.qb + cur.qo + (size_t)(wid * QBLK) * RS;
      for (int d0 = 0; d0 < 8; ++d0) S.qr[d0] = load8(qw + qvo + d0 * 16); }
    SLOAD_H(P.Kb + cur.ko, P.Vb + cur.ko, 0); ALOAD(P.Fa + cur.fo, 0, 0); VMW(); SWRITE_HK(0);
    __syncthreads();
}
__device__ __forceinline__ void attn_block(int wv, const Ptrs& P, const BlockRef& cur, const BlockRef& nxt, char* lds, LAS unsigned char* ldsl, Seam& S) {
    const int tid = ltid(wv), wid = wv, lane = tid & 63, r32 = lane & 31, hi = lane >> 5;
    const int bid_ = lbid(), ngrid_ = lgrid();
    const int NT = (cur.P0 + QB - 1) / KVBLK + 1;
    const int qlo = cur.P0 + wid * QBLK, qm = qlo + r32 - 4 * hi;
    char* V_lds = lds; char* K_lds = lds + OFF_K; const char* A_lds = lds + OFF_A;
    float* ws = (float*)(lds + OFF_WS) + wid * 64; float* li_l = ws, * al_l = ws + 32;
    float m_reg = -1e30f, l_reg = 0; f32x16 o[4] = {};
    const int sr = tid >> 4, sc = (tid & 15) * 8, vst0 = v_st(sr, sc), vst1 = v_st(32 + sr, sc), kws = KSWZ(sr, sc * 2);
    const unsigned svo = (unsigned)(sr * RS + sc), qvo = (unsigned)(r32 * RS + hi * 8);
    const int vb0 = (int)(uintptr_t)V_lds + v_rd_base(lane);
    const bf16_t* Kh = P.Kb + cur.ko; const bf16_t* Vh = P.Vb + cur.ko; const float* Fh = P.Fa + cur.fo;
#define RESC(a) do { if (__any((a) < 1.f)) { if (hi == 0) al_l[r32] = (a); asm volatile("s_waitcnt lgkmcnt(0)" ::: "memory");              \
                     for (int d_ = 0; d_ < 4; ++d_) for (int r = 0; r < 16; ++r) o[d_][r] *= al_l[crow(r, hi)]; } } while (0)
#define KBASE(t) ((t) * KVBLK)
#define ADDB(P0_, P1_, KB) do { const float* bp_ = (const float*)(A_lds + (KB) * SHM_A) + 4 * hi;                                      \
        _Pragma("unroll") for (int q_ = 0; q_ < 4; ++q_) { const f32x4 b0_ = *(const f32x4*)(bp_ + 8 * q_), b1_ = *(const f32x4*)(bp_ + 32 + 8 * q_); \
            _Pragma("unroll") for (int e_ = 0; e_ < 4; ++e_) { P0_[4 * q_ + e_] += b0_[e_]; P1_[4 * q_ + e_] += b1_[e_]; } } } while (0)
#define MASKT(P0_, P1_, t) do { const int kb_ = KBASE(t); if (kb_ + KVBLK - 1 > qlo) mask_tile(P0_, P1_, qm - kb_); } while (0)
    constexpr int NQL = 8;
#define SEAM_K0() do { VMWN(NQL); SWRITE_HK(0); SBAR(); } while (0)
    f32x16 pA0, pA1, pB0, pB1; float mnA, mnB, alA, alB; bf16x8 pa0, pa1, pa2, pa3;
    SWRITE_HV(0); SBAR();
    SLOAD_H(Kh, Vh, KBASE(1)); ALOAD(Fh, KBASE(1), 1);
    SBAR(); qkt<0>(pA0, pA1, K_lds, r32, hi, S.qr);
    ADDB(pA0, pA1, 0); MASKT(pA0, pA1, 0); partialSM(pA0, pA1, m_reg, mnA, alA);
    VMW(); SWRITE_H(1);
    __syncthreads();
#define HALF_STEP(PX0, PX1, mnX, alX, PY0, PY1, alY, t, KB, VB, SB) do {                                                      \
        SBAR(); qkt<KB>(PX0, PX1, K_lds, r32, hi, S.qr);                                                         \
        finishSM(PY0, PY1, alY, l_reg, pa0, pa1, pa2, pa3); SBAR();                                                           \
        if ((t) + 1 < NT) { SLOAD_H(Kh, Vh, KBASE((t) + 1)); ALOAD(Fh, KBASE((t) + 1), SB); SBAR(); }                         \
        pv_tile<VB>(o, vb0, pa0, pa1, pa2, pa3); ADDB(PX0, PX1, KB); MASKT(PX0, PX1, (t)); partialSM(PX0, PX1, m_reg, mnX, alX);                  \
        __syncthreads();                                                                                                      \
        if ((t) + 1 < NT) { VMW(); SWRITE_H(SB); }                                                                            \
        RESC(alX); __syncthreads(); } while (0)
    for (int t = 1; t + 1 < NT; t += 2) {
        HALF_STEP(pB0, pB1, mnB, alB, pA0, pA1, alA, t, 1, 0, 0);
        HALF_STEP(pA0, pA1, mnA, alA, pB0, pB1, alB, t + 1, 0, 1, 1);
    }
    const bool even = (NT & 1) == 0;
    if (even) { SBAR(); qkt<1>(pB0, pB1, K_lds, r32, hi, S.qr); SBAR(); }
    SLOAD_H(P.Kb + nxt.ko, P.Vb + nxt.ko, 0); ALOAD(P.Fa + nxt.fo, 0, 0); SBAR();
    { const bf16_t* qw = P.qb + nxt.qo + (size_t)(wid * QBLK) * RS;
#pragma unroll
      for (int d0 = 0; d0 < 8; ++d0) S.qr[d0] = load8(qw + qvo + d0 * 16); }
    SBAR();
    finishSM(pA0, pA1, alA, l_reg, pa0, pa1, pa2, pa3); SBAR();
    pv_tile<0>(o, vb0, pa0, pa1, pa2, pa3);
    if (even) { ADDB(pB0, pB1, 1); MASKT(pB0, pB1, NT - 1); partialSM(pB0, pB1, m_reg, mnB, alB); __syncthreads(); RESC(alB);
        finishSM(pB0, pB1, alB, l_reg, pa0, pa1, pa2, pa3); SBAR(); pv_tile<1>(o, vb0, pa0, pa1, pa2, pa3); }
    SBAR(); SEAM_K0();
    if (hi == 0) li_l[r32] = l_reg; asm volatile("s_waitcnt lgkmcnt(0)" ::: "memory");
    float rli[16];
#pragma unroll
    for (int r = 0; r < 16; ++r) rli[r] = __builtin_amdgcn_rcpf(li_l[crow(r, hi)]);
    bf16_t* Ow = P.ob + cur.qo + (size_t)(wid * QBLK) * RS;
    const bf16_t* Gw = P.gb + cur.qo + (size_t)(wid * QBLK) * RS;
    const unsigned ovo = (unsigned)(4 * hi * RS + r32);
    unsigned short gq[16][4];
#pragma unroll
    for (int r = 0; r < 16; ++r) { const bf16_t* growp = Gw + (size_t)((r & 3) + 8 * (r >> 2)) * RS;
#pragma unroll
        for (int d0 = 0; d0 < 4; ++d0) gq[r][d0] = growp[ovo + d0 * 32]; }
#pragma unroll
    for (int r = 0; r < 16; ++r) { bf16_t* rowp = Ow + (size_t)((r & 3) + 8 * (r >> 2)) * RS;
#pragma unroll
        for (int d0 = 0; d0 < 4; ++d0) { const float gl_ = __uint_as_float((unsigned)gq[r][d0] << 16);
            const float v = o[d0][r] * rli[r] * __builtin_amdgcn_rcpf(1.f + __expf(-gl_)); const float vn = shfl_idx(v, lane ^ 1);
            if ((r32 & 1) == 0) *(unsigned*)(rowp + ovo + d0 * 32) = cvtpkv(v, vn); } }
    __syncthreads();
#undef RESC
#undef ADDB
#undef KBASE
#undef MASKT
#undef SEAM_K0
#undef HALF_STEP
}
#undef VMW
#undef VMWN
#undef SLOAD_H
#undef ALOAD
#undef SWRITE_HK
#undef SWRITE_HV
#undef SWRITE_H
__device__ __forceinline__ BlockRef make_ref(const int* jlo, int bh, int qb) {
    const int b = bh >> 4, hd = bh & 15; BlockRef r; const int j0 = jlo[bh * 16 + qb] * KVBLK;
    r.qo = (unsigned)((b * SEQ + qb * QB) * RS + hd * D); r.ko = (unsigned)((b * SEQ + j0) * RS + hd * D); r.fo = (unsigned)(bh * SEQ + j0); r.P0 = qb * QB - j0; return r;
}
__device__ __forceinline__ void attn_phase(int wv, LAS unsigned char* ldsl, const bf16_t* qb_, const bf16_t* Kb_, const bf16_t* Vb_, const float* Fa_, bf16_t* ob_, const bf16_t* gb_, const int* jlo, unsigned* qctr) {
    char* lds = (char*)ldsl; const Ptrs p{qb_, Kb_, Vb_, Fa_, ob_, gb_};
    volatile int* s_next = (volatile int*)(lds + LDS_BYTES);
    const int tid = ltid(wv);
    if (tid == 0) *s_next = (int)__hip_atomic_fetch_add(qctr, 1u, __ATOMIC_RELAXED, __HIP_MEMORY_SCOPE_AGENT);
    __syncthreads();
    int L = __builtin_amdgcn_readfirstlane(*s_next);
    if (L >= 1024) return;
    BlockRef cur = make_ref(jlo, L & 63, 15 - (L >> 6));
    Seam S;
    attn_prime(wv, p, cur, lds, ldsl, S);
    for (;;) {
        if (tid == 0) *s_next = (int)__hip_atomic_fetch_add(qctr, 1u, __ATOMIC_RELAXED, __HIP_MEMORY_SCOPE_AGENT);
        __syncthreads();
        const int Ln = __builtin_amdgcn_readfirstlane(*s_next); const bool last = Ln >= 1024;
        const BlockRef nxt = last ? cur : make_ref(jlo, Ln & 63, 15 - (Ln >> 6));
        attn_block(wv, p, cur, nxt, lds, ldsl, S);
        if (last) break;
        cur = nxt;
    }
}
}

constexpr int NSTEPS = 49;
__device__ __forceinline__ void gemm_bf16_nl(int wv, LAS unsigned char* smem, const bf16_t* A, const bf16_t* Bt, int N, bf16_t* O, int ldc, int split_cols, size_t split_stride) {
    pg8::Gemm g{A, Bt, TT, N, DM}; pg8::StaticOrder S; S.init(TT, N, lgrid(), lbid());
    pg8::EpiBf16<0> E{O, ldc, nullptr, split_cols, split_stride};
    pg8::gemm_phase<pg8::EpiBf16<0>, pg8::StaticOrder, false>(wv, smem, g, S, E, nullptr);
}
__device__ __forceinline__ void gemm_resid_nl(int wv, LAS unsigned char* smem, const bf16_t* A, const bf16_t* Bt, const void* xold, int xold_f32, bf16_t* xnew, const float* gate) {
    pg8::Gemm g{A, Bt, TT, DM, DM}; pg8::StaticOrder S; S.init(TT, DM, lgrid(), lbid());
    pg8::EpiResid E{xold, xold_f32, xnew, gate, 12288};
    pg8::gemm_phase<pg8::EpiResid, pg8::StaticOrder, false>(wv, smem, g, S, E, nullptr);
}
template <unsigned PHASE_MASK>
__global__ void __launch_bounds__(NTHR, 2) trunk_kernel(Params p_unused, int lo, int hi) {
    extern __shared__ __attribute__((aligned(16))) unsigned char smem[];
    LAS unsigned char* sl = (LAS unsigned char*)smem;
    const int wv0 = __builtin_amdgcn_readfirstlane((int)threadIdx.x >> 6);
    typedef const __attribute__((address_space(4))) Params* KP;
    KP kp0 = (KP)__builtin_amdgcn_kernarg_segment_ptr();
    XcdBarrier bar; bar.bar = kp0->bar; bar.x = 0; bar.st = nullptr; bar.wv = wv0;
    if (hi - lo > 1) {
        LAS unsigned* stw = (LAS unsigned*)(smem + LDS_BYTES - 16);
        if (xb_thread0(wv0)) { stw[0] = 0u; stw[1] = 0u; stw[2] = 0u; stw[3] = 0u; }
        __syncthreads();
        bar = xcd_barrier_post(kp0->bar, (volatile LAS unsigned*)stw, wv0);
    }
    int step = 0;
#define EN(k) (((PHASE_MASK) >> (k)) & 1u)
#ifndef DUP_MASK
#define DUP_MASK 0u
#endif
#define DUP(k) (((DUP_MASK) >> (k)) & 1u)
#define RUN(kind, ...) do { KP kq = kp0; asm volatile("" : "+s"(kq)); const int lo_ = ((const __attribute__((address_space(4))) int*)kq)[sizeof(Params) / 4], hi_ = ((const __attribute__((address_space(4))) int*)kq)[sizeof(Params) / 4 + 1]; \
        if (step >= lo_ && step < hi_) { if constexpr (EN(kind)) { const Params& p = *(const Params*)kq; int wv = wv0; asm volatile("" : "+s"(wv)); __VA_ARGS__; if constexpr (DUP(kind)) { xcd_barrier(bar); __VA_ARGS__; } } if (step + 1 < hi_) xcd_barrier(bar); } ++step; } while (0)
    RUN(0, phase_prologue(wv, p, smem, p.bar + 3712));
    RUN(1, (phase_norm<false, false, true>(wv, p.x, p.norm_mix, p.mod + 0, p.mod + 2048, 12288, p.h, nullptr, nullptr, nullptr, 0, nullptr, nullptr)));
    for (int l = 0; l < 2; ++l) {
        RUN(2, gemm_bf16_nl(wv, sl, p.h, p.Wt_in + (size_t)l * GLA_NM * DM, GLA_NM, p.proj, GLA_NM, 0, 0));
        RUN(3, {
#ifdef PREP_PROBE
            phase_gla_prep<PREP_PROBE>(wv, p, l, smem); xcd_barrier(bar);
#endif
            phase_gla_prep<0>(wv, p, l, smem); });
        RUN(4, {
#ifdef REC_PROBE
            phase_gla_rec<REC_PROBE>(wv, p, smem); xcd_barrier(bar);
#endif
            phase_gla_rec<0>(wv, p, smem); });
        RUN(5, phase_gla_onorm(wv, p, l));
        RUN(6, gemm_resid_nl(wv, sl, p.og, p.Wt_out + (size_t)l * DM * DM, l == 0 ? (const void*)p.x : (const void*)p.xbuf, l == 0 ? 1 : 0, p.xbuf, (p.mod + (size_t)l * NBATCH * 12288) + 4096));
        RUN(1, (phase_norm<false, false>(wv, p.xbuf, p.norm_ffn + l * DM, (p.mod + (size_t)l * NBATCH * 12288) + 6144, (p.mod + (size_t)l * NBATCH * 12288) + 8192, 12288, p.h2, nullptr, nullptr, nullptr, 0, nullptr, nullptr)));
        RUN(2, gemm_bf16_nl(wv, sl, p.h2, p.Wt_pq + (size_t)l * DM * DM, DM, p.pq, DM, 0, 0));
        RUN(7, phase_peer_topk(wv, p, l, smem));
        RUN(8, phase_peer_gather1(wv, p, l));
        RUN(13, phase_peer_coef(wv, p, l));
        RUN(14, phase_peer_gather2(wv, p, l, (p.mod + (size_t)l * NBATCH * 12288) + 10240));
        if (l == 0) RUN(1, (phase_norm<false, false>(wv, p.xbuf, p.norm_mix + DM, (p.mod + (size_t)l * NBATCH * 12288) + NBATCH * 12288, (p.mod + (size_t)l * NBATCH * 12288) + NBATCH * 12288 + 2048, 12288, p.h, nullptr, nullptr, nullptr, 0, nullptr, nullptr)));
        else RUN(1, (phase_norm<true, false>(wv, p.xbuf, p.kv_norm, p.kvmod, p.kvmod + 2048, 4096, p.hk, p.norm_mix + 2 * DM, (p.mod + (size_t)l * NBATCH * 12288) + NBATCH * 12288, (p.mod + (size_t)l * NBATCH * 12288) + NBATCH * 12288 + 2048, 12288, p.h, nullptr)));
    }
    RUN(2, { gemm_bf16_nl(wv, sl, p.hk, p.Wt_kv, KV_NM, p.Kb, DM, DM, (size_t)TT * DM); __syncthreads(); if constexpr (EN(9)) phase_fl(wv, p, smem); });
    for (int l = 2; l < 4; ++l) {
        RUN(2, { gemm_bf16_nl(wv, sl, p.h, p.Wt_q + (size_t)(l - 2) * 4096 * DM, 4096, p.qb, DM, DM, (size_t)TT * DM); if constexpr (EN(10)) { if (l == 2) { phase_fscan(wv, p, smem); phase_knorm(wv, p, smem); } } });
        RUN(15, phase_qn(wv, p, smem));
        RUN(11, fa::attn_phase(wv, sl, p.qb, p.Kb, p.Vb, p.Fa, p.og, p.gb, p.jlo, p.bar + 3584 + 64 * (l - 2)));
        RUN(6, gemm_resid_nl(wv, sl, p.og, p.Wt_fo + (size_t)(l - 2) * DM * DM, (const void*)p.xbuf, 0, p.xbuf, (p.mod + (size_t)l * NBATCH * 12288) + 4096));
        RUN(1, (phase_norm<false, false>(wv, p.xbuf, p.norm_ffn + l * DM, (p.mod + (size_t)l * NBATCH * 12288) + 6144, (p.mod + (size_t)l * NBATCH * 12288) + 8192, 12288, p.h2, nullptr, nullptr, nullptr, 0, nullptr, nullptr)));
        RUN(2, gemm_bf16_nl(wv, sl, p.h2, p.Wt_pq + (size_t)l * DM * DM, DM, p.pq, DM, 0, 0));
        RUN(7, phase_peer_topk(wv, p, l, smem));
        RUN(8, phase_peer_gather1(wv, p, l));
        RUN(13, phase_peer_coef(wv, p, l));
        RUN(14, phase_peer_gather2(wv, p, l, (p.mod + (size_t)l * NBATCH * 12288) + 10240));
        if (l == 2) RUN(1, (phase_norm<false, false>(wv, p.xbuf, p.norm_mix + 3 * DM, (p.mod + (size_t)l * NBATCH * 12288) + NBATCH * 12288, (p.mod + (size_t)l * NBATCH * 12288) + NBATCH * 12288 + 2048, 12288, p.h, nullptr, nullptr, nullptr, 0, nullptr, nullptr)));
        else RUN(1, (phase_norm<false, true>(wv, p.xbuf, p.final_norm, nullptr, nullptr, 0, nullptr, nullptr, nullptr, nullptr, 0, nullptr, p.out)));
    }
#undef RUN
}

extern "C" void kernel_launch(void* const* d_in, const int* in_sizes, int n_in, void* d_out, int out_size, void* d_ws, size_t ws_size, hipStream_t stream) {
    static int grid = 0;
    if (grid == 0) {
        int dev = 0, cus = 0;
        if (hipGetDevice(&dev) != hipSuccess || hipDeviceGetAttribute(&cus, hipDeviceAttributeMultiprocessorCount, dev) != hipSuccess || cus <= 0) cus = 256;
        const bool ok = hipFuncSetAttribute((const void*)trunk_kernel<0xffffffffu>, hipFuncAttributeMaxDynamicSharedMemorySize, LDS_BYTES) == hipSuccess;
        if (!ok) { fprintf(stderr, "kernel_launch: hipFuncSetAttribute failed\n"); grid = -1; return; }
        (void)hipGetLastError();
        grid = cus;
    }
    if (grid < 0 || n_in != 23) return;
    Params p{};
    const float* const* in = (const float* const*)d_in;
    p.x = in[0]; p.c = in[1]; p.ada_w = in[2]; p.ada_b = in[3]; p.norm_mix = in[4]; p.norm_ffn = in[5]; p.gla_w_in = in[6]; p.gla_wg2 = in[7]; p.gla_bg2 = in[8]; p.gla_norm = in[9];
    p.gla_w_out = in[10]; p.kv_norm = in[11]; p.kv_ada_w = in[12]; p.kv_ada_b = in[13]; p.fox_w_kv = in[14]; p.fox_b_f = in[15]; p.fox_w_q = in[16]; p.fox_w_out = in[17];
    p.peer_w_q = in[18]; p.peer_subk = in[19]; p.peer_u = in[20]; p.peer_v = in[21]; p.final_norm = in[22];
    p.out = (float*)d_out;
    unsigned char* ws = (unsigned char*)d_ws; size_t off = 0;
    auto take = [&](size_t bytes) { unsigned char* r = ws + off; off += (bytes + 255) & ~(size_t)255; return r; };
    p.bar = (unsigned*)take(16384);
    p.mod = (float*)take((size_t)4 * NBATCH * 12288 * 4); p.kvmod = (float*)take((size_t)NBATCH * 4096 * 4);
    p.Wt_in = (bf16_t*)take((size_t)2 * GLA_NM * DM * 2); p.W16_in = (bf16_t*)take((size_t)2 * 16 * DM * 2);
    p.Wt_out = (bf16_t*)take((size_t)2 * DM * DM * 2); p.Wt_kv = (bf16_t*)take((size_t)KV_NM * DM * 2); p.W16_kv = (bf16_t*)take((size_t)16 * DM * 2);
    p.Wt_q = (bf16_t*)take((size_t)2 * 4096 * DM * 2); p.Wt_fo = (bf16_t*)take((size_t)2 * DM * DM * 2); p.Wt_pq = (bf16_t*)take((size_t)4 * DM * DM * 2);
    p.subk = (bf16_t*)take((size_t)4 * 8 * 2 * 128 * 128 * 2);
    p.U8 = (unsigned char*)take((size_t)4 * 16384 * DM); p.V8 = (unsigned char*)take((size_t)4 * 16384 * DM); p.su = (float*)take((size_t)4 * 16384 * 4); p.sv = (float*)take((size_t)4 * 16384 * 4);
    p.xbuf = (bf16_t*)take((size_t)TT * DM * 2);
    p.h = (bf16_t*)take((size_t)TT * DM * 2); p.hk = (bf16_t*)take((size_t)TT * DM * 2); p.h2 = (bf16_t*)take((size_t)TT * DM * 2);
    p.og = (bf16_t*)take((size_t)TT * DM * 2); p.pq = (bf16_t*)take((size_t)TT * DM * 2);
    p.ids = (int*)take((size_t)TT * 128 * 4); p.wts = (float*)take((size_t)TT * 128 * 4); p.fl = (float*)take((size_t)TT * 16 * 4); p.apart = (float*)take((size_t)8 * TT * 128 * 4); p.cqbuf = (signed char*)take((size_t)TT * 128); p.scbuf = (float*)take((size_t)TT * 4); p.kn2 = (float*)take(1024 * 4); p.jlo = (int*)take(1024 * 4);
    const size_t region = off;
    p.proj = (bf16_t*)take((size_t)TT * GLA_NM * 2); p.qt = (bf16_t*)take((size_t)TT * 1024 * 2); p.khT = (bf16_t*)take((size_t)TT * 1024 * 2);
    p.vT = (bf16_t*)take((size_t)TT * DM * 2); p.Pm = (bf16_t*)take((size_t)TT * 4 * 64 * 2); p.dec = (float*)take((size_t)1024 * 256 * 4); p.o = (bf16_t*)take((size_t)TT * DM * 2);
    const size_t end_gla = off; off = region;
    p.qb = (bf16_t*)take((size_t)TT * DM * 2); p.gb = (bf16_t*)take((size_t)TT * DM * 2); p.Kb = (bf16_t*)take((size_t)TT * DM * 2); p.Vb = (bf16_t*)take((size_t)TT * DM * 2);
    p.ob = (bf16_t*)take((size_t)TT * DM * 2); p.Fa = (float*)take((size_t)64 * SEQ * 4);
    const size_t end_all = off > end_gla ? off : end_gla;
    if (end_all > ws_size) { fprintf(stderr, "kernel_launch: workspace too small: need %zu have %zu\n", end_all, ws_size); return; }
    { int first = 0, m = 0;
      auto add = [&](const float* src, bf16_t* dst, bf16_t* dst16, int N, int Nmain) { TMat& t = p.tm[m++]; t.src = src; t.dst = dst; t.dst16 = dst16; t.N = N; t.Nmain = Nmain; t.ntn = (N + 255) / 256; t.first = first; first += 32 * t.ntn; };
      for (int l = 0; l < 2; ++l) add(p.gla_w_in + (size_t)l * DM * GLA_N, p.Wt_in + (size_t)l * GLA_NM * DM, p.W16_in + (size_t)l * 16 * DM, GLA_N, GLA_NM);
      for (int l = 0; l < 2; ++l) add(p.gla_w_out + (size_t)l * DM * DM, p.Wt_out + (size_t)l * DM * DM, nullptr, DM, DM);
      add(p.fox_w_kv, p.Wt_kv, p.W16_kv, KV_N, KV_NM);
      for (int l = 0; l < 2; ++l) add(p.fox_w_q + (size_t)l * DM * 4096, p.Wt_q + (size_t)l * 4096 * DM, nullptr, 4096, 4096);
      for (int l = 0; l < 2; ++l) add(p.fox_w_out + (size_t)l * DM * DM, p.Wt_fo + (size_t)l * DM * DM, nullptr, DM, DM);
      for (int l = 0; l < 4; ++l) add(p.peer_w_q + (size_t)l * DM * DM, p.Wt_pq + (size_t)l * DM * DM, nullptr, DM, DM);
      p.ntr_jobs = first; p.pad0 = 0; }
    (void)hipMemsetAsync(p.bar, 0, 16384, stream);
    hipLaunchKernelGGL(trunk_kernel<0xffffffffu>, dim3(grid), dim3(NTHR), LDS_BYTES, stream, p, 0, NSTEPS);
    const hipError_t le = hipPeekAtLastError();
    if (le != hipSuccess) fprintf(stderr, "kernel_launch: launch failed: %s\n", hipGetErrorName(le));
}
```
